# Optimizing an MI355X kernel written in HIP

```python
import jax
import jax.numpy as jnp
from jax import lax
import numpy as np

D_MODEL = 1024
BATCH = 32
SEQ = 2048
DEPTH = 2

CTX_LEN = 256
GRID_W = 64
N_EVEN = (DEPTH + 1) // 2
N_ODD = DEPTH // 2
EPS = 1e-6

ML_HEADS = 4
ML_DQK = 128
ML_DV = 128
ML_CHUNK = 64
ML_QK_W = ML_HEADS * ML_DQK
ML_W = ML_HEADS * ML_DV
ML_GATES = 4 * ML_HEADS

GLA_HEADS = 4
GLA_DK = 64
GLA_DV = 128
GLA_LR = 16
GLA_TAU = 16.0
GLA_CHUNK = 32
GLA_QK_W = GLA_HEADS * GLA_DK
GLA_W = GLA_HEADS * GLA_DV

MIX_W = ML_W + GLA_W
IN_SIZES = (ML_QK_W, ML_QK_W, ML_W, ML_W, ML_GATES, GLA_QK_W, GLA_QK_W, GLA_W, GLA_W, 2 * GLA_LR)
IN_WIDTH = sum(IN_SIZES)

RW_HEAD = 64
RW_HEADS = D_MODEL // RW_HEAD
RW_DECAY_LR = 64
RW_A_LR = 64
RW_G_LR = 128
RW_LN_EPS = 64e-5

D_FF = 2816

kernel_name = "hybrid_mlstm_gla_rwkv7_convffn_dit"


def split_points(sizes):
    pts, acc = [], 0
    for s in sizes[:-1]:
        acc += s
        pts.append(acc)
    return pts


def rmsnorm(x, g):
    xf = x.astype(jnp.float32)
    y = xf * lax.rsqrt(jnp.mean(xf * xf, axis=-1, keepdims=True) + EPS)
    return (y * g.astype(jnp.float32)).astype(x.dtype)


def head_rmsnorm(y, g, n_heads):
    bn, L, W = y.shape
    d = W // n_heads
    return rmsnorm(y.reshape(bn, L, n_heads, d), g.reshape(n_heads, d)).reshape(bn, L, W)


def head_layernorm(y, w, b, n_heads, out_dtype):
    bn, L, W = y.shape
    yf = y.astype(jnp.float32).reshape(bn, L, n_heads, W // n_heads)
    mu = jnp.mean(yf, axis=-1, keepdims=True)
    var = jnp.mean(jnp.square(yf - mu), axis=-1, keepdims=True)
    yn = ((yf - mu) * lax.rsqrt(var + RW_LN_EPS)).reshape(bn, L, W)
    return (yn * w.astype(jnp.float32) + b.astype(jnp.float32)).astype(out_dtype)


def modulate(h, shift, scale):
    return h * (1 + scale) + shift


def to_heads(t, n_heads):
    bn, L, W = t.shape
    return t.reshape(bn, L, n_heads, W // n_heads).transpose(0, 2, 1, 3)


def from_heads(t):
    bn, H, L, d = t.shape
    return t.transpose(0, 2, 1, 3).reshape(bn, L, H * d)


def to_chunks(t, chunk):
    bn, H, L = t.shape[:3]
    t = t.reshape((bn, H, L // chunk, chunk) + t.shape[3:])
    return jnp.moveaxis(t, 2, 0)


def from_chunks(t):
    t = jnp.moveaxis(t, 0, 2)
    return t.reshape(t.shape[:2] + (-1,) + t.shape[4:])


def short_conv(x, w, b):
    xp = jnp.pad(x, ((0, 0), (1, 1), (0, 0)))
    return xp[:, :-2] * w[0] + xp[:, 1:-1] * w[1] + xp[:, 2:] * w[2] + b


def dwconv_grid(h, w, b, grid):
    rows, width = grid
    bn, L, F = h.shape
    img = h.reshape(bn, rows, width, F)
    out = lax.conv_general_dilated(img, w[:, :, None, :].astype(h.dtype), window_strides=(1, 1), padding="SAME",
                                   dimension_numbers=("NHWC", "HWIO", "NHWC"), feature_group_count=F)
    return out.reshape(bn, L, F) + b


def grid_shift(x, grid):
    rows, width = grid
    bn, L, D = x.shape
    q = D // 4
    p = jnp.pad(x.reshape(bn, rows, width, D), ((0, 0), (1, 1), (1, 1), (0, 0)))
    out = jnp.concatenate([p[:, 1:-1, :-2, :q], p[:, 1:-1, 2:, q:2 * q],
                           p[:, :-2, 1:-1, 2 * q:3 * q], p[:, 2:, 1:-1, 3 * q:]], axis=-1)
    return out.reshape(bn, L, D)


def seq_shift(x):
    D = x.shape[-1]
    q = D // 4
    p = jnp.pad(x, ((0, 0), (1, 1), (0, 0)))
    prv, nxt = p[:, :-2], p[:, 2:]
    return jnp.concatenate([prv[..., :q], nxt[..., q:2 * q], prv[..., 2 * q:3 * q], nxt[..., 3 * q:]], axis=-1)


def bidir_scan(scan_fn, init, ctx_fwd, ctx_bwd, lat_fwd, lat_bwd):
    flip = lambda args: tuple(jnp.flip(a, axis=2) for a in args)
    y_cf, s_f = scan_fn(*ctx_fwd, init)
    y_cb, s_b = scan_fn(*flip(ctx_bwd), init)
    y_lf, _ = scan_fn(*lat_fwd, s_f)
    y_lb, _ = scan_fn(*flip(lat_bwd), s_b)
    return y_cf + jnp.flip(y_cb, axis=2), y_lf + jnp.flip(y_lb, axis=2)


def mlstm_scan(q, k, v, logi, logf, state):
    q, k, v, logi, logf = (t.astype(jnp.float32) for t in (q, k, v, logi, logf))
    mask = jnp.tril(jnp.ones((ML_CHUNK, ML_CHUNK), dtype=bool))

    def step(carry, blk):
        C, n, m = carry
        qc, kc, vc, ic, fc = blk
        b = jnp.cumsum(fc, axis=-1)
        inter = b + m[..., None]
        d = jnp.where(mask, b[..., :, None] - b[..., None, :] + ic[..., None, :], -jnp.inf)
        mt = jnp.maximum(inter, jnp.max(d, axis=-1))
        s = jnp.einsum("bhtd,bhsd->bhts", qc, kc) * jnp.exp(d - mt[..., None])
        wi = jnp.exp(inter - mt)
        num = jnp.einsum("bhts,bhsv->bhtv", s, vc) + wi[..., None] * jnp.einsum("bhtd,bhdv->bhtv", qc, C)
        den = jnp.sum(s, axis=-1) + wi * jnp.einsum("bhtd,bhd->bht", qc, n)
        h = num / jnp.maximum(jnp.abs(den), jnp.exp(-mt))[..., None]
        bl = b[..., -1]
        g = bl[..., None] - b + ic
        m_new = jnp.maximum(bl + m, jnp.max(g, axis=-1))
        ws = jnp.exp(g - m_new[..., None])
        wp = jnp.exp(bl + m - m_new)
        C = wp[..., None, None] * C + jnp.einsum("bhs,bhsd,bhsv->bhdv", ws, kc, vc)
        n = wp[..., None] * n + jnp.einsum("bhs,bhsd->bhd", ws, kc)
        return (C, n, m_new), h

    state, hs = lax.scan(step, state, tuple(to_chunks(t, ML_CHUNK) for t in (q, k, v, logi, logf)))
    return from_chunks(hs), state


def gla_scan(q, k, v, la, S):
    q, k, v, la = (t.astype(jnp.float32) for t in (q, k, v, la))
    mask = jnp.tril(jnp.ones((GLA_CHUNK, GLA_CHUNK), dtype=bool))[:, :, None]

    def step(S, blk):
        qc, kc, vc, ac = blk
        b = jnp.cumsum(ac, axis=2)
        decay = jnp.exp(jnp.where(mask, b[:, :, :, None, :] - b[:, :, None, :, :], -jnp.inf))
        A = jnp.einsum("bhtd,bhsd,bhtsd->bhts", qc, kc, decay)
        o = jnp.einsum("bhts,bhsv->bhtv", A, vc) + jnp.einsum("bhtd,bhdv->bhtv", qc * jnp.exp(b), S)
        bl = b[:, :, -1:, :]
        S = jnp.exp(bl[:, :, 0, :])[..., None] * S + jnp.einsum("bhsd,bhsv->bhdv", kc * jnp.exp(bl - b), vc)
        return S, o

    S, os_ = lax.scan(step, S, tuple(to_chunks(t, GLA_CHUNK) for t in (q, k, v, la)))
    return from_chunks(os_), S


def rwkv7_scan(r, w, k, v, kk, a, S):
    xs = tuple(jnp.moveaxis(t.astype(jnp.float32), 2, 0) for t in (r, w, k, v, kk, a))

    def step(S, inp):
        rt, wt, kt, vt, kkt, at = inp
        sa = jnp.einsum("bhvk,bhk->bhv", S, -kkt)
        S = S * wt[:, :, None, :] + sa[..., None] * (kkt * at)[:, :, None, :] + vt[..., None] * kt[:, :, None, :]
        return S, jnp.einsum("bhvk,bhk->bhv", S, rt)

    S, ys = lax.scan(step, S, xs)
    return jnp.moveaxis(ys, 0, 2), S


def even_project(h, w_in, b_gates, conv_w, conv_b, gla_w2, gla_b):
    bn, L, _ = h.shape
    z = h @ w_in
    mq, mk, mv, mo, mg, gq, gk, gv, gg, glr = jnp.split(z, split_points(IN_SIZES), axis=-1)
    qk = jax.nn.silu(short_conv(jnp.concatenate([mq, mk], axis=-1), conv_w, conv_b))
    mq, mk = jnp.split(qk, 2, axis=-1)
    mg = (mg + b_gates).astype(jnp.float32).reshape(bn, L, 4, ML_HEADS).transpose(2, 0, 3, 1)
    glr = glr.reshape(bn, L, 2, GLA_LR)
    la = jax.nn.log_sigmoid((jnp.einsum("blzr,zrc->zblc", glr, gla_w2) + gla_b[:, None, None, :]).astype(jnp.float32)) / GLA_TAU
    return {
        "mq": to_heads(mq * ML_DQK ** -0.5, ML_HEADS), "mk": to_heads(mk, ML_HEADS), "mv": to_heads(mv, ML_HEADS),
        "i_f": mg[0], "f_f": jax.nn.log_sigmoid(mg[1]), "i_b": mg[2], "f_b": jax.nn.log_sigmoid(mg[3]),
        "gq": to_heads(gq * GLA_DK ** -0.5, GLA_HEADS), "gk": to_heads(gk, GLA_HEADS), "gv": to_heads(gv, GLA_HEADS),
        "la_f": to_heads(la[0], GLA_HEADS), "la_b": to_heads(la[1], GLA_HEADS),
        "mo": mo, "gg": gg,
    }


def even_out(ml_y, gla_y, p, head_g, w_out):
    dt = p["mo"].dtype
    m = head_rmsnorm(from_heads(ml_y).astype(dt), head_g[:ML_W], ML_HEADS) * jax.nn.sigmoid(p["mo"])
    g = head_rmsnorm(from_heads(gla_y).astype(dt), head_g[ML_W:], GLA_HEADS) * jax.nn.silu(p["gg"])
    return jnp.concatenate([m, g], axis=-1) @ w_out


def even_mixer(hc, hl, w_in, b_gates, conv_w, conv_b, gla_w2, gla_b, head_g, w_out, need_ctx):
    pc = even_project(hc, w_in, b_gates, conv_w, conv_b, gla_w2, gla_b)
    pl = even_project(hl, w_in, b_gates, conv_w, conv_b, gla_w2, gla_b)
    bn = hl.shape[0]
    f32 = jnp.float32
    ml_init = (jnp.zeros((bn, ML_HEADS, ML_DQK, ML_DV), f32), jnp.zeros((bn, ML_HEADS, ML_DQK), f32),
               jnp.zeros((bn, ML_HEADS), f32))
    gla_init = jnp.zeros((bn, GLA_HEADS, GLA_DK, GLA_DV), f32)
    ml_args = lambda p: ((p["mq"], p["mk"], p["mv"], p["i_f"], p["f_f"]), (p["mq"], p["mk"], p["mv"], p["i_b"], p["f_b"]))
    gla_args = lambda p: ((p["gq"], p["gk"], p["gv"], p["la_f"]), (p["gq"], p["gk"], p["gv"], p["la_b"]))
    ml_c, ml_l = bidir_scan(mlstm_scan, ml_init, *ml_args(pc), *ml_args(pl))
    gla_c, gla_l = bidir_scan(gla_scan, gla_init, *gla_args(pc), *gla_args(pl))
    y_lat = even_out(ml_l, gla_l, pl, head_g, w_out)
    y_ctx = even_out(ml_c, gla_c, pc, head_g, w_out) if need_ctx else None
    return y_ctx, y_lat


def rwkv_project(h, shifted, mu, w_rkv, w0, w1, w2, a0, a1, a2, g1, g2, kvec):
    xx = shifted - h
    xr, xw, xk, xv, xa, xg = (h + xx * mu[i] for i in range(6))
    r = xr @ w_rkv[0]
    k = xk @ w_rkv[1]
    v = xv @ w_rkv[2]
    lw = jnp.einsum("zblr,zrd->zbld", jnp.tanh(jnp.einsum("bld,zdr->zblr", xw, w1)), w2) + w0[:, None, None, :]
    decay = jnp.exp(-jnp.exp(-jax.nn.softplus(-lw.astype(jnp.float32)) - 0.5))
    a = jax.nn.sigmoid(a0 + (xa @ a1) @ a2)
    g = jax.nn.sigmoid(xg @ g1) @ g2
    kk = to_heads(k * kvec[0], RW_HEADS).astype(jnp.float32)
    kk = kk / jnp.maximum(jnp.sqrt(jnp.sum(kk * kk, axis=-1, keepdims=True)), 1e-12)
    k = k * (1 + (a - 1) * kvec[1])
    return {"r": r, "k": k, "v": v, "a": a, "g": g, "decay": decay, "kk": kk}


def rwkv_out(y, p, kvec, lnx, w_o):
    r, k, v, g = p["r"], p["k"], p["v"], p["g"]
    bn, L, D = r.shape
    y = head_layernorm(from_heads(y), lnx[0], lnx[1], RW_HEADS, r.dtype)
    bonus = jnp.sum((r * k * kvec[2]).reshape(bn, L, RW_HEADS, RW_HEAD), axis=-1, keepdims=True) * v.reshape(bn, L, RW_HEADS, RW_HEAD)
    return ((y + bonus.reshape(bn, L, D)) * g) @ w_o


def rwkv_mixer(hc, hl, lat_grid, mu, w_rkv, w_o, w0, w1, w2, a0, a1, a2, g1, g2, kvec, lnx, need_ctx):
    pc = rwkv_project(hc, seq_shift(hc), mu, w_rkv, w0, w1, w2, a0, a1, a2, g1, g2, kvec)
    pl = rwkv_project(hl, grid_shift(hl, lat_grid), mu, w_rkv, w0, w1, w2, a0, a1, a2, g1, g2, kvec)
    init = jnp.zeros((hl.shape[0], RW_HEADS, RW_HEAD, RW_HEAD), jnp.float32)

    def scan_args(p):
        r, k, v, a = (to_heads(p[n], RW_HEADS) for n in ("r", "k", "v", "a"))
        return ((r, to_heads(p["decay"][0], RW_HEADS), k, v, p["kk"], a),
                (r, to_heads(p["decay"][1], RW_HEADS), k, v, p["kk"], a))

    y_c, y_l = bidir_scan(rwkv7_scan, init, *scan_args(pc), *scan_args(pl))
    out_l = rwkv_out(y_l, pl, kvec, lnx, w_o)
    out_c = rwkv_out(y_c, pc, kvec, lnx, w_o) if need_ctx else None
    return out_c, out_l


def conv_ffn(h, w_up, conv_w, conv_b, w_down, grid):
    gate, up = jnp.split(h @ w_up, 2, axis=-1)
    gate = dwconv_grid(gate, conv_w, conv_b, grid)
    return (jax.nn.gelu(gate, approximate=True) * up) @ w_down


def setup_inputs(seed: int = 0) -> dict:
    key = jax.random.key(seed)
    keys = iter(jax.random.split(key, 48))

    def nrm(shape, scale):
        return jax.random.normal(next(keys), shape, jnp.float32) * scale

    def unif(shape, lo, hi):
        return jax.random.uniform(next(keys), shape, jnp.float32, lo, hi)

    D = D_MODEL
    gate_i = nrm((N_EVEN, 2, 1, ML_HEADS), 0.1)
    gate_f = jnp.linspace(3.0, 6.0, ML_HEADS, dtype=jnp.float32) + nrm((N_EVEN, 2, 1, ML_HEADS), 0.1)
    return {
        "x": nrm((BATCH, SEQ, D), 1.0),
        "c": nrm((BATCH, D), 1.0),
        "ctx": nrm((BATCH, CTX_LEN, D), 1.0),
        "c_ctx": nrm((D,), 1.0),
        "w_mod": nrm((DEPTH, D, 6 * D), 0.5 * D ** -0.5),
        "b_mod": nrm((DEPTH, 6 * D), 0.02),
        "norm_g": 1.0 + nrm((DEPTH, 4, D), 0.02),
        "ffn_w_up": nrm((DEPTH, D, 2 * D_FF), D ** -0.5),
        "ffn_conv_w": nrm((DEPTH, 3, 3, D_FF), 1.0 / 3.0),
        "ffn_conv_b": nrm((DEPTH, D_FF), 0.02),
        "ffn_w_down": nrm((DEPTH, D_FF, D), D_FF ** -0.5),
        "ev_w_in": nrm((N_EVEN, D, IN_WIDTH), D ** -0.5),
        "ev_b_gates": jnp.concatenate([gate_i, gate_f], axis=2).reshape(N_EVEN, ML_GATES),
        "ev_conv_w": nrm((N_EVEN, 3, 2 * ML_QK_W), 3 ** -0.5),
        "ev_conv_b": nrm((N_EVEN, 2 * ML_QK_W), 0.02),
        "ev_gla_w2": nrm((N_EVEN, 2, GLA_LR, GLA_QK_W), GLA_LR ** -0.5),
        "ev_gla_b": nrm((N_EVEN, 2, GLA_QK_W), 0.1),
        "ev_head_g": 1.0 + nrm((N_EVEN, MIX_W), 0.02),
        "ev_w_out": nrm((N_EVEN, MIX_W, D), MIX_W ** -0.5),
        "rw_mu": unif((N_ODD, 6, D), 0.0, 1.0),
        "rw_w_rkv": nrm((N_ODD, 3, D, D), D ** -0.5),
        "rw_w_o": nrm((N_ODD, D, D), D ** -0.5),
        "rw_w0": unif((N_ODD, 2, D), -6.0, 1.0),
        "rw_w1": nrm((N_ODD, 2, D, RW_DECAY_LR), D ** -0.5),
        "rw_w2": nrm((N_ODD, 2, RW_DECAY_LR, D), 0.1 * RW_DECAY_LR ** -0.5),
        "rw_a0": nrm((N_ODD, D), 0.1),
        "rw_a1": nrm((N_ODD, D, RW_A_LR), D ** -0.5),
        "rw_a2": nrm((N_ODD, RW_A_LR, D), 0.1 * RW_A_LR ** -0.5),
        "rw_g1": nrm((N_ODD, D, RW_G_LR), D ** -0.5),
        "rw_g2": nrm((N_ODD, RW_G_LR, D), RW_G_LR ** -0.5),
        "rw_kvec": jnp.stack([0.85 + nrm((N_ODD, D), 0.02), 1.0 + nrm((N_ODD, D), 0.02), nrm((N_ODD, D), 0.1)], axis=1),
        "rw_lnx": jnp.stack([1.0 + nrm((N_ODD, D), 0.02), nrm((N_ODD, D), 0.02)], axis=1),
    }


def reference(x, c, ctx, c_ctx, w_mod, b_mod, norm_g, ffn_w_up, ffn_conv_w, ffn_conv_b, ffn_w_down,
              ev_w_in, ev_b_gates, ev_conv_w, ev_conv_b, ev_gla_w2, ev_gla_b, ev_head_g, ev_w_out,
              rw_mu, rw_w_rkv, rw_w_o, rw_w0, rw_w1, rw_w2, rw_a0, rw_a1, rw_a2, rw_g1, rw_g2, rw_kvec, rw_lnx):
    rows = x.shape[1] // GRID_W
    lat_grid = (rows, GRID_W)
    ctx_grid = (1, ctx.shape[1])
    xl, xc = x, ctx
    for layer in range(DEPTH):
        last = layer == DEPTH - 1
        j = layer // 2
        mod_l = jnp.split((jax.nn.silu(c) @ w_mod[layer] + b_mod[layer])[:, None, :], 6, axis=-1)
        mod_c = jnp.split((jax.nn.silu(c_ctx) @ w_mod[layer] + b_mod[layer])[None, None, :], 6, axis=-1)
        hl = modulate(rmsnorm(xl, norm_g[layer, 0]), mod_l[0], mod_l[1])
        hc = modulate(rmsnorm(xc, norm_g[layer, 0]), mod_c[0], mod_c[1])
        if layer % 2 == 0:
            yc, yl = even_mixer(hc, hl, ev_w_in[j], ev_b_gates[j], ev_conv_w[j], ev_conv_b[j], ev_gla_w2[j],
                                ev_gla_b[j], ev_head_g[j], ev_w_out[j], not last)
        else:
            yc, yl = rwkv_mixer(hc, hl, lat_grid, rw_mu[j], rw_w_rkv[j], rw_w_o[j], rw_w0[j], rw_w1[j], rw_w2[j],
                                rw_a0[j], rw_a1[j], rw_a2[j], rw_g1[j], rw_g2[j], rw_kvec[j], rw_lnx[j], not last)
        xl = xl + mod_l[2] * rmsnorm(yl, norm_g[layer, 1])
        hl = modulate(rmsnorm(xl, norm_g[layer, 2]), mod_l[3], mod_l[4])
        xl = xl + mod_l[5] * rmsnorm(conv_ffn(hl, ffn_w_up[layer], ffn_conv_w[layer], ffn_conv_b[layer],
                                              ffn_w_down[layer], lat_grid), norm_g[layer, 3])
        if not last:
            xc = xc + mod_c[2] * rmsnorm(yc, norm_g[layer, 1])
            hc = modulate(rmsnorm(xc, norm_g[layer, 2]), mod_c[3], mod_c[4])
            xc = xc + mod_c[5] * rmsnorm(conv_ffn(hc, ffn_w_up[layer], ffn_conv_w[layer], ffn_conv_b[layer],
                                                  ffn_w_down[layer], ctx_grid), norm_g[layer, 3])
    return xl
```

```cpp
#include <hip/hip_runtime.h>
#include <hip/hip_cooperative_groups.h>
#include <cstdio>
namespace cg = cooperative_groups;

typedef unsigned short u16;
using bf16x8 = __attribute__((ext_vector_type(8))) short;
using s16x4  = __attribute__((ext_vector_type(4))) short;
using f32x16 = __attribute__((ext_vector_type(16))) float;
#define DI __device__ __forceinline__
#define MFMA(a, b, c) __builtin_amdgcn_mfma_f32_32x32x16_bf16((a), (b), (c), 0, 0, 0)

constexpr int D = 1024, NB = 32, SEQ = 2048, CTX = 256, TPS = 2304;
constexpr int NG = 2, SPG = 16, R = SPG * TPS;
constexpr int ZW = 3712;
constexpr int DFF = 2816, GUW = 5632;
constexpr int NTHR = 256;

struct Ctx { int tid, bid; };
struct Params {
  const float *x, *c, *ctx, *c_ctx, *w_mod, *b_mod, *norm_g, *ffn_w_up, *ffn_conv_w, *ffn_conv_b, *ffn_w_down,
      *ev_w_in, *ev_b_gates, *ev_conv_w, *ev_conv_b, *ev_gla_w2, *ev_gla_b, *ev_head_g, *ev_w_out,
      *rw_mu, *rw_w_rkv, *rw_w_o, *rw_w0, *rw_w1, *rw_w2, *rw_a0, *rw_a1, *rw_a2, *rw_g1, *rw_g2, *rw_kvec, *rw_lnx;
  float* out;
  u16 *wt_in, *wt_out, *wt_up, *wt_down, *wt_r, *wt_k, *wt_v, *wt_o, *wt_w1, *wt_a1, *wt_g1, *wt_w2, *wt_a2, *wt_g2;
  float* mod; float* xc;
  u16* H; u16* BIG; u16* QK; float* YO; u16* LRW; u16* LRA; u16* LRG;
};

DI float bf2f(u16 v) { return __uint_as_float(((unsigned)v) << 16); }
DI u16 f2bf(float f) { unsigned u = __float_as_uint(f); u += 0x7fffu + ((u >> 16) & 1u); return (u16)(u >> 16); }
DI unsigned pack2(float a, float b) { return (unsigned)f2bf(a) | (((unsigned)f2bf(b)) << 16); }
DI float lo16(unsigned u) { return __uint_as_float(u << 16); }
DI float hi16(unsigned u) { return __uint_as_float(u & 0xffff0000u); }
DI void unpack8(const uint4& v, float* o) {
  o[0] = lo16(v.x); o[1] = hi16(v.x); o[2] = lo16(v.y); o[3] = hi16(v.y);
  o[4] = lo16(v.z); o[5] = hi16(v.z); o[6] = lo16(v.w); o[7] = hi16(v.w);
}
DI uint4 pack8(const float* o) { uint4 v; v.x = pack2(o[0], o[1]); v.y = pack2(o[2], o[3]); v.z = pack2(o[4], o[5]); v.w = pack2(o[6], o[7]); return v; }
DI int crow(int reg, int h) { return (reg & 3) + 8 * (reg >> 2) + 4 * h; }
DI float wsum(float v) { for (int o = 32; o; o >>= 1) v += __shfl_xor(v, o); return v; }
DI float sigmoidf_(float x) { return 1.f / (1.f + __expf(-x)); }
DI float logsigf_(float x) { return fminf(x, 0.f) - log1pf(__expf(-fabsf(x))); }
DI float siluf_(float x) { return x / (1.f + __expf(-x)); }
DI bf16x8 cat4(s16x4 lo, s16x4 hi) { return __builtin_shufflevector(lo, hi, 0, 1, 2, 3, 4, 5, 6, 7); }
DI bf16x8 pack_step(const f32x16& x, int s) {
  uint4 v;
  v.x = pack2(x[8 * s + 0], x[8 * s + 1]); v.y = pack2(x[8 * s + 2], x[8 * s + 3]);
  v.z = pack2(x[8 * s + 4], x[8 * s + 5]); v.w = pack2(x[8 * s + 6], x[8 * s + 7]);
  return __builtin_bit_cast(bf16x8, v);
}
DI float dppf(float x, int) { return x; }
#define DPP_F(x, ctrl) __int_as_float(__builtin_amdgcn_update_dpp(0, __float_as_int(x), (ctrl), 0xF, 0xF, true))
DI float red8(float x) {
  x += DPP_F(x, 0x141);
  x += DPP_F(x, 0xB1);
  x += DPP_F(x, 0x4E);
  return x;
}

DI int scan_row(int base, int dir, int p) {
  if (dir == 0) return base + p;
  return (p < CTX) ? base + (CTX - 1 - p) : base + (TPS + CTX - 1 - p);
}

__device__ void convert_job(const Ctx cx, const float* __restrict__ src, int K, int N, int Npad, u16* __restrict__ dst, float* tile) {
  const int tx = cx.tid & 31, ty = cx.tid >> 5;
  const int tk = K >> 5, tn = Npad >> 5;
  for (int t = cx.bid; t < tk * tn; t += gridDim.x) {
    const int k0 = (t / tn) * 32, n0 = (t % tn) * 32;
#pragma unroll
    for (int i = 0; i < 4; ++i) {
      const int kk = k0 + ty + 8 * i, nn = n0 + tx;
      tile[(ty + 8 * i) * 33 + tx] = (nn < N) ? src[(size_t)kk * N + nn] : 0.f;
    }
    __syncthreads();
#pragma unroll
    for (int i = 0; i < 4; ++i) {
      const int nn = n0 + ty + 8 * i, kk = k0 + tx;
      dst[(size_t)nn * K + kk] = f2bf(tile[tx * 33 + ty + 8 * i]);
    }
    __syncthreads();
  }
}

__device__ void ph_mod(const Ctx cx, const Params& p, float* smem) {
  const int tid = cx.tid, lane = tid & 63, w = tid >> 6;
  float* sc = smem + w * (33 * 64);
  float* red = smem + 4 * 33 * 64;
  (void)red;
  for (int u = cx.bid; u < 2 * 96; u += gridDim.x) {
    const int layer = u / 96, n = (u % 96) * 64 + lane;
    const float* W = p.w_mod + (size_t)layer * D * 6144;
    float acc[33];
#pragma unroll
    for (int i = 0; i < 33; ++i) acc[i] = 0.f;
    for (int kc = 0; kc < 4; ++kc) {
      const int k0 = w * 256 + kc * 64;
      for (int cr = 0; cr < 33; ++cr) {
        const float v = (cr < 32) ? p.c[cr * D + k0 + lane] : p.c_ctx[k0 + lane];
        sc[cr * 64 + lane] = siluf_(v);
      }
      __syncthreads();
      for (int j = 0; j < 64; ++j) {
        const float wv = W[(size_t)(k0 + j) * 6144 + n];
#pragma unroll
        for (int cr = 0; cr < 33; ++cr) acc[cr] += sc[cr * 64 + j] * wv;
      }
      __syncthreads();
    }
#pragma unroll
    for (int cr = 0; cr < 33; ++cr) sc[cr * 64 + lane] = acc[cr];
    __syncthreads();
    if (w == 0) {
      const float bm = p.b_mod[layer * 6144 + n];
      for (int cr = 0; cr < 33; ++cr) {
        const float s = smem[cr * 64 + lane] + smem[33 * 64 + cr * 64 + lane] + smem[2 * 33 * 64 + cr * 64 + lane] + smem[3 * 33 * 64 + cr * 64 + lane];
        p.mod[((size_t)layer * 33 + cr) * 6144 + n] = s + bm;
      }
    }
    __syncthreads();
  }
}

__device__ void ph_prologue(const Ctx cx, const Params& p, float* smem) {
  ph_mod(cx, p, smem);
  convert_job(cx, p.ev_w_in, D, 3632, ZW, p.wt_in, smem);
  convert_job(cx, p.ev_w_out, D, D, D, p.wt_out, smem);
  for (int l = 0; l < 2; ++l) {
    convert_job(cx, p.ffn_w_up + (size_t)l * D * GUW, D, GUW, GUW, p.wt_up + (size_t)l * GUW * D, smem);
    convert_job(cx, p.ffn_w_down + (size_t)l * DFF * D, DFF, D, D, p.wt_down + (size_t)l * D * DFF, smem);
  }
  convert_job(cx, p.rw_w_rkv, D, D, D, p.wt_r, smem);
  convert_job(cx, p.rw_w_rkv + (size_t)D * D, D, D, D, p.wt_k, smem);
  convert_job(cx, p.rw_w_rkv + (size_t)2 * D * D, D, D, D, p.wt_v, smem);
  convert_job(cx, p.rw_w_o, D, D, D, p.wt_o, smem);
  convert_job(cx, p.rw_w1, D, 64, 64, p.wt_w1, smem);
  convert_job(cx, p.rw_w1 + D * 64, D, 64, 64, p.wt_w1 + 64 * D, smem);
  convert_job(cx, p.rw_a1, D, 64, 128, p.wt_a1, smem);
  convert_job(cx, p.rw_g1, D, 128, 128, p.wt_g1, smem);
  convert_job(cx, p.rw_w2, 64, D, D, p.wt_w2, smem);
  convert_job(cx, p.rw_w2 + 64 * D, 64, D, D, p.wt_w2 + D * 64, smem);
  convert_job(cx, p.rw_a2, 64, D, D, p.wt_a2, smem);
  convert_job(cx, p.rw_g2, 128, D, D, p.wt_g2, smem);
}

DI void rowinfo(int g, int row, int& b, int& pos) { const int bl = row / TPS; pos = row - bl * TPS; b = g * SPG + bl; }

__device__ void ph_norm0(const Ctx cx, const Params& p, int g) {
  const int lane = cx.tid & 63;
  const int gw = cx.bid * 4 + (cx.tid >> 6), nw = gridDim.x * 4;
  for (int row = gw; row < R; row += nw) {
    int b, pos; rowinfo(g, row, b, pos);
    const float* src = (pos < CTX) ? p.ctx + ((size_t)(b * CTX + pos)) * D : p.x + ((size_t)(b * SEQ + pos - CTX)) * D;
    const float* md = p.mod + ((size_t)(pos < CTX ? 32 : b)) * 6144;
    float4 v[4]; float ss = 0.f;
#pragma unroll
    for (int j = 0; j < 4; ++j) { v[j] = ((const float4*)src)[j * 64 + lane]; ss += v[j].x * v[j].x + v[j].y * v[j].y + v[j].z * v[j].z + v[j].w * v[j].w; }
    ss = wsum(ss);
    const float rstd = rsqrtf(ss * (1.f / D) + 1e-6f);
#pragma unroll
    for (int j = 0; j < 4; ++j) {
      const int col = j * 256 + lane * 4;
      const float4 gg = *(const float4*)(p.norm_g + col);
      const float4 sh = *(const float4*)(md + col), sc = *(const float4*)(md + D + col);
      uint2 o;
      o.x = pack2(v[j].x * rstd * gg.x * (1.f + sc.x) + sh.x, v[j].y * rstd * gg.y * (1.f + sc.y) + sh.y);
      o.y = pack2(v[j].z * rstd * gg.z * (1.f + sc.z) + sh.z, v[j].w * rstd * gg.w * (1.f + sc.w) + sh.w);
      *(uint2*)(p.H + (size_t)row * D + col) = o;
    }
  }
}

__device__ void ph_resid(const Ctx cx, const Params& p, int g, int layer, int which, bool lat_only) {
  const int lane = cx.tid & 63;
  const int gw = cx.bid * 4 + (cx.tid >> 6), nw = gridDim.x * 4;
  const bool from_inputs = (layer == 0 && which == 0);
  const bool has_next = (which == 0) || (layer + 1 < 2);
  const float* ga = p.norm_g + (layer * 4 + (which ? 3 : 1)) * D;
  const float* gb = (which == 0) ? p.norm_g + (layer * 4 + 2) * D : p.norm_g + ((layer + 1) * 4 + 0) * D;
  for (int row = gw; row < R; row += nw) {
    int b, pos; rowinfo(g, row, b, pos);
    if (lat_only && pos < CTX) continue;
    const size_t ridx = (pos < CTX) ? ((size_t)(b * CTX + pos)) * D : ((size_t)(b * SEQ + pos - CTX)) * D;
    const float* src = from_inputs ? ((pos < CTX) ? p.ctx + ridx : p.x + ridx) : ((pos < CTX) ? p.xc + ridx : p.out + ridx);
    float* dst = (pos < CTX) ? p.xc + ridx : p.out + ridx;
    const int cr = (pos < CTX) ? 32 : b;
    const float* md = p.mod + ((size_t)layer * 33 + cr) * 6144;
    const float* mdn = (which == 0) ? md + 3 * D : p.mod + ((size_t)(layer + 1) * 33 + cr) * 6144;
    const float* gate = md + (which ? 5 : 2) * D;
    const float* yo = p.YO + (size_t)row * D;
    float4 y[4], xv[4]; float ss = 0.f;
#pragma unroll
    for (int j = 0; j < 4; ++j) { y[j] = ((const float4*)yo)[j * 64 + lane]; xv[j] = ((const float4*)src)[j * 64 + lane]; ss += y[j].x * y[j].x + y[j].y * y[j].y + y[j].z * y[j].z + y[j].w * y[j].w; }
    ss = wsum(ss);
    const float rstd = rsqrtf(ss * (1.f / D) + 1e-6f);
    float s2 = 0.f;
#pragma unroll
    for (int j = 0; j < 4; ++j) {
      const int col = j * 256 + lane * 4;
      const float4 g4 = *(const float4*)(ga + col), gt = *(const float4*)(gate + col);
      xv[j].x += gt.x * (y[j].x * rstd * g4.x); xv[j].y += gt.y * (y[j].y * rstd * g4.y);
      xv[j].z += gt.z * (y[j].z * rstd * g4.z); xv[j].w += gt.w * (y[j].w * rstd * g4.w);
      ((float4*)dst)[j * 64 + lane] = xv[j];
      s2 += xv[j].x * xv[j].x + xv[j].y * xv[j].y + xv[j].z * xv[j].z + xv[j].w * xv[j].w;
    }
    if (has_next) {
      s2 = wsum(s2);
      const float r2 = rsqrtf(s2 * (1.f / D) + 1e-6f);
#pragma unroll
      for (int j = 0; j < 4; ++j) {
        const int col = j * 256 + lane * 4;
        const float4 gg = *(const float4*)(gb + col);
        const float4 sh = *(const float4*)(mdn + col), sc = *(const float4*)(mdn + D + col);
        uint2 o;
        o.x = pack2(xv[j].x * r2 * gg.x * (1.f + sc.x) + sh.x, xv[j].y * r2 * gg.y * (1.f + sc.y) + sh.y);
        o.y = pack2(xv[j].z * r2 * gg.z * (1.f + sc.z) + sh.z, xv[j].w * r2 * gg.w * (1.f + sc.w) + sh.w);
        *(uint2*)(p.H + (size_t)row * D + col) = o;
      }
    }
  }
}

struct ALoadPlain {
  const u16* A; int lda;
  DI void operator()(int row, int k, uint4& v0, uint4& v1) const {
    const uint4* q = (const uint4*)(A + (size_t)row * lda + k); v0 = q[0]; v1 = q[1];
  }
};
struct ALoadMix {
  const u16* Hh; const u16* XX; const float* mu;
  DI void operator()(int row, int k, uint4& v0, uint4& v1) const {
    const uint4* qh = (const uint4*)(Hh + (size_t)row * D + k);
    const uint4* qx = (const uint4*)(XX + (size_t)row * D + k);
    const uint4 h0 = qh[0], h1 = qh[1], x0 = qx[0], x1 = qx[1];
    float hf[16], xf[16];
    unpack8(h0, hf); unpack8(h1, hf + 8); unpack8(x0, xf); unpack8(x1, xf + 8);
#pragma unroll
    for (int i = 0; i < 16; ++i) hf[i] += xf[i] * mu[k + i];
    v0 = pack8(hf); v1 = pack8(hf + 8);
  }
};

template <class AL, class EP>
__device__ void gemm_phase(const Ctx cx, const AL& al, const u16* __restrict__ Bt, int K, int nnt, bool lat_only, const EP& ep, u16* smem) {
  const int tid = cx.tid, lane = tid & 63, w = tid >> 6, r = lane & 31, h = lane >> 5;
  const int wm = w >> 1, wn = w & 1;
  const int nmt = lat_only ? SPG * 16 : R / 128;
  const int ntiles = nmt * nnt;
  u16* sA = smem; u16* sB = smem + 2 * 128 * 40;
  const int lrow = tid >> 1, lk = (tid & 1) * 16;
  const int nk = K >> 5;
  for (int t = cx.bid; t < ntiles; t += gridDim.x) {
    const int mt = t / nnt, nt = t - mt * nnt;
    const int m0 = lat_only ? ((mt >> 4) * 18 + 2 + (mt & 15)) * 128 : mt * 128;
    const int n0 = nt * 128;
    f32x16 acc[2][2];
#pragma unroll
    for (int a = 0; a < 2; ++a)
#pragma unroll
      for (int b = 0; b < 2; ++b)
#pragma unroll
        for (int i = 0; i < 16; ++i) acc[a][b][i] = 0.f;
    uint4 a0, a1, b0, b1;
    const u16* bp = Bt + (size_t)(n0 + lrow) * K + lk;
    al(m0 + lrow, lk, a0, a1);
    b0 = *(const uint4*)bp; b1 = *(const uint4*)(bp + 8);
    *(uint4*)(sA + lrow * 40 + lk) = a0; *(uint4*)(sA + lrow * 40 + lk + 8) = a1;
    *(uint4*)(sB + lrow * 40 + lk) = b0; *(uint4*)(sB + lrow * 40 + lk + 8) = b1;
    __syncthreads();
    for (int kt = 0; kt < nk; ++kt) {
      const int cur = kt & 1;
      if (kt + 1 < nk) {
        al(m0 + lrow, (kt + 1) * 32 + lk, a0, a1);
        b0 = *(const uint4*)(bp + (kt + 1) * 32); b1 = *(const uint4*)(bp + (kt + 1) * 32 + 8);
      }
      const u16* cA = sA + cur * 128 * 40; const u16* cB = sB + cur * 128 * 40;
#pragma unroll
      for (int ks = 0; ks < 2; ++ks) {
        bf16x8 af[2], bfr[2];
#pragma unroll
        for (int mi = 0; mi < 2; ++mi) af[mi] = *(const bf16x8*)(cA + (64 * wm + 32 * mi + r) * 40 + 16 * ks + 8 * h);
#pragma unroll
        for (int ni = 0; ni < 2; ++ni) bfr[ni] = *(const bf16x8*)(cB + (64 * wn + 32 * ni + r) * 40 + 16 * ks + 8 * h);
#pragma unroll
        for (int mi = 0; mi < 2; ++mi)
#pragma unroll
          for (int ni = 0; ni < 2; ++ni) acc[mi][ni] = MFMA(af[mi], bfr[ni], acc[mi][ni]);
      }
      if (kt + 1 < nk) {
        u16* nA = sA + (cur ^ 1) * 128 * 40; u16* nB = sB + (cur ^ 1) * 128 * 40;
        *(uint4*)(nA + lrow * 40 + lk) = a0; *(uint4*)(nA + lrow * 40 + lk + 8) = a1;
        *(uint4*)(nB + lrow * 40 + lk) = b0; *(uint4*)(nB + lrow * 40 + lk + 8) = b1;
      }
      __syncthreads();
    }
#pragma unroll
    for (int mi = 0; mi < 2; ++mi)
#pragma unroll
      for (int ni = 0; ni < 2; ++ni)
#pragma unroll
        for (int i = 0; i < 16; ++i)
          ep(m0 + 64 * wm + 32 * mi + crow(i, h), n0 + 64 * wn + 32 * ni + r, acc[mi][ni][i]);
  }
}

struct EpBf16 { u16* dst; int ld; DI void operator()(int row, int col, float v) const { dst[(size_t)row * ld + col] = f2bf(v); } };
struct EpF32 { float* dst; int ld; DI void operator()(int row, int col, float v) const { dst[(size_t)row * ld + col] = v; } };
struct EpTanh { u16* dst; DI void operator()(int row, int col, float v) const { dst[(size_t)row * 128 + col] = f2bf(tanhf(v)); } };
struct EpSig128 { u16* dst; DI void operator()(int row, int col, float v) const { dst[(size_t)row * 128 + col] = f2bf(sigmoidf_(v)); } };
struct EpN64 { u16* dst; DI void operator()(int row, int col, float v) const { if (col < 64) dst[(size_t)row * 64 + col] = f2bf(v); } };
struct EpDecay {
  u16* dst; const float* w0;
  DI void operator()(int row, int col, float v) const {
    const float lw = v + w0[col];
    const float e = __expf(logsigf_(lw) - 0.5f);
    dst[(size_t)row * D + col] = f2bf(expm1f(-e));
  }
};
struct EpSigA { u16* dst; const float* a0; DI void operator()(int row, int col, float v) const { dst[(size_t)row * D + col] = f2bf(sigmoidf_(a0[col] + v)); } };

__device__ void ph_qkconv(const Ctx cx, const Params& p, int g) {
  const size_t total = (size_t)R * 128;
  for (size_t i = (size_t)cx.bid * NTHR + cx.tid; i < total; i += (size_t)gridDim.x * NTHR) {
    const int row = (int)(i >> 7), c0 = ((int)(i & 127)) * 8;
    int b, pos; rowinfo(g, row, b, pos);
    const bool hasp = (pos != 0 && pos != CTX), hasn = (pos != CTX - 1 && pos != TPS - 1);
    const u16* Z = p.BIG + (size_t)row * ZW + c0;
    float cur[8], pv[8], nx[8];
    unpack8(*(const uint4*)Z, cur);
    if (hasp) unpack8(*(const uint4*)(Z - ZW), pv); else { for (int e = 0; e < 8; ++e) pv[e] = 0.f; }
    if (hasn) unpack8(*(const uint4*)(Z + ZW), nx); else { for (int e = 0; e < 8; ++e) nx[e] = 0.f; }
    const float scale = (c0 < 512) ? 0.08838834764831845f : 1.f;
    float o[8];
#pragma unroll
    for (int e = 0; e < 8; ++e) {
      const int c = c0 + e;
      const float v = pv[e] * p.ev_conv_w[c] + cur[e] * p.ev_conv_w[D + c] + nx[e] * p.ev_conv_w[2 * D + c] + p.ev_conv_b[c];
      o[e] = siluf_(v) * scale;
    }
    *(uint4*)(p.QK + (size_t)row * D + c0) = pack8(o);
  }
}

__device__ void mlstm_item(const Ctx cx, const Params& p, int item, char* smem) {
  const int tid = cx.tid, lane = tid & 63, w = tid >> 6, r = lane & 31, h = lane >> 5;
  const int bl = item >> 3, head = (item >> 1) & 3, dir = item & 1;
  const int base = bl * TPS;
  u16* sQ = (u16*)smem;
  u16* sK = sQ + 32 * 136;
  u16* sVT = sK + 32 * 136;
  u16* sKT = sVT + 128 * 40;
  float* sU = (float*)(sKT + 128 * 40);
  float* sM = sU + 32; float* sBc = sM + 32; float* sLast = sBc + 32;
  float* sN = sLast + 32;
  float* sRD = sN + 128;
  float* sWI = sRD + 128;
  const u16* Z = p.BIG;
  u16* Y = p.BIG + (size_t)R * ZW + (size_t)dir * R * 512;
  const float bgi = p.ev_b_gates[(2 * dir) * 4 + head], bgf = p.ev_b_gates[(2 * dir + 1) * 4 + head];
  f32x16 cacc[4];
#pragma unroll
  for (int a = 0; a < 4; ++a)
#pragma unroll
    for (int i = 0; i < 16; ++i) cacc[a][i] = 0.f;
  if (tid < 128) sN[tid] = 0.f;
  float m = 0.f;
  const int lr = tid >> 3, lc = tid & 7;
  for (int ch = 0; ch < TPS / 32; ++ch) {
    const int p0 = ch * 32;
    __syncthreads();
    const int grow = scan_row(base, dir, p0 + lr);
    const uint4 q0 = *(const uint4*)(p.QK + (size_t)grow * D + head * 128 + lc * 8);
    const uint4 q1 = *(const uint4*)(p.QK + (size_t)grow * D + head * 128 + lc * 8 + 64);
    const uint4 k0 = *(const uint4*)(p.QK + (size_t)grow * D + 512 + head * 128 + lc * 8);
    const uint4 k1 = *(const uint4*)(p.QK + (size_t)grow * D + 512 + head * 128 + lc * 8 + 64);
    const uint4 v0 = *(const uint4*)(Z + (size_t)grow * ZW + 1024 + head * 128 + lc * 8);
    const uint4 v1 = *(const uint4*)(Z + (size_t)grow * ZW + 1024 + head * 128 + lc * 8 + 64);
    if (w == 0) {
      const int t = lane & 31;
      const int row = scan_row(base, dir, p0 + t);
      const float zi = bf2f(Z[(size_t)row * ZW + 2048 + (2 * dir) * 4 + head]) + bgi;
      const float zf = bf2f(Z[(size_t)row * ZW + 2048 + (2 * dir + 1) * 4 + head]) + bgf;
      float bsum = logsigf_(zf);
      for (int o = 1; o < 32; o <<= 1) { const float v = __shfl_up(bsum, o); if (t >= o) bsum += v; }
      const float u = zi - bsum;
      float pm = u;
      for (int o = 1; o < 32; o <<= 1) { const float v = __shfl_up(pm, o); if (t >= o) pm = fmaxf(pm, v); }
      const float M = fmaxf(m, pm);
      if (lane < 32) { sU[t] = u; sM[t] = M; sBc[t] = bsum; if (t == 31) { sLast[0] = M; sLast[1] = bsum; } }
    }
    __syncthreads();
    const float Mlast = sLast[0], blast = sLast[1];
    {
      const float ws = __expf(sU[lr] - Mlast);
      *(uint4*)(sQ + lr * 136 + lc * 8) = q0; *(uint4*)(sQ + lr * 136 + lc * 8 + 64) = q1;
      *(uint4*)(sK + lr * 136 + lc * 8) = k0; *(uint4*)(sK + lr * 136 + lc * 8 + 64) = k1;
      float f[8];
      unpack8(k0, f);
#pragma unroll
      for (int e = 0; e < 8; ++e) sKT[(lc * 8 + e) * 40 + lr] = f2bf(f[e] * ws);
      unpack8(k1, f);
#pragma unroll
      for (int e = 0; e < 8; ++e) sKT[(lc * 8 + 64 + e) * 40 + lr] = f2bf(f[e] * ws);
      const u16* pv0 = (const u16*)&v0; const u16* pv1 = (const u16*)&v1;
#pragma unroll
      for (int e = 0; e < 8; ++e) { sVT[(lc * 8 + e) * 40 + lr] = pv0[e]; sVT[(lc * 8 + 64 + e) * 40 + lr] = pv1[e]; }
    }
    __syncthreads();
    f32x16 st;
#pragma unroll
    for (int i = 0; i < 16; ++i) st[i] = 0.f;
#pragma unroll
    for (int ks = 0; ks < 8; ++ks) {
      const bf16x8 a = *(const bf16x8*)(sK + r * 136 + 16 * ks + 8 * h);
      const bf16x8 b = *(const bf16x8*)(sQ + r * 136 + 16 * ks + 8 * h);
      st = MFMA(a, b, st);
    }
    const float Mt = sM[r];
    float dsum = 0.f;
#pragma unroll
    for (int i = 0; i < 16; ++i) {
      const int s = crow(i, h);
      const float pv = (s <= r) ? st[i] * __expf(sU[s] - Mt) : 0.f;
      st[i] = pv; dsum += pv;
    }
    dsum += __shfl_xor(dsum, 32);
    float qn = 0.f;
#pragma unroll
    for (int d8 = 0; d8 < 8; ++d8) {
      float qf[8]; unpack8(*(const uint4*)(sQ + r * 136 + 64 * h + 8 * d8), qf);
#pragma unroll
      for (int e = 0; e < 8; ++e) qn += qf[e] * sN[64 * h + 8 * d8 + e];
    }
    qn += __shfl_xor(qn, 32);
    const float wi = __expf(m - Mt);
    const float den = dsum + wi * qn;
    const float dn = fmaxf(fabsf(den), __expf(-(sBc[r] + Mt)));
    if (h == 0) { sRD[w * 32 + r] = 1.f / dn; sWI[w * 32 + r] = wi; }
    __syncthreads();
    f32x16 o;
#pragma unroll
    for (int i = 0; i < 16; ++i) o[i] = 0.f;
#pragma unroll
    for (int mb = 0; mb < 4; ++mb)
#pragma unroll
      for (int s2 = 0; s2 < 2; ++s2) {
        const bf16x8 cb = pack_step(cacc[mb], s2);
        const u16* qp = sQ + r * 136 + 32 * mb + 16 * s2 + 4 * h;
        const bf16x8 a = cat4(*(const s16x4*)qp, *(const s16x4*)(qp + 8));
        o = MFMA(a, cb, o);
      }
#pragma unroll
    for (int i = 0; i < 16; ++i) o[i] *= sWI[w * 32 + crow(i, h)];
#pragma unroll
    for (int s2 = 0; s2 < 2; ++s2) {
      const bf16x8 a = pack_step(st, s2);
      const u16* vp = sVT + (32 * w + r) * 40 + 16 * s2 + 4 * h;
      const bf16x8 b = cat4(*(const s16x4*)vp, *(const s16x4*)(vp + 8));
      o = MFMA(a, b, o);
    }
#pragma unroll
    for (int i = 0; i < 16; ++i) {
      const int t = crow(i, h);
      const int row = scan_row(base, dir, p0 + t);
      Y[(size_t)row * 512 + head * 128 + 32 * w + r] = f2bf(o[i] * sRD[w * 32 + t]);
    }
    const float wp = __expf(m - Mlast);
#pragma unroll
    for (int mb = 0; mb < 4; ++mb) {
#pragma unroll
      for (int i = 0; i < 16; ++i) cacc[mb][i] *= wp;
#pragma unroll
      for (int s2 = 0; s2 < 2; ++s2) {
        const bf16x8 a = *(const bf16x8*)(sKT + (32 * mb + r) * 40 + 16 * s2 + 8 * h);
        const bf16x8 b = *(const bf16x8*)(sVT + (32 * w + r) * 40 + 16 * s2 + 8 * h);
        cacc[mb] = MFMA(a, b, cacc[mb]);
      }
    }
    __syncthreads();
    if (tid < 128) {
      float s = 0.f;
#pragma unroll
      for (int e = 0; e < 32; ++e) s += bf2f(sKT[tid * 40 + e]);
      sN[tid] = wp * sN[tid] + s;
    }
    m = blast + Mlast;
  }
}

__device__ void gla_item(const Ctx cx, const Params& p, int item, char* smem) {
  const int tid = cx.tid, lane = tid & 63, w = tid >> 6, r = lane & 31, h = lane >> 5;
  const int bl = item >> 3, head = (item >> 1) & 3, dir = item & 1;
  const int base = bl * TPS;
  u16* sQ = (u16*)smem;
  u16* sK = sQ + 32 * 72;
  u16* sKT = sK + 32 * 72;
  u16* sVT = sKT + 64 * 40;
  float* sLa = (float*)(sVT + 128 * 40);
  float* sW2 = sLa + 32 * 64;
  float* sBi = sW2 + 16 * 64;
  const u16* Z = p.BIG;
  u16* Y = p.BIG + (size_t)R * ZW + (size_t)(2 + dir) * R * 512;
  for (int i = tid; i < 16 * 64; i += NTHR) sW2[i] = p.ev_gla_w2[((size_t)dir * 16 + (i >> 6)) * 256 + head * 64 + (i & 63)];
  if (tid < 64) sBi[tid] = p.ev_gla_b[dir * 256 + head * 64 + tid];
  f32x16 sacc[2];
#pragma unroll
  for (int a = 0; a < 2; ++a)
#pragma unroll
    for (int i = 0; i < 16; ++i) sacc[a][i] = 0.f;
  const int lr = tid >> 3, lc = tid & 7;
  for (int ch = 0; ch < TPS / 32; ++ch) {
    const int p0 = ch * 32;
    __syncthreads();
    const int grow = scan_row(base, dir, p0 + lr);
    const u16* zr = Z + (size_t)grow * ZW;
    const uint4 gq = *(const uint4*)(zr + 2064 + head * 64 + lc * 8);
    const uint4 gk = *(const uint4*)(zr + 2320 + head * 64 + lc * 8);
    const uint4 v0 = *(const uint4*)(zr + 2576 + head * 128 + lc * 8);
    const uint4 v1 = *(const uint4*)(zr + 2576 + head * 128 + lc * 8 + 64);
    {
      float gl[16];
      unpack8(*(const uint4*)(zr + 3600 + dir * 16), gl); unpack8(*(const uint4*)(zr + 3600 + dir * 16 + 8), gl + 8);
#pragma unroll
      for (int e = 0; e < 8; ++e) {
        const int c = lc * 8 + e;
        float xv = sBi[c];
#pragma unroll
        for (int q = 0; q < 16; ++q) xv += gl[q] * sW2[q * 64 + c];
        sLa[lr * 64 + c] = logsigf_(xv) * (1.f / 16.f);
      }
    }
    __syncthreads();
    if (tid < 64) { float b = 0.f; for (int t = 0; t < 32; ++t) { b += sLa[t * 64 + tid]; sLa[t * 64 + tid] = b; } }
    __syncthreads();
    {
      float qf[8], kf[8], o[8];
      unpack8(gq, qf); unpack8(gk, kf);
#pragma unroll
      for (int e = 0; e < 8; ++e) { const float bb = sLa[lr * 64 + lc * 8 + e]; qf[e] *= 0.125f * __expf(bb); kf[e] *= __expf(-bb); }
      *(uint4*)(sQ + lr * 72 + lc * 8) = pack8(qf);
      *(uint4*)(sK + lr * 72 + lc * 8) = pack8(kf);
#pragma unroll
      for (int e = 0; e < 8; ++e) sKT[(lc * 8 + e) * 40 + lr] = f2bf(kf[e]);
      (void)o;
      const u16* pv0 = (const u16*)&v0; const u16* pv1 = (const u16*)&v1;
#pragma unroll
      for (int e = 0; e < 8; ++e) { sVT[(lc * 8 + e) * 40 + lr] = pv0[e]; sVT[(lc * 8 + 64 + e) * 40 + lr] = pv1[e]; }
    }
    __syncthreads();
    f32x16 st;
#pragma unroll
    for (int i = 0; i < 16; ++i) st[i] = 0.f;
#pragma unroll
    for (int ks = 0; ks < 4; ++ks) {
      const bf16x8 a = *(const bf16x8*)(sK + r * 72 + 16 * ks + 8 * h);
      const bf16x8 b = *(const bf16x8*)(sQ + r * 72 + 16 * ks + 8 * h);
      st = MFMA(a, b, st);
    }
#pragma unroll
    for (int i = 0; i < 16; ++i) { if (crow(i, h) > r) st[i] = 0.f; }
    f32x16 o;
#pragma unroll
    for (int i = 0; i < 16; ++i) o[i] = 0.f;
#pragma unroll
    for (int mb = 0; mb < 2; ++mb)
#pragma unroll
      for (int s2 = 0; s2 < 2; ++s2) {
        const bf16x8 cb = pack_step(sacc[mb], s2);
        const u16* qp = sQ + r * 72 + 32 * mb + 16 * s2 + 4 * h;
        const bf16x8 a = cat4(*(const s16x4*)qp, *(const s16x4*)(qp + 8));
        o = MFMA(a, cb, o);
      }
#pragma unroll
    for (int s2 = 0; s2 < 2; ++s2) {
      const bf16x8 a = pack_step(st, s2);
      const u16* vp = sVT + (32 * w + r) * 40 + 16 * s2 + 4 * h;
      const bf16x8 b = cat4(*(const s16x4*)vp, *(const s16x4*)(vp + 8));
      o = MFMA(a, b, o);
    }
#pragma unroll
    for (int i = 0; i < 16; ++i) {
      const int row = scan_row(base, dir, p0 + crow(i, h));
      Y[(size_t)row * 512 + head * 128 + 32 * w + r] = f2bf(o[i]);
    }
#pragma unroll
    for (int mb = 0; mb < 2; ++mb) {
#pragma unroll
      for (int s2 = 0; s2 < 2; ++s2) {
        const bf16x8 a = *(const bf16x8*)(sKT + (32 * mb + r) * 40 + 16 * s2 + 8 * h);
        const bf16x8 b = *(const bf16x8*)(sVT + (32 * w + r) * 40 + 16 * s2 + 8 * h);
        sacc[mb] = MFMA(a, b, sacc[mb]);
      }
#pragma unroll
      for (int i = 0; i < 16; ++i) sacc[mb][i] *= __expf(sLa[31 * 64 + 32 * mb + crow(i, h)]);
    }
  }
}

__device__ void ph_scan0(const Ctx cx, const Params& p, char* smem) {
  for (int it = cx.bid; it < 2 * SPG * 8; it += gridDim.x) {
    __syncthreads();
    if (it < SPG * 8) mlstm_item(cx, p, it, smem); else gla_item(cx, p, it - SPG * 8, smem);
  }
}

__device__ void ph_evout(const Ctx cx, const Params& p, int g) {
  const int lane = cx.tid & 63;
  const int gw = cx.bid * 4 + (cx.tid >> 6), nw = gridDim.x * 4;
  const u16* Yb = p.BIG + (size_t)R * ZW;
  for (int row = gw; row < R; row += nw) {
    const int c0 = lane * 16;
    const int part = c0 >> 9, cc = c0 & 511;
    const u16* yf = Yb + ((size_t)(2 * part) * R + row) * 512 + cc;
    const u16* yb = Yb + ((size_t)(2 * part + 1) * R + row) * 512 + cc;
    float a[16], b[16];
    unpack8(*(const uint4*)yf, a); unpack8(*(const uint4*)(yf + 8), a + 8);
    unpack8(*(const uint4*)yb, b); unpack8(*(const uint4*)(yb + 8), b + 8);
    float ss = 0.f;
#pragma unroll
    for (int e = 0; e < 16; ++e) { a[e] += b[e]; ss += a[e] * a[e]; }
    ss += __shfl_xor(ss, 1); ss += __shfl_xor(ss, 2); ss += __shfl_xor(ss, 4);
    const float rstd = rsqrtf(ss * (1.f / 128.f) + 1e-6f);
    const u16* zg = p.BIG + (size_t)row * ZW + (part ? 3088 : 1536) + cc;
    float gt[16];
    unpack8(*(const uint4*)zg, gt); unpack8(*(const uint4*)(zg + 8), gt + 8);
#pragma unroll
    for (int e = 0; e < 16; ++e) {
      const float gv = part ? siluf_(gt[e]) : sigmoidf_(gt[e]);
      a[e] = a[e] * rstd * p.ev_head_g[c0 + e] * gv;
    }
    *(uint4*)(p.H + (size_t)row * D + c0) = pack8(a);
    *(uint4*)(p.H + (size_t)row * D + c0 + 8) = pack8(a + 8);
  }
}

__device__ void ph_ffnact(const Ctx cx, const Params& p, int g, int layer, bool lat_only) {
  const float* cw = p.ffn_conv_w + (size_t)layer * 9 * DFF;
  const float* cb = p.ffn_conv_b + (size_t)layer * DFF;
  const size_t total = (size_t)R * 352;
  for (size_t i = (size_t)cx.bid * NTHR + cx.tid; i < total; i += (size_t)gridDim.x * NTHR) {
    const int row = (int)(i / 352), f0 = ((int)(i % 352)) * 8;
    int b, pos; rowinfo(g, row, b, pos);
    if (lat_only && pos < CTX) continue;
    float acc[8];
#pragma unroll
    for (int e = 0; e < 8; ++e) acc[e] = cb[f0 + e];
    u16* gu = p.BIG + (size_t)row * GUW;
    if (pos < CTX) {
#pragma unroll
      for (int dw = 0; dw < 3; ++dw) {
        const int pp = pos + dw - 1;
        if (pp < 0 || pp >= CTX) continue;
        float v[8]; unpack8(*(const uint4*)(gu + (ptrdiff_t)(dw - 1) * GUW + f0), v);
#pragma unroll
        for (int e = 0; e < 8; ++e) acc[e] += v[e] * cw[(3 + dw) * DFF + f0 + e];
      }
    } else {
      const int lp = pos - CTX, gr = lp >> 6, gc = lp & 63;
#pragma unroll
      for (int dh = 0; dh < 3; ++dh) {
        const int rr = gr + dh - 1;
        if (rr < 0 || rr >= 32) continue;
#pragma unroll
        for (int dw = 0; dw < 3; ++dw) {
          const int c2 = gc + dw - 1;
          if (c2 < 0 || c2 >= 64) continue;
          float v[8]; unpack8(*(const uint4*)(gu + (ptrdiff_t)((dh - 1) * 64 + (dw - 1)) * GUW + f0), v);
#pragma unroll
          for (int e = 0; e < 8; ++e) acc[e] += v[e] * cw[(dh * 3 + dw) * DFF + f0 + e];
        }
      }
    }
    float up[8]; unpack8(*(const uint4*)(gu + DFF + f0), up);
#pragma unroll
    for (int e = 0; e < 8; ++e) {
      const float xg = acc[e];
      const float t = tanhf(0.7978845608028654f * (xg + 0.044715f * xg * xg * xg));
      up[e] *= 0.5f * xg * (1.f + t);
    }
    *(uint4*)(gu + DFF + f0) = pack8(up);
  }
}

__device__ void ph_xx(const Ctx cx, const Params& p, int g) {
  const size_t total = (size_t)R * 128;
  for (size_t i = (size_t)cx.bid * NTHR + cx.tid; i < total; i += (size_t)gridDim.x * NTHR) {
    const int row = (int)(i >> 7), c0 = ((int)(i & 127)) * 8;
    int b, pos; rowinfo(g, row, b, pos);
    const int q = c0 >> 8;
    int off = 0; bool ok;
    if (pos < CTX) {
      if ((q & 1) == 0) { off = -1; ok = pos > 0; } else { off = 1; ok = pos < CTX - 1; }
    } else {
      const int lp = pos - CTX, gr = lp >> 6, gc = lp & 63;
      if (q == 0) { off = -1; ok = gc > 0; }
      else if (q == 1) { off = 1; ok = gc < 63; }
      else if (q == 2) { off = -64; ok = gr > 0; }
      else { off = 64; ok = gr < 31; }
    }
    float hc[8], hs[8];
    unpack8(*(const uint4*)(p.H + (size_t)row * D + c0), hc);
    if (ok) unpack8(*(const uint4*)(p.H + (size_t)(row + off) * D + c0), hs); else { for (int e = 0; e < 8; ++e) hs[e] = 0.f; }
#pragma unroll
    for (int e = 0; e < 8; ++e) hs[e] -= hc[e];
    *(uint4*)(p.QK + (size_t)row * D + c0) = pack8(hs);
  }
}

__device__ void ph_rwscan(const Ctx cx, const Params& p) {
  const int lane = cx.tid & 63, w = cx.tid >> 6;
  const int vq = lane >> 3, kq = lane & 7;
  const size_t RS = (size_t)R * D;
  const u16* Rb = p.BIG; const u16* Kb = p.BIG + RS; const u16* Vb = p.BIG + 2 * RS; const u16* Ab = p.BIG + 3 * RS;
  const int nblk = (SPG * 16 * 2) / 4;
  for (int bi = cx.bid; bi < nblk; bi += gridDim.x) {
    const int item = bi * 4 + w;
    const int bl = item >> 5, head = (item >> 1) & 15, dir = item & 1;
    u16* Wb = p.BIG + (size_t)(4 + dir) * RS;
    const int base = bl * TPS;
    const int colk = head * 64 + kq * 8, colv = head * 64 + vq * 8;
    float kv0[8], kv1[8];
#pragma unroll
    for (int e = 0; e < 8; ++e) { kv0[e] = p.rw_kvec[colk + e]; kv1[e] = p.rw_kvec[D + colk + e]; }
    float S[8][8];
#pragma unroll
    for (int i = 0; i < 8; ++i)
#pragma unroll
      for (int e = 0; e < 8; ++e) S[i][e] = 0.f;
    int row = scan_row(base, dir, 0);
    uint4 nr = *(const uint4*)(Rb + (size_t)row * D + colk), nk_ = *(const uint4*)(Kb + (size_t)row * D + colk),
          na = *(const uint4*)(Ab + (size_t)row * D + colk), nwv = *(const uint4*)(Wb + (size_t)row * D + colk),
          nv = *(const uint4*)(Vb + (size_t)row * D + colv);
    for (int ps = 0; ps < TPS; ++ps) {
      const uint4 cr_ = nr, ck = nk_, ca = na, cw = nwv, cv = nv;
      const int crow_ = row;
      if (ps + 1 < TPS) {
        row = scan_row(base, dir, ps + 1);
        nr = *(const uint4*)(Rb + (size_t)row * D + colk); nk_ = *(const uint4*)(Kb + (size_t)row * D + colk);
        na = *(const uint4*)(Ab + (size_t)row * D + colk); nwv = *(const uint4*)(Wb + (size_t)row * D + colk);
        nv = *(const uint4*)(Vb + (size_t)row * D + colv);
      }
      float rr[8], kk[8], aa[8], wm1[8], vv[8], kka[8], km[8];
      unpack8(cr_, rr); unpack8(ck, kk); unpack8(ca, aa); unpack8(cw, wm1); unpack8(cv, vv);
      float ss = 0.f;
#pragma unroll
      for (int e = 0; e < 8; ++e) {
        km[e] = kk[e] * (1.f + (aa[e] - 1.f) * kv1[e]);
        kk[e] *= kv0[e]; ss += kk[e] * kk[e];
      }
      ss = red8(ss);
      const float inv = 1.f / fmaxf(sqrtf(ss), 1e-12f);
#pragma unroll
      for (int e = 0; e < 8; ++e) { kk[e] *= inv; kka[e] = kk[e] * aa[e]; }
      float sa[8];
#pragma unroll
      for (int i = 0; i < 8; ++i) {
        float s = 0.f;
#pragma unroll
        for (int e = 0; e < 8; ++e) s += S[i][e] * kk[e];
        sa[i] = -red8(s);
      }
      float y[8];
#pragma unroll
      for (int i = 0; i < 8; ++i) {
        float s = 0.f;
#pragma unroll
        for (int e = 0; e < 8; ++e) {
          float t = S[i][e] + S[i][e] * wm1[e];
          t += sa[i] * kka[e];
          t += vv[i] * km[e];
          S[i][e] = t;
          s += t * rr[e];
        }
        y[i] = red8(s);
      }
      if (kq == 0) *(uint4*)(Wb + (size_t)crow_ * D + colv) = pack8(y);
    }
  }
}

__device__ void ph_rwout(const Ctx cx, const Params& p, int g) {
  const int lane = cx.tid & 63;
  const int gw = cx.bid * 4 + (cx.tid >> 6), nw = gridDim.x * 4;
  const size_t RS = (size_t)R * D;
  for (int row = gw; row < R; row += nw) {
    int b, pos; rowinfo(g, row, b, pos);
    if (pos < CTX) continue;
    const int c0 = lane * 16;
    const size_t o = (size_t)row * D + c0;
    float yf[16], yb[16], rr[16], kk[16], vv[16], aa[16], gg[16];
    unpack8(*(const uint4*)(p.BIG + 4 * RS + o), yf); unpack8(*(const uint4*)(p.BIG + 4 * RS + o + 8), yf + 8);
    unpack8(*(const uint4*)(p.BIG + 5 * RS + o), yb); unpack8(*(const uint4*)(p.BIG + 5 * RS + o + 8), yb + 8);
    unpack8(*(const uint4*)(p.BIG + o), rr); unpack8(*(const uint4*)(p.BIG + o + 8), rr + 8);
    unpack8(*(const uint4*)(p.BIG + RS + o), kk); unpack8(*(const uint4*)(p.BIG + RS + o + 8), kk + 8);
    unpack8(*(const uint4*)(p.BIG + 2 * RS + o), vv); unpack8(*(const uint4*)(p.BIG + 2 * RS + o + 8), vv + 8);
    unpack8(*(const uint4*)(p.BIG + 3 * RS + o), aa); unpack8(*(const uint4*)(p.BIG + 3 * RS + o + 8), aa + 8);
    unpack8(*(const uint4*)(p.QK + o), gg); unpack8(*(const uint4*)(p.QK + o + 8), gg + 8);
    float s1 = 0.f, bon = 0.f;
#pragma unroll
    for (int e = 0; e < 16; ++e) {
      yf[e] += yb[e]; s1 += yf[e];
      const float km = kk[e] * (1.f + (aa[e] - 1.f) * p.rw_kvec[D + c0 + e]);
      bon += rr[e] * km * p.rw_kvec[2 * D + c0 + e];
    }
    s1 += __shfl_xor(s1, 1); s1 += __shfl_xor(s1, 2);
    bon += __shfl_xor(bon, 1); bon += __shfl_xor(bon, 2);
    const float mu = s1 * (1.f / 64.f);
    float s2 = 0.f;
#pragma unroll
    for (int e = 0; e < 16; ++e) { const float d = yf[e] - mu; s2 += d * d; }
    s2 += __shfl_xor(s2, 1); s2 += __shfl_xor(s2, 2);
    const float rstd = rsqrtf(s2 * (1.f / 64.f) + 64e-5f);
#pragma unroll
    for (int e = 0; e < 16; ++e) {
      const float yn = (yf[e] - mu) * rstd * p.rw_lnx[c0 + e] + p.rw_lnx[D + c0 + e];
      yf[e] = (yn + bon * vv[e]) * gg[e];
    }
    *(uint4*)(p.H + o) = pack8(yf);
    *(uint4*)(p.H + o + 8) = pack8(yf + 8);
  }
}

__global__ void __launch_bounds__(NTHR) fwd_megakernel(Params p) {
  cg::grid_group grid = cg::this_grid();
  __shared__ __attribute__((aligned(16))) char smem[49152];
  u16* sm16 = (u16*)smem;
  const size_t RS = (size_t)R * D;

  {
    Ctx cx; cx.tid = threadIdx.x; cx.bid = blockIdx.x;
    ph_prologue(cx, p, (float*)smem);
  }
  grid.sync();
#pragma nounroll
  for (int it = 0; it < NG * 22; ++it) {
    const int g = it / 22, ph = it - g * 22;
    Ctx cx;
    { int t_ = threadIdx.x, b_ = blockIdx.x; asm volatile("" : "+v"(t_), "+s"(b_)); cx.tid = t_; cx.bid = b_; }
    switch (ph) {
      case 0: ph_norm0(cx, p, g); break;
      case 1: gemm_phase(cx, ALoadPlain{p.H, D}, p.wt_in, D, ZW / 128, false, EpBf16{p.BIG, ZW}, sm16); break;
      case 2: ph_qkconv(cx, p, g); break;
      case 3: ph_scan0(cx, p, smem); break;
      case 4: ph_evout(cx, p, g); break;
      case 5: gemm_phase(cx, ALoadPlain{p.H, D}, p.wt_out, D, 8, false, EpF32{p.YO, D}, sm16); break;
      case 6: ph_resid(cx, p, g, 0, 0, false); break;
      case 7: gemm_phase(cx, ALoadPlain{p.H, D}, p.wt_up, D, GUW / 128, false, EpBf16{p.BIG, GUW}, sm16); break;
      case 8: ph_ffnact(cx, p, g, 0, false); break;
      case 9: gemm_phase(cx, ALoadPlain{p.BIG + DFF, GUW}, p.wt_down, DFF, 8, false, EpF32{p.YO, D}, sm16); break;
      case 10: ph_resid(cx, p, g, 0, 1, false); break;
      case 11: ph_xx(cx, p, g); break;
      case 12:
        gemm_phase(cx, ALoadMix{p.H, p.QK, p.rw_mu + 0 * D}, p.wt_r, D, 8, false, EpBf16{p.BIG, D}, sm16);
        gemm_phase(cx, ALoadMix{p.H, p.QK, p.rw_mu + 2 * D}, p.wt_k, D, 8, false, EpBf16{p.BIG + RS, D}, sm16);
        gemm_phase(cx, ALoadMix{p.H, p.QK, p.rw_mu + 3 * D}, p.wt_v, D, 8, false, EpBf16{p.BIG + 2 * RS, D}, sm16);
        gemm_phase(cx, ALoadMix{p.H, p.QK, p.rw_mu + 1 * D}, p.wt_w1, D, 1, false, EpTanh{p.LRW}, sm16);
        gemm_phase(cx, ALoadMix{p.H, p.QK, p.rw_mu + 4 * D}, p.wt_a1, D, 1, false, EpN64{p.LRA}, sm16);
        gemm_phase(cx, ALoadMix{p.H, p.QK, p.rw_mu + 5 * D}, p.wt_g1, D, 1, false, EpSig128{p.LRG}, sm16);
        break;
      case 13:
        gemm_phase(cx, ALoadPlain{p.LRW, 128}, p.wt_w2, 64, 8, false, EpDecay{p.BIG + 4 * RS, p.rw_w0}, sm16);
        gemm_phase(cx, ALoadPlain{p.LRW + 64, 128}, p.wt_w2 + D * 64, 64, 8, false, EpDecay{p.BIG + 5 * RS, p.rw_w0 + D}, sm16);
        gemm_phase(cx, ALoadPlain{p.LRA, 64}, p.wt_a2, 64, 8, false, EpSigA{p.BIG + 3 * RS, p.rw_a0}, sm16);
        gemm_phase(cx, ALoadPlain{p.LRG, 128}, p.wt_g2, 128, 8, false, EpBf16{p.QK, D}, sm16);
        break;
      case 14: ph_rwscan(cx, p); break;
      case 15: ph_rwout(cx, p, g); break;
      case 16: gemm_phase(cx, ALoadPlain{p.H, D}, p.wt_o, D, 8, true, EpF32{p.YO, D}, sm16); break;
      case 17: ph_resid(cx, p, g, 1, 0, true); break;
      case 18: gemm_phase(cx, ALoadPlain{p.H, D}, p.wt_up + (size_t)GUW * D, D, GUW / 128, true, EpBf16{p.BIG, GUW}, sm16); break;
      case 19: ph_ffnact(cx, p, g, 1, true); break;
      case 20: gemm_phase(cx, ALoadPlain{p.BIG + DFF, GUW}, p.wt_down + (size_t)D * DFF, DFF, 8, true, EpF32{p.YO, D}, sm16); break;
      default: ph_resid(cx, p, g, 1, 1, true); break;
    }
    grid.sync();
  }
}

extern "C" void kernel_launch(void* const* d_in, const int* in_sizes, int n_in, void* d_out, int out_size, void* d_ws,
                              size_t ws_size, hipStream_t stream) {
  static int grid_blocks = 0;
  if (!grid_blocks) {
    int dev = 0, cus = 0, per_cu = 0;
    hipGetDevice(&dev);
    hipDeviceGetAttribute(&cus, hipDeviceAttributeMultiprocessorCount, dev);
    hipOccupancyMaxActiveBlocksPerMultiprocessor(&per_cu, fwd_megakernel, NTHR, 0);
    if (per_cu > 2) per_cu = 2;
    if (per_cu < 1) per_cu = 1;
    grid_blocks = cus * per_cu;
  }
  Params p{};
  const float** f = (const float**)&p;
  for (int i = 0; i < 32; ++i) f[i] = (const float*)d_in[i];
  p.out = (float*)d_out;
  char* ws = (char*)d_ws;
  size_t off = 0;
  auto take = [&](size_t bytes) { char* q = ws + off; off += (bytes + 255) & ~(size_t)255; return q; };
  p.wt_in = (u16*)take((size_t)ZW * D * 2);
  p.wt_out = (u16*)take((size_t)D * D * 2);
  p.wt_up = (u16*)take((size_t)2 * GUW * D * 2);
  p.wt_down = (u16*)take((size_t)2 * D * DFF * 2);
  p.wt_r = (u16*)take((size_t)D * D * 2);
  p.wt_k = (u16*)take((size_t)D * D * 2);
  p.wt_v = (u16*)take((size_t)D * D * 2);
  p.wt_o = (u16*)take((size_t)D * D * 2);
  p.wt_w1 = (u16*)take((size_t)128 * D * 2);
  p.wt_a1 = (u16*)take((size_t)128 * D * 2);
  p.wt_g1 = (u16*)take((size_t)128 * D * 2);
  p.wt_w2 = (u16*)take((size_t)2 * D * 64 * 2);
  p.wt_a2 = (u16*)take((size_t)D * 64 * 2);
  p.wt_g2 = (u16*)take((size_t)D * 128 * 2);
  p.mod = (float*)take((size_t)2 * 33 * 6144 * 4);
  p.xc = (float*)take((size_t)NB * CTX * D * 4);
  p.H = (u16*)take((size_t)R * D * 2);
  p.BIG = (u16*)take((size_t)6 * R * D * 2);
  p.QK = (u16*)take((size_t)R * D * 2);
  p.YO = (float*)take((size_t)R * D * 4);
  p.LRW = (u16*)take((size_t)R * 128 * 2);
  p.LRA = (u16*)take((size_t)R * 64 * 2);
  p.LRG = (u16*)take((size_t)R * 128 * 2);
  if (off > ws_size) { fprintf(stderr, "workspace too small: need %zu have %zu\n", off, ws_size); return; }
  void* args[] = {&p};
  hipError_t e = hipLaunchCooperativeKernel((void*)fwd_megakernel, dim3(grid_blocks), dim3(NTHR), args, 0, stream);
  if (e != hipSuccess) fprintf(stderr, "cooperative launch failed: %s (grid %d)\n", hipGetErrorString(e), grid_blocks);
}
```

```cpp
#include <hip/hip_runtime.h>
#include <hip/hip_cooperative_groups.h>
#include <cstdio>
namespace cg = cooperative_groups;

typedef unsigned short u16;
using bf16x8 = __attribute__((ext_vector_type(8))) short;
using s16x4  = __attribute__((ext_vector_type(4))) short;
using f32x16 = __attribute__((ext_vector_type(16))) float;
#define DI __device__ __forceinline__
#define MFMA(a, b, c) __builtin_amdgcn_mfma_f32_32x32x16_bf16((a), (b), (c), 0, 0, 0)

constexpr int D = 1024, NB = 32, SEQ = 2048, CTX = 256, TPS = 2304;
constexpr int NG = 2, SPG = 16, R = SPG * TPS;
constexpr int ZW = 3840;
constexpr int DFF = 2816, GUW = 5632;
constexpr int NTHR = 512, NWV = NTHR / 64;
constexpr int N1 = 3584, K1 = 2048, N2 = 4096, K2 = 320;
#ifndef PROBE_MASK_V
#define PROBE_MASK_V 0u
#endif
constexpr unsigned PROBE_MASK = PROBE_MASK_V;

struct Ctx { int tid, bid; };
struct Params {
  const float *x, *c, *ctx, *c_ctx, *w_mod, *b_mod, *norm_g, *ffn_w_up, *ffn_conv_w, *ffn_conv_b, *ffn_w_down,
      *ev_w_in, *ev_b_gates, *ev_conv_w, *ev_conv_b, *ev_gla_w2, *ev_gla_b, *ev_head_g, *ev_w_out,
      *rw_mu, *rw_w_rkv, *rw_w_o, *rw_w0, *rw_w1, *rw_w2, *rw_a0, *rw_a1, *rw_a2, *rw_g1, *rw_g2, *rw_kvec, *rw_lnx;
  float* out;
  u16 *wt_in, *wt_out, *wt_up, *wt_down, *wt_o, *wt_1, *wt_2;
  float* mod; float* xc;
  u16* H; u16* BIG; u16* QK; float* YO; u16* LR;
};

typedef const __attribute__((address_space(4))) Params CParams;

DI float bf2f(u16 v) { return __uint_as_float(((unsigned)v) << 16); }
DI u16 f2bf(float f) { unsigned u = __float_as_uint(f); u += 0x7fffu + ((u >> 16) & 1u); return (u16)(u >> 16); }
DI unsigned pack2(float a, float b) { return (unsigned)f2bf(a) | (((unsigned)f2bf(b)) << 16); }
DI float lo16(unsigned u) { return __uint_as_float(u << 16); }
DI float hi16(unsigned u) { return __uint_as_float(u & 0xffff0000u); }
DI void unpack8(const uint4& v, float* o) {
  o[0] = lo16(v.x); o[1] = hi16(v.x); o[2] = lo16(v.y); o[3] = hi16(v.y);
  o[4] = lo16(v.z); o[5] = hi16(v.z); o[6] = lo16(v.w); o[7] = hi16(v.w);
}
DI uint4 pack8(const float* o) { uint4 v; v.x = pack2(o[0], o[1]); v.y = pack2(o[2], o[3]); v.z = pack2(o[4], o[5]); v.w = pack2(o[6], o[7]); return v; }
DI int crow(int reg, int h) { return (reg & 3) + 8 * (reg >> 2) + 4 * h; }
DI float wsum(float v) { for (int o = 32; o; o >>= 1) v += __shfl_xor(v, o); return v; }
DI float sigmoidf_(float x) { return 1.f / (1.f + __expf(-x)); }
DI float logsigf_(float x) { return fminf(x, 0.f) - log1pf(__expf(-fabsf(x))); }
DI float siluf_(float x) { return x / (1.f + __expf(-x)); }
DI bf16x8 cat4(s16x4 lo, s16x4 hi) { return __builtin_shufflevector(lo, hi, 0, 1, 2, 3, 4, 5, 6, 7); }
DI bf16x8 pack_step(const f32x16& x, int s) {
  uint4 v;
  v.x = pack2(x[8 * s + 0], x[8 * s + 1]); v.y = pack2(x[8 * s + 2], x[8 * s + 3]);
  v.z = pack2(x[8 * s + 4], x[8 * s + 5]); v.w = pack2(x[8 * s + 6], x[8 * s + 7]);
  return __builtin_bit_cast(bf16x8, v);
}
DI float dppf(float x, int) { return x; }
#define DPP_F(x, ctrl) __int_as_float(__builtin_amdgcn_update_dpp(0, __float_as_int(x), (ctrl), 0xF, 0xF, true))
DI float red8(float x) {
  x += DPP_F(x, 0x141);
  x += DPP_F(x, 0xB1);
  x += DPP_F(x, 0x4E);
  return x;
}

DI int scan_row(int base, int dir, int p) {
  if (dir == 0) return base + p;
  return (p < CTX) ? base + (CTX - 1 - p) : base + (TPS + CTX - 1 - p);
}

__device__ __forceinline__ void convert_job(const Ctx cx, const float* __restrict__ src, int K, int N, int Npad, u16* __restrict__ dst, int ldd, const float* __restrict__ mu, float* tile) {
  const int tx = cx.tid & 31, ty = cx.tid >> 5;
  const int tk = K >> 5, tn = Npad >> 5;
  for (int t = cx.bid; t < tk * tn; t += gridDim.x) {
    const int k0 = (t / tn) * 32, n0 = (t % tn) * 32;
#pragma unroll
    for (int i = 0; i < 2; ++i) {
      const int kk = k0 + ty + 16 * i, nn = n0 + tx;
      float v = (nn < N) ? src[(size_t)kk * N + nn] : 0.f;
      if (mu) v *= mu[kk];
      tile[(ty + 16 * i) * 33 + tx] = v;
    }
    __syncthreads();
#pragma unroll
    for (int i = 0; i < 2; ++i) {
      const int nn = n0 + ty + 16 * i, kk = k0 + tx;
      dst[(size_t)nn * ldd + kk] = f2bf(tile[tx * 33 + ty + 16 * i]);
    }
    __syncthreads();
  }
}

__device__ __forceinline__ void ph_mod(const Ctx cx, CParams& p, float* smem) {
  const int tid = cx.tid, lane = tid & 63, w = tid >> 6;
  float* sc = smem + w * (33 * 64);
  for (int u = cx.bid; u < 2 * 96; u += gridDim.x) {
    const int layer = u / 96, n = (u % 96) * 64 + lane;
    const float* W = p.w_mod + (size_t)layer * D * 6144;
    float acc[33];
#pragma unroll
    for (int i = 0; i < 33; ++i) acc[i] = 0.f;
    for (int kc = 0; kc < 2; ++kc) {
      const int k0 = w * 128 + kc * 64;
#pragma nounroll
      for (int cr = 0; cr < 33; ++cr) {
        const float v = (cr < 32) ? p.c[cr * D + k0 + lane] : p.c_ctx[k0 + lane];
        sc[cr * 64 + lane] = siluf_(v);
      }
      __syncthreads();
#pragma unroll 2
      for (int j = 0; j < 64; ++j) {
        const float wv = W[(size_t)(k0 + j) * 6144 + n];
#pragma unroll
        for (int cr = 0; cr < 33; ++cr) acc[cr] += sc[cr * 64 + j] * wv;
      }
      __syncthreads();
    }
#pragma unroll
    for (int cr = 0; cr < 33; ++cr) sc[cr * 64 + lane] = acc[cr];
    __syncthreads();
    if (w == 0) {
      const float bm = p.b_mod[layer * 6144 + n];
      for (int cr = 0; cr < 33; ++cr) {
        float s = 0.f;
#pragma unroll
        for (int q = 0; q < NWV; ++q) s += smem[q * 33 * 64 + cr * 64 + lane];
        p.mod[((size_t)layer * 33 + cr) * 6144 + n] = s + bm;
      }
    }
    __syncthreads();
  }
}

__device__ __forceinline__ void ph_prologue(const Ctx cx, CParams& p, float* smem) {
  ph_mod(cx, p, smem);
  convert_job(cx, p.ev_w_in, D, 3632, ZW, p.wt_in, D, nullptr, smem);
  convert_job(cx, p.ev_w_out, D, D, D, p.wt_out, D, nullptr, smem);
  for (int l = 0; l < 2; ++l) {
    convert_job(cx, p.ffn_w_up + (size_t)l * D * GUW, D, GUW, GUW, p.wt_up + (size_t)l * GUW * D, D, nullptr, smem);
    convert_job(cx, p.ffn_w_down + (size_t)l * DFF * D, DFF, D, D, p.wt_down + (size_t)l * D * DFF, DFF, nullptr, smem);
  }
  convert_job(cx, p.rw_w_o, D, D, D, p.wt_o, D, nullptr, smem);
  for (int half = 0; half < 2; ++half) {
    u16* dcol = p.wt_1 + half * D;
    const float* m0 = half ? p.rw_mu : nullptr;
    convert_job(cx, p.rw_w_rkv, D, D, D, dcol, K1, half ? m0 + 0 * D : nullptr, smem);
    convert_job(cx, p.rw_w_rkv + (size_t)D * D, D, D, D, dcol + (size_t)1024 * K1, K1, half ? m0 + 2 * D : nullptr, smem);
    convert_job(cx, p.rw_w_rkv + (size_t)2 * D * D, D, D, D, dcol + (size_t)2048 * K1, K1, half ? m0 + 3 * D : nullptr, smem);
    convert_job(cx, p.rw_w1, D, 64, 64, dcol + (size_t)3072 * K1, K1, half ? m0 + 1 * D : nullptr, smem);
    convert_job(cx, p.rw_w1 + D * 64, D, 64, 64, dcol + (size_t)3136 * K1, K1, half ? m0 + 1 * D : nullptr, smem);
    convert_job(cx, p.rw_a1, D, 64, 64, dcol + (size_t)3200 * K1, K1, half ? m0 + 4 * D : nullptr, smem);
    convert_job(cx, p.rw_g1, D, 128, 320, dcol + (size_t)3264 * K1, K1, half ? m0 + 5 * D : nullptr, smem);
  }
  for (size_t i = (size_t)cx.bid * NTHR + cx.tid; i < (size_t)N2 * K2; i += (size_t)gridDim.x * NTHR) {
    const int n = (int)(i / K2), c = (int)(i % K2), blk = n >> 10, nn = n & 1023;
    float v = 0.f;
    if (blk == 0) { if (c < 64) v = p.rw_w2[(size_t)c * D + nn]; }
    else if (blk == 1) { if (c >= 64 && c < 128) v = p.rw_w2[(size_t)(64 + c - 64) * D + nn]; }
    else if (blk == 2) { if (c >= 128 && c < 192) v = p.rw_a2[(size_t)(c - 128) * D + nn]; }
    else { if (c >= 192) v = p.rw_g2[(size_t)(c - 192) * D + nn]; }
    p.wt_2[i] = f2bf(v);
  }
}

DI void rowinfo(int g, int row, int& b, int& pos) { const int bl = row / TPS; pos = row - bl * TPS; b = g * SPG + bl; }

__device__ __forceinline__ void ph_norm0(const Ctx cx, CParams& p, int g) {
  const int lane = cx.tid & 63;
  const int gw = cx.bid * NWV + (cx.tid >> 6), nw = gridDim.x * NWV;
  for (int row = gw; row < R; row += nw) {
    int b, pos; rowinfo(g, row, b, pos);
    const float* src = (pos < CTX) ? p.ctx + ((size_t)(b * CTX + pos)) * D : p.x + ((size_t)(b * SEQ + pos - CTX)) * D;
    const float* md = p.mod + ((size_t)(pos < CTX ? 32 : b)) * 6144;
    float4 v[4]; float ss = 0.f;
#pragma unroll
    for (int j = 0; j < 4; ++j) { v[j] = ((const float4*)src)[j * 64 + lane]; ss += v[j].x * v[j].x + v[j].y * v[j].y + v[j].z * v[j].z + v[j].w * v[j].w; }
    ss = wsum(ss);
    const float rstd = rsqrtf(ss * (1.f / D) + 1e-6f);
#pragma unroll
    for (int j = 0; j < 4; ++j) {
      const int col = j * 256 + lane * 4;
      const float4 gg = *(const float4*)(p.norm_g + col);
      const float4 sh = *(const float4*)(md + col), sc = *(const float4*)(md + D + col);
      uint2 o;
      o.x = pack2(v[j].x * rstd * gg.x * (1.f + sc.x) + sh.x, v[j].y * rstd * gg.y * (1.f + sc.y) + sh.y);
      o.y = pack2(v[j].z * rstd * gg.z * (1.f + sc.z) + sh.z, v[j].w * rstd * gg.w * (1.f + sc.w) + sh.w);
      *(uint2*)(p.H + (size_t)row * D + col) = o;
    }
  }
}

__device__ __forceinline__ void ph_resid(const Ctx cx, CParams& p, int g, int layer, int which, bool lat_only) {
  const int lane = cx.tid & 63;
  const int gw = cx.bid * NWV + (cx.tid >> 6), nw = gridDim.x * NWV;
  const bool from_inputs = (layer == 0 && which == 0);
  const bool has_next = (which == 0) || (layer + 1 < 2);
  const float* ga = p.norm_g + (layer * 4 + (which ? 3 : 1)) * D;
  const float* gb = (which == 0) ? p.norm_g + (layer * 4 + 2) * D : p.norm_g + ((layer + 1) * 4 + 0) * D;
  for (int row = gw; row < R; row += nw) {
    int b, pos; rowinfo(g, row, b, pos);
    if (lat_only && pos < CTX) continue;
    const size_t ridx = (pos < CTX) ? ((size_t)(b * CTX + pos)) * D : ((size_t)(b * SEQ + pos - CTX)) * D;
    const float* src = from_inputs ? ((pos < CTX) ? p.ctx + ridx : p.x + ridx) : ((pos < CTX) ? p.xc + ridx : p.out + ridx);
    float* dst = (pos < CTX) ? p.xc + ridx : p.out + ridx;
    const int cr = (pos < CTX) ? 32 : b;
    const float* md = p.mod + ((size_t)layer * 33 + cr) * 6144;
    const float* mdn = (which == 0) ? md + 3 * D : p.mod + ((size_t)(layer + 1) * 33 + cr) * 6144;
    const float* gate = md + (which ? 5 : 2) * D;
    const float* yo = p.YO + (size_t)row * D;
    float4 y[4], xv[4]; float ss = 0.f;
#pragma unroll
    for (int j = 0; j < 4; ++j) { y[j] = ((const float4*)yo)[j * 64 + lane]; xv[j] = ((const float4*)src)[j * 64 + lane]; ss += y[j].x * y[j].x + y[j].y * y[j].y + y[j].z * y[j].z + y[j].w * y[j].w; }
    ss = wsum(ss);
    const float rstd = rsqrtf(ss * (1.f / D) + 1e-6f);
    float s2 = 0.f;
#pragma unroll
    for (int j = 0; j < 4; ++j) {
      const int col = j * 256 + lane * 4;
      const float4 g4 = *(const float4*)(ga + col), gt = *(const float4*)(gate + col);
      xv[j].x += gt.x * (y[j].x * rstd * g4.x); xv[j].y += gt.y * (y[j].y * rstd * g4.y);
      xv[j].z += gt.z * (y[j].z * rstd * g4.z); xv[j].w += gt.w * (y[j].w * rstd * g4.w);
      ((float4*)dst)[j * 64 + lane] = xv[j];
      s2 += xv[j].x * xv[j].x + xv[j].y * xv[j].y + xv[j].z * xv[j].z + xv[j].w * xv[j].w;
    }
    if (has_next) {
      s2 = wsum(s2);
      const float r2 = rsqrtf(s2 * (1.f / D) + 1e-6f);
#pragma unroll
      for (int j = 0; j < 4; ++j) {
        const int col = j * 256 + lane * 4;
        const float4 gg = *(const float4*)(gb + col);
        const float4 sh = *(const float4*)(mdn + col), sc = *(const float4*)(mdn + D + col);
        uint2 o;
        o.x = pack2(xv[j].x * r2 * gg.x * (1.f + sc.x) + sh.x, xv[j].y * r2 * gg.y * (1.f + sc.y) + sh.y);
        o.y = pack2(xv[j].z * r2 * gg.z * (1.f + sc.z) + sh.z, xv[j].w * r2 * gg.w * (1.f + sc.w) + sh.w);
        *(uint2*)(p.H + (size_t)row * D + col) = o;
      }
    }
  }
}

using f32x4 = __attribute__((ext_vector_type(4))) float;
using i32x4 = __attribute__((ext_vector_type(4))) int;
DI int lds_byte(int r, int c) {
  const int st = (r >> 4) * 2 + (c >> 5), ob = (r & 15) * 64 + (c & 31) * 2;
  return st * 1024 + (ob ^ (((ob >> 9) & 1) << 5));
}
DI void stage_rc(int b, int& Rr, int& Cc) {
  const int st = b >> 10, sb = b & 1023, swz = sb ^ (((sb >> 9) & 1) << 5);
  Rr = (st >> 1) * 16 + swz / 64;
  Cc = (st & 1) * 32 + (swz % 64) / 2;
}
constexpr int TILE_B = 256 * 64 * 2, STAGE_B = 2 * TILE_B;

template <class EP>
__device__ __forceinline__ void gemm256(const Ctx cx, const u16* __restrict__ A0, const u16* __restrict__ A1, int ksplit, int lda,
                        const u16* __restrict__ Bt, int K, int nN, bool lat_only, const EP& ep, char* shm) {
  const int tid = cx.tid, wid = tid >> 6, lane = tid & 63, wr = wid >> 2, wc = wid & 3, fr = lane & 15, fq = lane >> 4;
  const int nM = lat_only ? SPG * 8 : R / 256;
  const int nwg = nM * nN, nt = K >> 6;
  for (int u = cx.bid; u < nwg; u += gridDim.x) {
    const int pm = u / nN, pn = u - pm * nN;
    const int brow = lat_only ? ((pm >> 3) * 9 + 1 + (pm & 7)) * 256 : pm * 256;
    const int bcol = pn * 256;
    const u16* Bb = Bt + (size_t)bcol * K;
    unsigned aoff[4], boff[4];
#pragma unroll
    for (int i = 0; i < 4; ++i) {
      int sR, sC; stage_rc(wid * 1024 + i * 8192 + lane * 16, sR, sC);
      aoff[i] = (unsigned)(((brow + sR) * lda + sC) * 2);
      boff[i] = (unsigned)((sR * K + sC) * 2);
    }
    f32x4 acc[8][4];
#pragma unroll
    for (int m = 0; m < 8; ++m)
#pragma unroll
      for (int n = 0; n < 4; ++n) acc[m][n] = (f32x4){0.f, 0.f, 0.f, 0.f};
#define G_STAGE(buf, kt) do { const int kb_ = (kt) * 64; const char* Ab_ = (const char*)((kb_ < ksplit) ? A0 + kb_ : A1 + (kb_ - ksplit)); \
    const char* Bb_ = (const char*)(Bb + kb_); \
    _Pragma("unroll") for (int i = 0; i < 4; ++i) { \
      __builtin_amdgcn_global_load_lds((const unsigned*)(Ab_ + aoff[i]), (__attribute__((address_space(3))) unsigned*)(shm + (buf) * STAGE_B + wid * 1024 + i * 8192), 16, 0, 0); \
      __builtin_amdgcn_global_load_lds((const unsigned*)(Bb_ + boff[i]), (__attribute__((address_space(3))) unsigned*)(shm + (buf) * STAGE_B + TILE_B + wid * 1024 + i * 8192), 16, 0, 0); } } while (0)
    G_STAGE(0, 0);
    asm volatile("s_waitcnt vmcnt(0)" ::: "memory");
    __syncthreads();
    for (int t = 0; t < nt; ++t) {
      const int cur = t & 1;
      if (t + 1 < nt) G_STAGE(cur ^ 1, t + 1);
      const char* SAp = shm + cur * STAGE_B; const char* SBp = SAp + TILE_B;
#pragma unroll
      for (int ks = 0; ks < 2; ++ks) {
        bf16x8 At[8], Bf[4];
#pragma unroll
        for (int m = 0; m < 8; ++m) At[m] = *(const bf16x8*)(SAp + lds_byte(wr * 128 + m * 16 + fr, ks * 32 + fq * 8));
#pragma unroll
        for (int n = 0; n < 4; ++n) Bf[n] = *(const bf16x8*)(SBp + lds_byte(wc * 64 + n * 16 + fr, ks * 32 + fq * 8));
#pragma unroll
        for (int m = 0; m < 8; ++m)
#pragma unroll
          for (int n = 0; n < 4; ++n) acc[m][n] = __builtin_amdgcn_mfma_f32_16x16x32_bf16(Bf[n], At[m], acc[m][n], 0, 0, 0);
      }
      asm volatile("s_waitcnt vmcnt(0)" ::: "memory");
      __syncthreads();
    }
#undef G_STAGE
#pragma unroll
    for (int m = 0; m < 8; ++m) {
#pragma unroll
      for (int n = 0; n < 4; ++n) ep(brow + wr * 128 + m * 16 + fr, bcol + wc * 64 + n * 16 + fq * 4, acc[m][n]);
      __builtin_amdgcn_sched_barrier(0);
    }
  }
}

DI void st_bf4(u16* dst, f32x4 v) { uint2 o; o.x = pack2(v[0], v[1]); o.y = pack2(v[2], v[3]); *(uint2*)dst = o; }
struct EpBf16 { u16* dst; int ld; DI void operator()(int row, int col, f32x4 v) const { st_bf4(dst + (size_t)row * ld + col, v); } };
struct EpF32 { float* dst; int ld; DI void operator()(int row, int col, f32x4 v) const { *(f32x4*)(dst + (size_t)row * ld + col) = v; } };
DI float tanh_fast(float x) { x = fminf(fmaxf(x, -15.f), 15.f); const float t = __expf(2.f * x); return (t - 1.f) / (t + 1.f); }
DI float decay_m1(float lw) {
  const float el = __expf(-fabsf(lw));
  const float ls = fminf(lw, 0.f) - __logf(1.f + el);
  const float e = __expf(ls - 0.5f);
  return __expf(-e) - 1.f;
}
struct EpRw1 {
  u16* big; u16* lr;
  DI void operator()(int row, int col, f32x4 v) const {
    if (col < 3072) { st_bf4(big + (size_t)(col >> 10) * ((size_t)R * D) + (size_t)row * D + (col & 1023), v); }
    else if (col < 3392) {
      const int lc = col - 3072;
      float a = v[0], b = v[1], c = v[2], d = v[3];
      if (lc < 128) { a = tanh_fast(a); b = tanh_fast(b); c = tanh_fast(c); d = tanh_fast(d); }
      else if (lc >= 192) { a = sigmoidf_(a); b = sigmoidf_(b); c = sigmoidf_(c); d = sigmoidf_(d); }
      uint2 o; o.x = pack2(a, b); o.y = pack2(c, d);
      *(uint2*)(lr + (size_t)row * K2 + lc) = o;
    }
  }
};
struct EpRw2 {
  u16* big; u16* gq; const float* w0; const float* a0;
  DI void operator()(int row, int col, f32x4 v) const {
    const int blk = col >> 10, cc = col & 1023;
    float a = v[0], b = v[1], c = v[2], d = v[3];
    u16* dst;
    if (blk < 2) {
      const float4 ww = *(const float4*)(w0 + blk * D + cc);
      a = decay_m1(a + ww.x); b = decay_m1(b + ww.y); c = decay_m1(c + ww.z); d = decay_m1(d + ww.w);
      dst = big + (size_t)(4 + blk) * ((size_t)R * D);
    } else if (blk == 2) {
      const float4 ww = *(const float4*)(a0 + cc);
      a = sigmoidf_(a + ww.x); b = sigmoidf_(b + ww.y); c = sigmoidf_(c + ww.z); d = sigmoidf_(d + ww.w);
      dst = big + (size_t)3 * ((size_t)R * D);
    } else dst = gq;
    uint2 o; o.x = pack2(a, b); o.y = pack2(c, d);
    *(uint2*)(dst + (size_t)row * D + cc) = o;
  }
};

__device__ __forceinline__ void ph_qkconv(const Ctx cx, CParams& p, int g) {
  const size_t total = (size_t)R * 128;
  for (size_t i = (size_t)cx.bid * NTHR + cx.tid; i < total; i += (size_t)gridDim.x * NTHR) {
    const int row = (int)(i >> 7), c0 = ((int)(i & 127)) * 8;
    int b, pos; rowinfo(g, row, b, pos);
    const bool hasp = (pos != 0 && pos != CTX), hasn = (pos != CTX - 1 && pos != TPS - 1);
    const u16* Z = p.BIG + (size_t)row * ZW + c0;
    float cur[8], pv[8], nx[8];
    unpack8(*(const uint4*)Z, cur);
    if (hasp) unpack8(*(const uint4*)(Z - ZW), pv); else { for (int e = 0; e < 8; ++e) pv[e] = 0.f; }
    if (hasn) unpack8(*(const uint4*)(Z + ZW), nx); else { for (int e = 0; e < 8; ++e) nx[e] = 0.f; }
    const float scale = (c0 < 512) ? 0.08838834764831845f : 1.f;
    float o[8];
#pragma unroll
    for (int e = 0; e < 8; ++e) {
      const int c = c0 + e;
      const float v = pv[e] * p.ev_conv_w[c] + cur[e] * p.ev_conv_w[D + c] + nx[e] * p.ev_conv_w[2 * D + c] + p.ev_conv_b[c];
      o[e] = siluf_(v) * scale;
    }
    *(uint4*)(p.QK + (size_t)row * D + c0) = pack8(o);
  }
}

__device__ __forceinline__ void mlstm_item(const Ctx cx, CParams& p, int item, char* smem) {
  const int tid = cx.tid, lane = tid & 63, w = tid >> 6, r = lane & 31, h = lane >> 5;
  const int bl = item >> 3, head = (item >> 1) & 3, dir = item & 1;
  const int base = bl * TPS;
  u16* sQ = (u16*)smem;
  u16* sK = sQ + 32 * 136;
  u16* sVT = sK + 32 * 136;
  u16* sKT = sVT + 128 * 40;
  float* sU = (float*)(sKT + 128 * 40);
  float* sM = sU + 32; float* sBc = sM + 32; float* sLast = sBc + 32;
  float* sN = sLast + 32;
  float* sRD = sN + 128;
  float* sWI = sRD + 128;
  const u16* Z = p.BIG;
  u16* Y = p.BIG + (size_t)R * ZW + (size_t)dir * R * 512;
  const float bgi = p.ev_b_gates[(2 * dir) * 4 + head], bgf = p.ev_b_gates[(2 * dir + 1) * 4 + head];
  f32x16 cacc[4];
#pragma unroll
  for (int a = 0; a < 4; ++a)
#pragma unroll
    for (int i = 0; i < 16; ++i) cacc[a][i] = 0.f;
  if (tid < 128) sN[tid] = 0.f;
  float m = 0.f;
  const bool act = tid < 256;
  const int lr = (tid >> 3) & 31, lc = tid & 7;
  for (int ch = 0; ch < TPS / 32; ++ch) {
    const int p0 = ch * 32;
    __syncthreads();
    uint4 q0, q1, k0, k1, v0, v1;
    if (act) {
      const int grow = scan_row(base, dir, p0 + lr);
      q0 = *(const uint4*)(p.QK + (size_t)grow * D + head * 128 + lc * 8);
      q1 = *(const uint4*)(p.QK + (size_t)grow * D + head * 128 + lc * 8 + 64);
      k0 = *(const uint4*)(p.QK + (size_t)grow * D + 512 + head * 128 + lc * 8);
      k1 = *(const uint4*)(p.QK + (size_t)grow * D + 512 + head * 128 + lc * 8 + 64);
      v0 = *(const uint4*)(Z + (size_t)grow * ZW + 1024 + head * 128 + lc * 8);
      v1 = *(const uint4*)(Z + (size_t)grow * ZW + 1024 + head * 128 + lc * 8 + 64);
    }
    if (w == 0) {
      const int t = lane & 31;
      const int row = scan_row(base, dir, p0 + t);
      const float zi = bf2f(Z[(size_t)row * ZW + 2048 + (2 * dir) * 4 + head]) + bgi;
      const float zf = bf2f(Z[(size_t)row * ZW + 2048 + (2 * dir + 1) * 4 + head]) + bgf;
      float bsum = logsigf_(zf);
      for (int o = 1; o < 32; o <<= 1) { const float v = __shfl_up(bsum, o); if (t >= o) bsum += v; }
      const float u = zi - bsum;
      float pm = u;
      for (int o = 1; o < 32; o <<= 1) { const float v = __shfl_up(pm, o); if (t >= o) pm = fmaxf(pm, v); }
      const float M = fmaxf(m, pm);
      if (lane < 32) { sU[t] = u; sM[t] = M; sBc[t] = bsum; if (t == 31) { sLast[0] = M; sLast[1] = bsum; } }
    }
    __syncthreads();
    const float Mlast = sLast[0], blast = sLast[1];
    if (act) {
      const float ws = __expf(sU[lr] - Mlast);
      *(uint4*)(sQ + lr * 136 + lc * 8) = q0; *(uint4*)(sQ + lr * 136 + lc * 8 + 64) = q1;
      *(uint4*)(sK + lr * 136 + lc * 8) = k0; *(uint4*)(sK + lr * 136 + lc * 8 + 64) = k1;
      float f[8];
      unpack8(k0, f);
#pragma unroll
      for (int e = 0; e < 8; ++e) sKT[(lc * 8 + e) * 40 + lr] = f2bf(f[e] * ws);
      unpack8(k1, f);
#pragma unroll
      for (int e = 0; e < 8; ++e) sKT[(lc * 8 + 64 + e) * 40 + lr] = f2bf(f[e] * ws);
      const u16* pv0 = (const u16*)&v0; const u16* pv1 = (const u16*)&v1;
#pragma unroll
      for (int e = 0; e < 8; ++e) { sVT[(lc * 8 + e) * 40 + lr] = pv0[e]; sVT[(lc * 8 + 64 + e) * 40 + lr] = pv1[e]; }
    }
    __syncthreads();
    f32x16 st;
#pragma unroll
    for (int i = 0; i < 16; ++i) st[i] = 0.f;
    if (act) {
#pragma unroll
    for (int ks = 0; ks < 8; ++ks) {
      const bf16x8 a = *(const bf16x8*)(sK + r * 136 + 16 * ks + 8 * h);
      const bf16x8 b = *(const bf16x8*)(sQ + r * 136 + 16 * ks + 8 * h);
      st = MFMA(a, b, st);
    }
    const float Mt = sM[r];
    float dsum = 0.f;
#pragma unroll
    for (int i = 0; i < 16; ++i) {
      const int s = crow(i, h);
      const float pv = (s <= r) ? st[i] * __expf(sU[s] - Mt) : 0.f;
      st[i] = pv; dsum += pv;
    }
    dsum += __shfl_xor(dsum, 32);
    float qn = 0.f;
#pragma unroll
    for (int d8 = 0; d8 < 8; ++d8) {
      float qf[8]; unpack8(*(const uint4*)(sQ + r * 136 + 64 * h + 8 * d8), qf);
#pragma unroll
      for (int e = 0; e < 8; ++e) qn += qf[e] * sN[64 * h + 8 * d8 + e];
    }
    qn += __shfl_xor(qn, 32);
    const float wi = __expf(m - Mt);
    const float den = dsum + wi * qn;
    const float dn = fmaxf(fabsf(den), __expf(-(sBc[r] + Mt)));
    if (h == 0) { sRD[w * 32 + r] = 1.f / dn; sWI[w * 32 + r] = wi; }
    }
    __syncthreads();
    const float wp = __expf(m - Mlast);
    if (act) {
    f32x16 o;
#pragma unroll
    for (int i = 0; i < 16; ++i) o[i] = 0.f;
#pragma unroll
    for (int mb = 0; mb < 4; ++mb)
#pragma unroll
      for (int s2 = 0; s2 < 2; ++s2) {
        const bf16x8 cb = pack_step(cacc[mb], s2);
        const u16* qp = sQ + r * 136 + 32 * mb + 16 * s2 + 4 * h;
        const bf16x8 a = cat4(*(const s16x4*)qp, *(const s16x4*)(qp + 8));
        o = MFMA(a, cb, o);
      }
#pragma unroll
    for (int i = 0; i < 16; ++i) o[i] *= sWI[w * 32 + crow(i, h)];
#pragma unroll
    for (int s2 = 0; s2 < 2; ++s2) {
      const bf16x8 a = pack_step(st, s2);
      const u16* vp = sVT + (32 * w + r) * 40 + 16 * s2 + 4 * h;
      const bf16x8 b = cat4(*(const s16x4*)vp, *(const s16x4*)(vp + 8));
      o = MFMA(a, b, o);
    }
#pragma unroll
    for (int i = 0; i < 16; ++i) {
      const int t = crow(i, h);
      const int row = scan_row(base, dir, p0 + t);
      Y[(size_t)row * 512 + head * 128 + 32 * w + r] = f2bf(o[i] * sRD[w * 32 + t]);
    }
#pragma unroll
    for (int mb = 0; mb < 4; ++mb) {
#pragma unroll
      for (int i = 0; i < 16; ++i) cacc[mb][i] *= wp;
#pragma unroll
      for (int s2 = 0; s2 < 2; ++s2) {
        const bf16x8 a = *(const bf16x8*)(sKT + (32 * mb + r) * 40 + 16 * s2 + 8 * h);
        const bf16x8 b = *(const bf16x8*)(sVT + (32 * w + r) * 40 + 16 * s2 + 8 * h);
        cacc[mb] = MFMA(a, b, cacc[mb]);
      }
    }
    }
    __syncthreads();
    if (tid < 128) {
      float s = 0.f;
#pragma unroll
      for (int e = 0; e < 32; ++e) s += bf2f(sKT[tid * 40 + e]);
      sN[tid] = wp * sN[tid] + s;
    }
    m = blast + Mlast;
  }
}

__device__ __forceinline__ void gla_item(const Ctx cx, CParams& p, int item, char* smem) {
  const int tid = cx.tid, lane = tid & 63, w = tid >> 6, r = lane & 31, h = lane >> 5;
  const int bl = item >> 3, head = (item >> 1) & 3, dir = item & 1;
  const int base = bl * TPS;
  u16* sQ = (u16*)smem;
  u16* sK = sQ + 32 * 72;
  u16* sKT = sK + 32 * 72;
  u16* sVT = sKT + 64 * 40;
  float* sLa = (float*)(sVT + 128 * 40);
  float* sW2 = sLa + 32 * 64;
  float* sBi = sW2 + 16 * 64;
  const u16* Z = p.BIG;
  u16* Y = p.BIG + (size_t)R * ZW + (size_t)(2 + dir) * R * 512;
  for (int i = tid; i < 16 * 64; i += NTHR) sW2[i] = p.ev_gla_w2[((size_t)dir * 16 + (i >> 6)) * 256 + head * 64 + (i & 63)];
  if (tid < 64) sBi[tid] = p.ev_gla_b[dir * 256 + head * 64 + tid];
  f32x16 sacc[2];
#pragma unroll
  for (int a = 0; a < 2; ++a)
#pragma unroll
    for (int i = 0; i < 16; ++i) sacc[a][i] = 0.f;
  const bool act = tid < 256;
  const int lr = (tid >> 3) & 31, lc = tid & 7;
  for (int ch = 0; ch < TPS / 32; ++ch) {
    const int p0 = ch * 32;
    __syncthreads();
    uint4 gq, gk, v0, v1;
    if (act) {
      const int grow = scan_row(base, dir, p0 + lr);
      const u16* zr = Z + (size_t)grow * ZW;
      gq = *(const uint4*)(zr + 2064 + head * 64 + lc * 8);
      gk = *(const uint4*)(zr + 2320 + head * 64 + lc * 8);
      v0 = *(const uint4*)(zr + 2576 + head * 128 + lc * 8);
      v1 = *(const uint4*)(zr + 2576 + head * 128 + lc * 8 + 64);
      float gl[16];
      unpack8(*(const uint4*)(zr + 3600 + dir * 16), gl); unpack8(*(const uint4*)(zr + 3600 + dir * 16 + 8), gl + 8);
#pragma unroll
      for (int e = 0; e < 8; ++e) {
        const int c = lc * 8 + e;
        float xv = sBi[c];
#pragma unroll
        for (int q = 0; q < 16; ++q) xv += gl[q] * sW2[q * 64 + c];
        sLa[lr * 64 + c] = logsigf_(xv) * (1.f / 16.f);
      }
    }
    __syncthreads();
    if (tid < 64) { float b = 0.f; for (int t = 0; t < 32; ++t) { b += sLa[t * 64 + tid]; sLa[t * 64 + tid] = b; } }
    __syncthreads();
    if (act) {
      float qf[8], kf[8], o[8];
      unpack8(gq, qf); unpack8(gk, kf);
#pragma unroll
      for (int e = 0; e < 8; ++e) { const float bb = sLa[lr * 64 + lc * 8 + e]; qf[e] *= 0.125f * __expf(bb); kf[e] *= __expf(-bb); }
      *(uint4*)(sQ + lr * 72 + lc * 8) = pack8(qf);
      *(uint4*)(sK + lr * 72 + lc * 8) = pack8(kf);
#pragma unroll
      for (int e = 0; e < 8; ++e) sKT[(lc * 8 + e) * 40 + lr] = f2bf(kf[e]);
      (void)o;
      const u16* pv0 = (const u16*)&v0; const u16* pv1 = (const u16*)&v1;
#pragma unroll
      for (int e = 0; e < 8; ++e) { sVT[(lc * 8 + e) * 40 + lr] = pv0[e]; sVT[(lc * 8 + 64 + e) * 40 + lr] = pv1[e]; }
    }
    __syncthreads();
    if (act) {
    f32x16 st;
#pragma unroll
    for (int i = 0; i < 16; ++i) st[i] = 0.f;
#pragma unroll
    for (int ks = 0; ks < 4; ++ks) {
      const bf16x8 a = *(const bf16x8*)(sK + r * 72 + 16 * ks + 8 * h);
      const bf16x8 b = *(const bf16x8*)(sQ + r * 72 + 16 * ks + 8 * h);
      st = MFMA(a, b, st);
    }
#pragma unroll
    for (int i = 0; i < 16; ++i) { if (crow(i, h) > r) st[i] = 0.f; }
    f32x16 o;
#pragma unroll
    for (int i = 0; i < 16; ++i) o[i] = 0.f;
#pragma unroll
    for (int mb = 0; mb < 2; ++mb)
#pragma unroll
      for (int s2 = 0; s2 < 2; ++s2) {
        const bf16x8 cb = pack_step(sacc[mb], s2);
        const u16* qp = sQ + r * 72 + 32 * mb + 16 * s2 + 4 * h;
        const bf16x8 a = cat4(*(const s16x4*)qp, *(const s16x4*)(qp + 8));
        o = MFMA(a, cb, o);
      }
#pragma unroll
    for (int s2 = 0; s2 < 2; ++s2) {
      const bf16x8 a = pack_step(st, s2);
      const u16* vp = sVT + (32 * w + r) * 40 + 16 * s2 + 4 * h;
      const bf16x8 b = cat4(*(const s16x4*)vp, *(const s16x4*)(vp + 8));
      o = MFMA(a, b, o);
    }
#pragma unroll
    for (int i = 0; i < 16; ++i) {
      const int row = scan_row(base, dir, p0 + crow(i, h));
      Y[(size_t)row * 512 + head * 128 + 32 * w + r] = f2bf(o[i]);
    }
#pragma unroll
    for (int mb = 0; mb < 2; ++mb) {
#pragma unroll
      for (int s2 = 0; s2 < 2; ++s2) {
        const bf16x8 a = *(const bf16x8*)(sKT + (32 * mb + r) * 40 + 16 * s2 + 8 * h);
        const bf16x8 b = *(const bf16x8*)(sVT + (32 * w + r) * 40 + 16 * s2 + 8 * h);
        sacc[mb] = MFMA(a, b, sacc[mb]);
      }
#pragma unroll
      for (int i = 0; i < 16; ++i) sacc[mb][i] *= __expf(sLa[31 * 64 + 32 * mb + crow(i, h)]);
    }
    }
  }
}

__device__ __forceinline__ void ph_scan0(const Ctx cx, CParams& p, char* smem) {
  for (int it = cx.bid; it < 2 * SPG * 8; it += gridDim.x) {
    __syncthreads();
    if (it < SPG * 8) mlstm_item(cx, p, it, smem); else gla_item(cx, p, it - SPG * 8, smem);
  }
}

__device__ __forceinline__ void ph_evout(const Ctx cx, CParams& p, int g) {
  const int lane = cx.tid & 63;
  const int gw = cx.bid * NWV + (cx.tid >> 6), nw = gridDim.x * NWV;
  const u16* Yb = p.BIG + (size_t)R * ZW;
  for (int row = gw; row < R; row += nw) {
    const int c0 = lane * 16;
    const int part = c0 >> 9, cc = c0 & 511;
    const u16* yf = Yb + ((size_t)(2 * part) * R + row) * 512 + cc;
    const u16* yb = Yb + ((size_t)(2 * part + 1) * R + row) * 512 + cc;
    float a[16], b[16];
    unpack8(*(const uint4*)yf, a); unpack8(*(const uint4*)(yf + 8), a + 8);
    unpack8(*(const uint4*)yb, b); unpack8(*(const uint4*)(yb + 8), b + 8);
    float ss = 0.f;
#pragma unroll
    for (int e = 0; e < 16; ++e) { a[e] += b[e]; ss += a[e] * a[e]; }
    ss += __shfl_xor(ss, 1); ss += __shfl_xor(ss, 2); ss += __shfl_xor(ss, 4);
    const float rstd = rsqrtf(ss * (1.f / 128.f) + 1e-6f);
    const u16* zg = p.BIG + (size_t)row * ZW + (part ? 3088 : 1536) + cc;
    float gt[16];
    unpack8(*(const uint4*)zg, gt); unpack8(*(const uint4*)(zg + 8), gt + 8);
#pragma unroll
    for (int e = 0; e < 16; ++e) {
      const float gv = part ? siluf_(gt[e]) : sigmoidf_(gt[e]);
      a[e] = a[e] * rstd * p.ev_head_g[c0 + e] * gv;
    }
    *(uint4*)(p.H + (size_t)row * D + c0) = pack8(a);
    *(uint4*)(p.H + (size_t)row * D + c0 + 8) = pack8(a + 8);
  }
}

__device__ __forceinline__ void ph_ffnact(const Ctx cx, CParams& p, int g, int layer, bool lat_only) {
  const float* cw = p.ffn_conv_w + (size_t)layer * 9 * DFF;
  const float* cb = p.ffn_conv_b + (size_t)layer * DFF;
  const size_t total = (size_t)R * 352;
  for (size_t i = (size_t)cx.bid * NTHR + cx.tid; i < total; i += (size_t)gridDim.x * NTHR) {
    const int row = (int)(i / 352), f0 = ((int)(i % 352)) * 8;
    int b, pos; rowinfo(g, row, b, pos);
    if (lat_only && pos < CTX) continue;
    float acc[8];
#pragma unroll
    for (int e = 0; e < 8; ++e) acc[e] = cb[f0 + e];
    u16* gu = p.BIG + (size_t)row * GUW;
    if (pos < CTX) {
#pragma unroll
      for (int dw = 0; dw < 3; ++dw) {
        const int pp = pos + dw - 1;
        if (pp < 0 || pp >= CTX) continue;
        float v[8]; unpack8(*(const uint4*)(gu + (ptrdiff_t)(dw - 1) * GUW + f0), v);
#pragma unroll
        for (int e = 0; e < 8; ++e) acc[e] += v[e] * cw[(3 + dw) * DFF + f0 + e];
      }
    } else {
      const int lp = pos - CTX, gr = lp >> 6, gc = lp & 63;
#pragma unroll
      for (int dh = 0; dh < 3; ++dh) {
        const int rr = gr + dh - 1;
        if (rr < 0 || rr >= 32) continue;
#pragma unroll
        for (int dw = 0; dw < 3; ++dw) {
          const int c2 = gc + dw - 1;
          if (c2 < 0 || c2 >= 64) continue;
          float v[8]; unpack8(*(const uint4*)(gu + (ptrdiff_t)((dh - 1) * 64 + (dw - 1)) * GUW + f0), v);
#pragma unroll
          for (int e = 0; e < 8; ++e) acc[e] += v[e] * cw[(dh * 3 + dw) * DFF + f0 + e];
        }
      }
    }
    float up[8]; unpack8(*(const uint4*)(gu + DFF + f0), up);
#pragma unroll
    for (int e = 0; e < 8; ++e) {
      const float xg = acc[e];
      const float t = tanhf(0.7978845608028654f * (xg + 0.044715f * xg * xg * xg));
      up[e] *= 0.5f * xg * (1.f + t);
    }
    *(uint4*)(gu + DFF + f0) = pack8(up);
  }
}

__device__ __forceinline__ void ph_xx(const Ctx cx, CParams& p, int g) {
  const size_t total = (size_t)R * 128;
  for (size_t i = (size_t)cx.bid * NTHR + cx.tid; i < total; i += (size_t)gridDim.x * NTHR) {
    const int row = (int)(i >> 7), c0 = ((int)(i & 127)) * 8;
    int b, pos; rowinfo(g, row, b, pos);
    const int q = c0 >> 8;
    int off = 0; bool ok;
    if (pos < CTX) {
      if ((q & 1) == 0) { off = -1; ok = pos > 0; } else { off = 1; ok = pos < CTX - 1; }
    } else {
      const int lp = pos - CTX, gr = lp >> 6, gc = lp & 63;
      if (q == 0) { off = -1; ok = gc > 0; }
      else if (q == 1) { off = 1; ok = gc < 63; }
      else if (q == 2) { off = -64; ok = gr > 0; }
      else { off = 64; ok = gr < 31; }
    }
    float hc[8], hs[8];
    unpack8(*(const uint4*)(p.H + (size_t)row * D + c0), hc);
    if (ok) unpack8(*(const uint4*)(p.H + (size_t)(row + off) * D + c0), hs); else { for (int e = 0; e < 8; ++e) hs[e] = 0.f; }
#pragma unroll
    for (int e = 0; e < 8; ++e) hs[e] -= hc[e];
    *(uint4*)(p.QK + (size_t)row * D + c0) = pack8(hs);
  }
}

__device__ __forceinline__ void ph_rwscan(const Ctx cx, CParams& p) {
  const int lane = cx.tid & 63, w = cx.tid >> 6;
  if (w >= 4) return;
  const int vq = lane >> 3, kq = lane & 7, hf = w & 1;
  const size_t RS = (size_t)R * D;
  const u16* Rb = p.BIG; const u16* Kb = p.BIG + RS; const u16* Vb = p.BIG + 2 * RS; const u16* Ab = p.BIG + 3 * RS;
  const int nblk = (SPG * 16 * 2) / 2;
  for (int bi = cx.bid; bi < nblk; bi += gridDim.x) {
    const int item = bi * 2 + (w >> 1);
    const int bl = item >> 5, head = (item >> 1) & 15, dir = item & 1;
    const u16* Wb = p.BIG + (size_t)(4 + dir) * RS;
    u16* Yb = (u16*)p.YO + (size_t)dir * RS;
    const int base = bl * TPS;
    const int colk = head * 64 + kq * 8, colv = head * 64 + hf * 32 + vq * 4;
    float kv0[8], kv1[8];
#pragma unroll
    for (int e = 0; e < 8; ++e) { kv0[e] = p.rw_kvec[colk + e]; kv1[e] = p.rw_kvec[D + colk + e]; }
    float S[4][8];
#pragma unroll
    for (int i = 0; i < 4; ++i)
#pragma unroll
      for (int e = 0; e < 8; ++e) S[i][e] = 0.f;
    int row = scan_row(base, dir, 0);
    uint4 nr = *(const uint4*)(Rb + (size_t)row * D + colk), nk_ = *(const uint4*)(Kb + (size_t)row * D + colk),
          na = *(const uint4*)(Ab + (size_t)row * D + colk), nwv = *(const uint4*)(Wb + (size_t)row * D + colk);
    uint2 nv = *(const uint2*)(Vb + (size_t)row * D + colv);
    for (int ps = 0; ps < TPS; ++ps) {
      const uint4 cr_ = nr, ck = nk_, ca = na, cw = nwv; const uint2 cv = nv;
      const int crow_ = row;
      if (ps + 1 < TPS) {
        row = scan_row(base, dir, ps + 1);
        nr = *(const uint4*)(Rb + (size_t)row * D + colk); nk_ = *(const uint4*)(Kb + (size_t)row * D + colk);
        na = *(const uint4*)(Ab + (size_t)row * D + colk); nwv = *(const uint4*)(Wb + (size_t)row * D + colk);
        nv = *(const uint2*)(Vb + (size_t)row * D + colv);
      }
      float rr[8], kk[8], aa[8], wm1[8], vv[4], kka[8], km[8];
      unpack8(cr_, rr); unpack8(ck, kk); unpack8(ca, aa); unpack8(cw, wm1);
      vv[0] = lo16(cv.x); vv[1] = hi16(cv.x); vv[2] = lo16(cv.y); vv[3] = hi16(cv.y);
      float ss = 0.f;
#pragma unroll
      for (int e = 0; e < 8; ++e) {
        km[e] = kk[e] * (1.f + (aa[e] - 1.f) * kv1[e]);
        kk[e] *= kv0[e]; ss += kk[e] * kk[e];
      }
      ss = red8(ss);
      const float inv = 1.f / fmaxf(sqrtf(ss), 1e-12f);
#pragma unroll
      for (int e = 0; e < 8; ++e) { kk[e] *= inv; kka[e] = kk[e] * aa[e]; }
      float sa[4];
#pragma unroll
      for (int i = 0; i < 4; ++i) {
        float s = 0.f;
#pragma unroll
        for (int e = 0; e < 8; ++e) s += S[i][e] * kk[e];
        sa[i] = -red8(s);
      }
      float y[4];
#pragma unroll
      for (int i = 0; i < 4; ++i) {
        float s = 0.f;
#pragma unroll
        for (int e = 0; e < 8; ++e) {
          float t = S[i][e] + S[i][e] * wm1[e];
          t += sa[i] * kka[e];
          t += vv[i] * km[e];
          S[i][e] = t;
          s += t * rr[e];
        }
        y[i] = red8(s);
      }
      if (kq == 0) { uint2 o; o.x = pack2(y[0], y[1]); o.y = pack2(y[2], y[3]); *(uint2*)(Yb + (size_t)crow_ * D + colv) = o; }
    }
  }
}

__device__ __forceinline__ void ph_rwout(const Ctx cx, CParams& p, int g) {
  const int lane = cx.tid & 63;
  const int gw = cx.bid * NWV + (cx.tid >> 6), nw = gridDim.x * NWV;
  const size_t RS = (size_t)R * D;
  for (int row = gw; row < R; row += nw) {
    int b, pos; rowinfo(g, row, b, pos);
    if (pos < CTX) continue;
    const int c0 = lane * 16;
    const size_t o = (size_t)row * D + c0;
    float yf[16], yb[16], rr[16], kk[16], vv[16], aa[16], gg[16];
    const u16* Yy = (const u16*)p.YO;
    unpack8(*(const uint4*)(Yy + o), yf); unpack8(*(const uint4*)(Yy + o + 8), yf + 8);
    unpack8(*(const uint4*)(Yy + RS + o), yb); unpack8(*(const uint4*)(Yy + RS + o + 8), yb + 8);
    unpack8(*(const uint4*)(p.BIG + o), rr); unpack8(*(const uint4*)(p.BIG + o + 8), rr + 8);
    unpack8(*(const uint4*)(p.BIG + RS + o), kk); unpack8(*(const uint4*)(p.BIG + RS + o + 8), kk + 8);
    unpack8(*(const uint4*)(p.BIG + 2 * RS + o), vv); unpack8(*(const uint4*)(p.BIG + 2 * RS + o + 8), vv + 8);
    unpack8(*(const uint4*)(p.BIG + 3 * RS + o), aa); unpack8(*(const uint4*)(p.BIG + 3 * RS + o + 8), aa + 8);
    unpack8(*(const uint4*)(p.QK + o), gg); unpack8(*(const uint4*)(p.QK + o + 8), gg + 8);
    float s1 = 0.f, bon = 0.f;
#pragma unroll
    for (int e = 0; e < 16; ++e) {
      yf[e] += yb[e]; s1 += yf[e];
      const float km = kk[e] * (1.f + (aa[e] - 1.f) * p.rw_kvec[D + c0 + e]);
      bon += rr[e] * km * p.rw_kvec[2 * D + c0 + e];
    }
    s1 += __shfl_xor(s1, 1); s1 += __shfl_xor(s1, 2);
    bon += __shfl_xor(bon, 1); bon += __shfl_xor(bon, 2);
    const float mu = s1 * (1.f / 64.f);
    float s2 = 0.f;
#pragma unroll
    for (int e = 0; e < 16; ++e) { const float d = yf[e] - mu; s2 += d * d; }
    s2 += __shfl_xor(s2, 1); s2 += __shfl_xor(s2, 2);
    const float rstd = rsqrtf(s2 * (1.f / 64.f) + 64e-5f);
#pragma unroll
    for (int e = 0; e < 16; ++e) {
      const float yn = (yf[e] - mu) * rstd * p.rw_lnx[c0 + e] + p.rw_lnx[D + c0 + e];
      yf[e] = (yn + bon * vv[e]) * gg[e];
    }
    *(uint4*)(p.H + o) = pack8(yf);
    *(uint4*)(p.H + o + 8) = pack8(yf + 8);
  }
}

__global__ void __launch_bounds__(NTHR) fwd_megakernel(Params p_arg) {
  cg::grid_group grid = cg::this_grid();
  __shared__ __attribute__((aligned(1024))) char smem[2 * STAGE_B];
  const size_t RS = (size_t)R * D;
  (void)RS;
  {
    Ctx cx; cx.tid = threadIdx.x; cx.bid = blockIdx.x;
    CParams* pp = (CParams*)__builtin_amdgcn_kernarg_segment_ptr();
    ph_prologue(cx, *pp, (float*)smem);
  }
  grid.sync();
#pragma nounroll
  for (int it2 = 0; it2 < NG * 22 * 2; ++it2) {
    const int it = it2 >> 1;
    const int g = it / 22, ph = it - g * 22;
    if ((it2 & 1) && !((PROBE_MASK >> ph) & 1u)) continue;
    Ctx cx;
    { int t_ = threadIdx.x, b_ = blockIdx.x; asm volatile("" : "+v"(t_), "+s"(b_)); cx.tid = t_; cx.bid = b_; }
    CParams* pp = (CParams*)__builtin_amdgcn_kernarg_segment_ptr();
    asm volatile("" : "+s"(pp));
    CParams& p = *pp;
    switch (ph) {
      case 0: ph_norm0(cx, p, g); break;
      case 1: gemm256(cx, p.H, p.H, 1 << 30, D, p.wt_in, D, ZW / 256, false, EpBf16{p.BIG, ZW}, smem); break;
      case 2: ph_qkconv(cx, p, g); break;
      case 3: ph_scan0(cx, p, smem); break;
      case 4: ph_evout(cx, p, g); break;
      case 5: gemm256(cx, p.H, p.H, 1 << 30, D, p.wt_out, D, 4, false, EpF32{p.YO, D}, smem); break;
      case 6: ph_resid(cx, p, g, 0, 0, false); break;
      case 7: gemm256(cx, p.H, p.H, 1 << 30, D, p.wt_up, D, GUW / 256, false, EpBf16{p.BIG, GUW}, smem); break;
      case 8: ph_ffnact(cx, p, g, 0, false); break;
      case 9: gemm256(cx, p.BIG + DFF, p.BIG + DFF, 1 << 30, GUW, p.wt_down, DFF, 4, false, EpF32{p.YO, D}, smem); break;
      case 10: ph_resid(cx, p, g, 0, 1, false); break;
      case 11: ph_xx(cx, p, g); break;
      case 12: gemm256(cx, p.H, p.QK, D, D, p.wt_1, K1, N1 / 256, false, EpRw1{p.BIG, p.LR}, smem); break;
      case 13: gemm256(cx, p.LR, p.LR, 1 << 30, K2, p.wt_2, K2, N2 / 256, false, EpRw2{p.BIG, p.QK, p.rw_w0, p.rw_a0}, smem); break;
      case 14: ph_rwscan(cx, p); break;
      case 15: ph_rwout(cx, p, g); break;
      case 16: gemm256(cx, p.H, p.H, 1 << 30, D, p.wt_o, D, 4, true, EpF32{p.YO, D}, smem); break;
      case 17: ph_resid(cx, p, g, 1, 0, true); break;
      case 18: gemm256(cx, p.H, p.H, 1 << 30, D, p.wt_up + (size_t)GUW * D, D, GUW / 256, true, EpBf16{p.BIG, GUW}, smem); break;
      case 19: ph_ffnact(cx, p, g, 1, true); break;
      case 20: gemm256(cx, p.BIG + DFF, p.BIG + DFF, 1 << 30, GUW, p.wt_down + (size_t)D * DFF, DFF, 4, true, EpF32{p.YO, D}, smem); break;
      default: ph_resid(cx, p, g, 1, 1, true); break;
    }
    grid.sync();
  }
}

extern "C" void kernel_launch(void* const* d_in, const int* in_sizes, int n_in, void* d_out, int out_size, void* d_ws,
                              size_t ws_size, hipStream_t stream) {
  static int grid_blocks = 0;
  if (!grid_blocks) {
    int dev = 0, cus = 0, per_cu = 0;
    hipGetDevice(&dev);
    hipDeviceGetAttribute(&cus, hipDeviceAttributeMultiprocessorCount, dev);
    hipOccupancyMaxActiveBlocksPerMultiprocessor(&per_cu, fwd_megakernel, NTHR, 0);
    if (per_cu > 1) per_cu = 1;
    if (per_cu < 1) per_cu = 1;
    grid_blocks = cus * per_cu;
  }
  Params p{};
  const float** f = (const float**)&p;
  for (int i = 0; i < 32; ++i) f[i] = (const float*)d_in[i];
  p.out = (float*)d_out;
  char* ws = (char*)d_ws;
  size_t off = 0;
  auto take = [&](size_t bytes) { char* q = ws + off; off += (bytes + 255) & ~(size_t)255; return q; };
  p.wt_in = (u16*)take((size_t)ZW * D * 2);
  p.wt_out = (u16*)take((size_t)D * D * 2);
  p.wt_up = (u16*)take((size_t)2 * GUW * D * 2);
  p.wt_down = (u16*)take((size_t)2 * D * DFF * 2);
  p.wt_o = (u16*)take((size_t)D * D * 2);
  p.wt_1 = (u16*)take((size_t)N1 * K1 * 2);
  p.wt_2 = (u16*)take((size_t)N2 * K2 * 2);
  p.mod = (float*)take((size_t)2 * 33 * 6144 * 4);
  p.xc = (float*)take((size_t)NB * CTX * D * 4);
  p.H = (u16*)take((size_t)R * D * 2);
  p.BIG = (u16*)take((size_t)6 * R * D * 2);
  p.QK = (u16*)take((size_t)R * D * 2);
  p.YO = (float*)take((size_t)R * D * 4);
  p.LR = (u16*)take((size_t)R * K2 * 2);
  if (off > ws_size) { fprintf(stderr, "workspace too small: need %zu have %zu\n", off, ws_size); return; }
  void* args[] = {&p};
  hipError_t e = hipLaunchCooperativeKernel((void*)fwd_megakernel, dim3(grid_blocks), dim3(NTHR), args, 0, stream);
  if (e != hipSuccess) fprintf(stderr, "cooperative launch failed: %s (grid %d)\n", hipGetErrorString(e), grid_blocks);
}
```

```cpp
#include <hip/hip_runtime.h>
#include <hip/hip_cooperative_groups.h>
#include <cstdio>
namespace cg = cooperative_groups;

typedef unsigned short u16;
using bf16x8 = __attribute__((ext_vector_type(8))) short;
using s16x4  = __attribute__((ext_vector_type(4))) short;
using f32x16 = __attribute__((ext_vector_type(16))) float;
#define DI __device__ __forceinline__
#define MFMA(a, b, c) __builtin_amdgcn_mfma_f32_32x32x16_bf16((a), (b), (c), 0, 0, 0)

constexpr int D = 1024, NB = 32, SEQ = 2048, CTX = 256, TPS = 2304;
constexpr int NG = 2, SPG = 16, R = SPG * TPS;
constexpr int ZW = 3840;
constexpr int DFF = 2816, GUW = 5632;
constexpr int NTHR = 512, NWV = NTHR / 64, NPH = 23;
constexpr int N1 = 3584, K1 = 2048, N2 = 4096, K2 = 320;
#ifndef PROBE_MASK_V
#define PROBE_MASK_V 0u
#endif
constexpr unsigned PROBE_MASK = PROBE_MASK_V;

struct Ctx { int tid, bid; };
struct Params {
  const float *x, *c, *ctx, *c_ctx, *w_mod, *b_mod, *norm_g, *ffn_w_up, *ffn_conv_w, *ffn_conv_b, *ffn_w_down,
      *ev_w_in, *ev_b_gates, *ev_conv_w, *ev_conv_b, *ev_gla_w2, *ev_gla_b, *ev_head_g, *ev_w_out,
      *rw_mu, *rw_w_rkv, *rw_w_o, *rw_w0, *rw_w1, *rw_w2, *rw_a0, *rw_a1, *rw_a2, *rw_g1, *rw_g2, *rw_kvec, *rw_lnx;
  float* out;
  u16 *wt_in, *wt_out, *wt_up, *wt_down, *wt_o, *wt_1, *wt_2;
  float* mod; float* xc;
  u16* H; u16* BIG; u16* QK; float* YO; u16* LR;
};

typedef const __attribute__((address_space(4))) Params CParams;

DI float bf2f(u16 v) { return __uint_as_float(((unsigned)v) << 16); }
typedef __bf16 bf16x2_t __attribute__((ext_vector_type(2)));
typedef float f32x2_t __attribute__((ext_vector_type(2)));
DI unsigned pack2(float a, float b) { f32x2_t v; v.x = a; v.y = b; return __builtin_bit_cast(unsigned, __builtin_convertvector(v, bf16x2_t)); }
DI u16 f2bf(float f) { return (u16)(pack2(f, 0.f) & 0xffffu); }
DI float lo16(unsigned u) { return __uint_as_float(u << 16); }
DI float hi16(unsigned u) { return __uint_as_float(u & 0xffff0000u); }
DI void unpack8(const uint4& v, float* o) {
  o[0] = lo16(v.x); o[1] = hi16(v.x); o[2] = lo16(v.y); o[3] = hi16(v.y);
  o[4] = lo16(v.z); o[5] = hi16(v.z); o[6] = lo16(v.w); o[7] = hi16(v.w);
}
DI uint4 pack8(const float* o) { uint4 v; v.x = pack2(o[0], o[1]); v.y = pack2(o[2], o[3]); v.z = pack2(o[4], o[5]); v.w = pack2(o[6], o[7]); return v; }
DI int crow(int reg, int h) { return (reg & 3) + 8 * (reg >> 2) + 4 * h; }
DI float wsum(float v) { for (int o = 32; o; o >>= 1) v += __shfl_xor(v, o); return v; }
DI float sigmoidf_(float x) { return 1.f / (1.f + __expf(-x)); }
DI float logsigf_(float x) { return fminf(x, 0.f) - log1pf(__expf(-fabsf(x))); }
DI float siluf_(float x) { return x / (1.f + __expf(-x)); }
DI bf16x8 cat4(s16x4 lo, s16x4 hi) { return __builtin_shufflevector(lo, hi, 0, 1, 2, 3, 4, 5, 6, 7); }
DI bf16x8 pack_step(const f32x16& x, int s) {
  uint4 v;
  v.x = pack2(x[8 * s + 0], x[8 * s + 1]); v.y = pack2(x[8 * s + 2], x[8 * s + 3]);
  v.z = pack2(x[8 * s + 4], x[8 * s + 5]); v.w = pack2(x[8 * s + 6], x[8 * s + 7]);
  return __builtin_bit_cast(bf16x8, v);
}
DI float dppf(float x, int) { return x; }
#define DPP_F(x, ctrl) __int_as_float(__builtin_amdgcn_update_dpp(0, __float_as_int(x), (ctrl), 0xF, 0xF, true))
DI float red8(float x) {
  x += DPP_F(x, 0x141);
  x += DPP_F(x, 0xB1);
  x += DPP_F(x, 0x4E);
  return x;
}

DI int scan_row(int base, int dir, int p) {
  if (dir == 0) return base + p;
  return (p < CTX) ? base + (CTX - 1 - p) : base + (TPS + CTX - 1 - p);
}

__device__ __forceinline__ void convert_job(const Ctx cx, const float* __restrict__ src, int K, int N, int Npad, u16* __restrict__ dst, int ldd, const float* __restrict__ mu, float* tile) {
  const int tx = cx.tid & 31, ty = cx.tid >> 5;
  const int tk = K >> 5, tn = Npad >> 5;
  for (int t = cx.bid; t < tk * tn; t += gridDim.x) {
    const int k0 = (t / tn) * 32, n0 = (t % tn) * 32;
#pragma unroll
    for (int i = 0; i < 2; ++i) {
      const int kk = k0 + ty + 16 * i, nn = n0 + tx;
      float v = (nn < N) ? src[(size_t)kk * N + nn] : 0.f;
      if (mu) v *= mu[kk];
      tile[(ty + 16 * i) * 33 + tx] = v;
    }
    __syncthreads();
#pragma unroll
    for (int i = 0; i < 2; ++i) {
      const int nn = n0 + ty + 16 * i, kk = k0 + tx;
      dst[(size_t)nn * ldd + kk] = f2bf(tile[tx * 33 + ty + 16 * i]);
    }
    __syncthreads();
  }
}

__device__ __forceinline__ void ph_mod(const Ctx cx, CParams& p, float* smem) {
  const int tid = cx.tid, lane = tid & 63, w = tid >> 6;
  float* sc = smem + w * (33 * 64);
  for (int u = cx.bid; u < 2 * 96; u += gridDim.x) {
    const int layer = u / 96, n = (u % 96) * 64 + lane;
    const float* W = p.w_mod + (size_t)layer * D * 6144;
    float acc[33];
#pragma unroll
    for (int i = 0; i < 33; ++i) acc[i] = 0.f;
    for (int kc = 0; kc < 2; ++kc) {
      const int k0 = w * 128 + kc * 64;
#pragma nounroll
      for (int cr = 0; cr < 33; ++cr) {
        const float v = (cr < 32) ? p.c[cr * D + k0 + lane] : p.c_ctx[k0 + lane];
        sc[cr * 64 + lane] = siluf_(v);
      }
      __syncthreads();
#pragma unroll 2
      for (int j = 0; j < 64; ++j) {
        const float wv = W[(size_t)(k0 + j) * 6144 + n];
#pragma unroll
        for (int cr = 0; cr < 33; ++cr) acc[cr] += sc[cr * 64 + j] * wv;
      }
      __syncthreads();
    }
#pragma unroll
    for (int cr = 0; cr < 33; ++cr) sc[cr * 64 + lane] = acc[cr];
    __syncthreads();
    if (w == 0) {
      const float bm = p.b_mod[layer * 6144 + n];
      for (int cr = 0; cr < 33; ++cr) {
        float s = 0.f;
#pragma unroll
        for (int q = 0; q < NWV; ++q) s += smem[q * 33 * 64 + cr * 64 + lane];
        p.mod[((size_t)layer * 33 + cr) * 6144 + n] = s + bm;
      }
    }
    __syncthreads();
  }
}

__device__ __forceinline__ void ph_prologue(const Ctx cx, CParams& p, float* smem) {
  ph_mod(cx, p, smem);
  convert_job(cx, p.ev_w_in, D, 3632, ZW, p.wt_in, D, nullptr, smem);
  convert_job(cx, p.ev_w_out, D, D, D, p.wt_out, D, nullptr, smem);
  for (int l = 0; l < 2; ++l) {
    convert_job(cx, p.ffn_w_up + (size_t)l * D * GUW, D, GUW, GUW, p.wt_up + (size_t)l * GUW * D, D, nullptr, smem);
    convert_job(cx, p.ffn_w_down + (size_t)l * DFF * D, DFF, D, D, p.wt_down + (size_t)l * D * DFF, DFF, nullptr, smem);
  }
  convert_job(cx, p.rw_w_o, D, D, D, p.wt_o, D, nullptr, smem);
  for (int half = 0; half < 2; ++half) {
    u16* dcol = p.wt_1 + half * D;
    const float* m0 = half ? p.rw_mu : nullptr;
    convert_job(cx, p.rw_w_rkv, D, D, D, dcol, K1, half ? m0 + 0 * D : nullptr, smem);
    convert_job(cx, p.rw_w_rkv + (size_t)D * D, D, D, D, dcol + (size_t)1024 * K1, K1, half ? m0 + 2 * D : nullptr, smem);
    convert_job(cx, p.rw_w_rkv + (size_t)2 * D * D, D, D, D, dcol + (size_t)2048 * K1, K1, half ? m0 + 3 * D : nullptr, smem);
    convert_job(cx, p.rw_w1, D, 64, 64, dcol + (size_t)3072 * K1, K1, half ? m0 + 1 * D : nullptr, smem);
    convert_job(cx, p.rw_w1 + D * 64, D, 64, 64, dcol + (size_t)3136 * K1, K1, half ? m0 + 1 * D : nullptr, smem);
    convert_job(cx, p.rw_a1, D, 64, 64, dcol + (size_t)3200 * K1, K1, half ? m0 + 4 * D : nullptr, smem);
    convert_job(cx, p.rw_g1, D, 128, 320, dcol + (size_t)3264 * K1, K1, half ? m0 + 5 * D : nullptr, smem);
  }
  for (size_t i = (size_t)cx.bid * NTHR + cx.tid; i < (size_t)N2 * K2; i += (size_t)gridDim.x * NTHR) {
    const int n = (int)(i / K2), c = (int)(i % K2), blk = n >> 10, nn = n & 1023;
    float v = 0.f;
    if (blk == 0) { if (c < 64) v = p.rw_w2[(size_t)c * D + nn]; }
    else if (blk == 1) { if (c >= 64 && c < 128) v = p.rw_w2[(size_t)(64 + c - 64) * D + nn]; }
    else if (blk == 2) { if (c >= 128 && c < 192) v = p.rw_a2[(size_t)(c - 128) * D + nn]; }
    else { if (c >= 192) v = p.rw_g2[(size_t)(c - 192) * D + nn]; }
    p.wt_2[i] = f2bf(v);
  }
}

DI void rowinfo(int g, int row, int& b, int& pos) { const int bl = row / TPS; pos = row - bl * TPS; b = g * SPG + bl; }

__device__ __forceinline__ void ph_norm0(const Ctx cx, CParams& p, int g) {
  const int lane = cx.tid & 63;
  const int gw = cx.bid * NWV + (cx.tid >> 6), nw = gridDim.x * NWV;
  for (int row = gw; row < R; row += nw) {
    int b, pos; rowinfo(g, row, b, pos);
    const float* src = (pos < CTX) ? p.ctx + ((size_t)(b * CTX + pos)) * D : p.x + ((size_t)(b * SEQ + pos - CTX)) * D;
    const float* md = p.mod + ((size_t)(pos < CTX ? 32 : b)) * 6144;
    float4 v[4]; float ss = 0.f;
#pragma unroll
    for (int j = 0; j < 4; ++j) { v[j] = ((const float4*)src)[j * 64 + lane]; ss += v[j].x * v[j].x + v[j].y * v[j].y + v[j].z * v[j].z + v[j].w * v[j].w; }
    ss = wsum(ss);
    const float rstd = rsqrtf(ss * (1.f / D) + 1e-6f);
#pragma unroll
    for (int j = 0; j < 4; ++j) {
      const int col = j * 256 + lane * 4;
      const float4 gg = *(const float4*)(p.norm_g + col);
      const float4 sh = *(const float4*)(md + col), sc = *(const float4*)(md + D + col);
      uint2 o;
      o.x = pack2(v[j].x * rstd * gg.x * (1.f + sc.x) + sh.x, v[j].y * rstd * gg.y * (1.f + sc.y) + sh.y);
      o.y = pack2(v[j].z * rstd * gg.z * (1.f + sc.z) + sh.z, v[j].w * rstd * gg.w * (1.f + sc.w) + sh.w);
      *(uint2*)(p.H + (size_t)row * D + col) = o;
    }
  }
}

__device__ __forceinline__ void ph_resid(const Ctx cx, CParams& p, int g, int layer, int which, bool lat_only) {
  const int lane = cx.tid & 63;
  const int gw = cx.bid * NWV + (cx.tid >> 6), nw = gridDim.x * NWV;
  const bool from_inputs = (layer == 0 && which == 0);
  const bool has_next = (which == 0) || (layer + 1 < 2);
  const float* ga = p.norm_g + (layer * 4 + (which ? 3 : 1)) * D;
  const float* gb = (which == 0) ? p.norm_g + (layer * 4 + 2) * D : p.norm_g + ((layer + 1) * 4 + 0) * D;
  for (int row = gw; row < R; row += nw) {
    int b, pos; rowinfo(g, row, b, pos);
    if (lat_only && pos < CTX) continue;
    const size_t ridx = (pos < CTX) ? ((size_t)(b * CTX + pos)) * D : ((size_t)(b * SEQ + pos - CTX)) * D;
    const float* src = from_inputs ? ((pos < CTX) ? p.ctx + ridx : p.x + ridx) : ((pos < CTX) ? p.xc + ridx : p.out + ridx);
    float* dst = (pos < CTX) ? p.xc + ridx : p.out + ridx;
    const int cr = (pos < CTX) ? 32 : b;
    const float* md = p.mod + ((size_t)layer * 33 + cr) * 6144;
    const float* mdn = (which == 0) ? md + 3 * D : p.mod + ((size_t)(layer + 1) * 33 + cr) * 6144;
    const float* gate = md + (which ? 5 : 2) * D;
    const float* yo = p.YO + (size_t)row * D;
    float4 y[4], xv[4]; float ss = 0.f;
#pragma unroll
    for (int j = 0; j < 4; ++j) { y[j] = ((const float4*)yo)[j * 64 + lane]; xv[j] = ((const float4*)src)[j * 64 + lane]; ss += y[j].x * y[j].x + y[j].y * y[j].y + y[j].z * y[j].z + y[j].w * y[j].w; }
    ss = wsum(ss);
    const float rstd = rsqrtf(ss * (1.f / D) + 1e-6f);
    float s2 = 0.f;
#pragma unroll
    for (int j = 0; j < 4; ++j) {
      const int col = j * 256 + lane * 4;
      const float4 g4 = *(const float4*)(ga + col), gt = *(const float4*)(gate + col);
      xv[j].x += gt.x * (y[j].x * rstd * g4.x); xv[j].y += gt.y * (y[j].y * rstd * g4.y);
      xv[j].z += gt.z * (y[j].z * rstd * g4.z); xv[j].w += gt.w * (y[j].w * rstd * g4.w);
      ((float4*)dst)[j * 64 + lane] = xv[j];
      s2 += xv[j].x * xv[j].x + xv[j].y * xv[j].y + xv[j].z * xv[j].z + xv[j].w * xv[j].w;
    }
    if (has_next) {
      s2 = wsum(s2);
      const float r2 = rsqrtf(s2 * (1.f / D) + 1e-6f);
#pragma unroll
      for (int j = 0; j < 4; ++j) {
        const int col = j * 256 + lane * 4;
        const float4 gg = *(const float4*)(gb + col);
        const float4 sh = *(const float4*)(mdn + col), sc = *(const float4*)(mdn + D + col);
        uint2 o;
        o.x = pack2(xv[j].x * r2 * gg.x * (1.f + sc.x) + sh.x, xv[j].y * r2 * gg.y * (1.f + sc.y) + sh.y);
        o.y = pack2(xv[j].z * r2 * gg.z * (1.f + sc.z) + sh.z, xv[j].w * r2 * gg.w * (1.f + sc.w) + sh.w);
        *(uint2*)(p.H + (size_t)row * D + col) = o;
      }
    }
  }
}

using f32x4 = __attribute__((ext_vector_type(4))) float;
using i32x4 = __attribute__((ext_vector_type(4))) int;
DI int lds_byte(int r, int c) {
  const int st = (r >> 4) * 2 + (c >> 5), ob = (r & 15) * 64 + (c & 31) * 2;
  return st * 1024 + (ob ^ (((ob >> 9) & 1) << 5));
}
DI void stage_rc(int b, int& Rr, int& Cc) {
  const int st = b >> 10, sb = b & 1023, swz = sb ^ (((sb >> 9) & 1) << 5);
  Rr = (st >> 1) * 16 + swz / 64;
  Cc = (st & 1) * 32 + (swz % 64) / 2;
}
constexpr int TILE_B = 256 * 64 * 2, STAGE_B = 2 * TILE_B;

template <class EP>
__device__ __forceinline__ void gemm256(const Ctx cx, const u16* __restrict__ A0, const u16* __restrict__ A1, int ksplit, int lda,
                        const u16* __restrict__ Bt, int K, int nN, bool lat_only, const EP& ep, char* shm) {
  const int tid = cx.tid, wid = tid >> 6, lane = tid & 63, wr = wid >> 2, wc = wid & 3, fr = lane & 15, fq = lane >> 4;
  const int nM = lat_only ? SPG * 8 : R / 256;
  const int nwg = nM * nN, nt = K >> 6;
  const int xcd = cx.bid & 7, slot = cx.bid >> 3, nslot = gridDim.x >> 3, per_xcd = (nM >> 3) * nN;
  (void)nwg;
  for (int u = slot; u < per_xcd; u += nslot) {
    const int ml = u / nN, pn = u - ml * nN, pm = ml * 8 + xcd;
    const int brow = lat_only ? ((pm >> 3) * 9 + 1 + (pm & 7)) * 256 : pm * 256;
    const int bcol = pn * 256;
    const u16* Bb = Bt + (size_t)bcol * K;
    unsigned aoff[4], boff[4];
#pragma unroll
    for (int i = 0; i < 4; ++i) {
      int sR, sC; stage_rc(wid * 1024 + i * 8192 + lane * 16, sR, sC);
      aoff[i] = (unsigned)(((brow + sR) * lda + sC) * 2);
      boff[i] = (unsigned)((sR * K + sC) * 2);
    }
    f32x4 acc[8][4];
#pragma unroll
    for (int m = 0; m < 8; ++m)
#pragma unroll
      for (int n = 0; n < 4; ++n) acc[m][n] = (f32x4){0.f, 0.f, 0.f, 0.f};
#define G_STAGE(buf, kt) do { const int kb_ = (kt) * 64; const char* Ab_ = (const char*)((kb_ < ksplit) ? A0 + kb_ : A1 + (kb_ - ksplit)); \
    const char* Bb_ = (const char*)(Bb + kb_); \
    _Pragma("unroll") for (int i = 0; i < 4; ++i) { \
      __builtin_amdgcn_global_load_lds((const unsigned*)(Ab_ + aoff[i]), (__attribute__((address_space(3))) unsigned*)(shm + (buf) * STAGE_B + wid * 1024 + i * 8192), 16, 0, 0); \
      __builtin_amdgcn_global_load_lds((const unsigned*)(Bb_ + boff[i]), (__attribute__((address_space(3))) unsigned*)(shm + (buf) * STAGE_B + TILE_B + wid * 1024 + i * 8192), 16, 0, 0); } } while (0)
    G_STAGE(0, 0);
    asm volatile("s_waitcnt vmcnt(0)" ::: "memory");
    __syncthreads();
#pragma nounroll
    for (int t = 0; t < nt; ++t) {
      const int cur = t & 1;
      if (t + 1 < nt) G_STAGE(cur ^ 1, t + 1);
      const char* SAp = shm + cur * STAGE_B; const char* SBp = SAp + TILE_B;
#pragma unroll
      for (int ks = 0; ks < 2; ++ks) {
        bf16x8 At[8], Bf[4];
#pragma unroll
        for (int m = 0; m < 8; ++m) At[m] = *(const bf16x8*)(SAp + lds_byte(wr * 128 + m * 16 + fr, ks * 32 + fq * 8));
#pragma unroll
        for (int n = 0; n < 4; ++n) Bf[n] = *(const bf16x8*)(SBp + lds_byte(wc * 64 + n * 16 + fr, ks * 32 + fq * 8));
#pragma unroll
        for (int m = 0; m < 8; ++m)
#pragma unroll
          for (int n = 0; n < 4; ++n) acc[m][n] = __builtin_amdgcn_mfma_f32_16x16x32_bf16(Bf[n], At[m], acc[m][n], 0, 0, 0);
      }
      asm volatile("s_waitcnt vmcnt(0)" ::: "memory");
      __syncthreads();
    }
#undef G_STAGE
#pragma unroll
    for (int m = 0; m < 8; ++m) {
#pragma unroll
      for (int n = 0; n < 4; ++n) ep(brow + wr * 128 + m * 16 + fr, bcol + wc * 64 + n * 16 + fq * 4, acc[m][n]);
      __builtin_amdgcn_sched_barrier(0);
    }
  }
}

DI void st_bf4(u16* dst, f32x4 v) { uint2 o; o.x = pack2(v[0], v[1]); o.y = pack2(v[2], v[3]); *(uint2*)dst = o; }
struct EpBf16 { u16* dst; int ld; DI void operator()(int row, int col, f32x4 v) const { st_bf4(dst + (size_t)row * ld + col, v); } };
struct EpF32 { float* dst; int ld; DI void operator()(int row, int col, f32x4 v) const { *(f32x4*)(dst + (size_t)row * ld + col) = v; } };
DI float tanh_fast(float x) { x = fminf(fmaxf(x, -15.f), 15.f); const float t = __expf(2.f * x); return (t - 1.f) / (t + 1.f); }
DI float decay_m1(float lw) {
  const float el = __expf(-fabsf(lw));
  const float ls = fminf(lw, 0.f) - __logf(1.f + el);
  const float e = __expf(ls - 0.5f);
  return __expf(-e) - 1.f;
}
struct EpRw1 {
  u16* big; u16* lr;
  DI void operator()(int row, int col, f32x4 v) const {
    const int cu = __builtin_amdgcn_readfirstlane(col >> 6);
    if (cu < 48) { st_bf4(big + (size_t)(cu >> 4) * ((size_t)R * D) + (size_t)row * D + (col & 1023), v); }
    else if (cu < 53) {
      const int lc = col - 3072;
      float a = v[0], b = v[1], c = v[2], d = v[3];
      if (lc < 128) { a = tanh_fast(a); b = tanh_fast(b); c = tanh_fast(c); d = tanh_fast(d); }
      else if (lc >= 192) { a = sigmoidf_(a); b = sigmoidf_(b); c = sigmoidf_(c); d = sigmoidf_(d); }
      uint2 o; o.x = pack2(a, b); o.y = pack2(c, d);
      *(uint2*)(lr + (size_t)row * K2 + lc) = o;
    }
  }
};
struct EpRw2 {
  u16* big; u16* gq; const float* w0; const float* a0;
  DI void operator()(int row, int col, f32x4 v) const {
    const int blk = __builtin_amdgcn_readfirstlane(col >> 10), cc = col & 1023;
    float a = v[0], b = v[1], c = v[2], d = v[3];
    u16* dst;
    if (blk < 2) {
      const float4 ww = *(const float4*)(w0 + blk * D + cc);
      a = decay_m1(a + ww.x); b = decay_m1(b + ww.y); c = decay_m1(c + ww.z); d = decay_m1(d + ww.w);
      dst = big + (size_t)(4 + blk) * ((size_t)R * D);
    } else if (blk == 2) {
      const float4 ww = *(const float4*)(a0 + cc);
      a = sigmoidf_(a + ww.x); b = sigmoidf_(b + ww.y); c = sigmoidf_(c + ww.z); d = sigmoidf_(d + ww.w);
      dst = big + (size_t)3 * ((size_t)R * D);
    } else dst = gq;
    uint2 o; o.x = pack2(a, b); o.y = pack2(c, d);
    *(uint2*)(dst + (size_t)row * D + cc) = o;
  }
};

__device__ __forceinline__ void ph_qkconv(const Ctx cx, CParams& p, int g) {
  const size_t total = (size_t)R * 128;
  for (size_t i = (size_t)cx.bid * NTHR + cx.tid; i < total; i += (size_t)gridDim.x * NTHR) {
    const int row = (int)(i >> 7), c0 = ((int)(i & 127)) * 8;
    int b, pos; rowinfo(g, row, b, pos);
    const bool hasp = (pos != 0 && pos != CTX), hasn = (pos != CTX - 1 && pos != TPS - 1);
    const u16* Z = p.BIG + (size_t)row * ZW + c0;
    float cur[8], pv[8], nx[8];
    unpack8(*(const uint4*)Z, cur);
    if (hasp) unpack8(*(const uint4*)(Z - ZW), pv); else { for (int e = 0; e < 8; ++e) pv[e] = 0.f; }
    if (hasn) unpack8(*(const uint4*)(Z + ZW), nx); else { for (int e = 0; e < 8; ++e) nx[e] = 0.f; }
    const float scale = (c0 < 512) ? 0.08838834764831845f : 1.f;
    float o[8];
#pragma unroll
    for (int e = 0; e < 8; ++e) {
      const int c = c0 + e;
      const float v = pv[e] * p.ev_conv_w[c] + cur[e] * p.ev_conv_w[D + c] + nx[e] * p.ev_conv_w[2 * D + c] + p.ev_conv_b[c];
      o[e] = siluf_(v) * scale;
    }
    *(uint4*)(p.QK + (size_t)row * D + c0) = pack8(o);
  }
}

__device__ __forceinline__ void mlstm_item(const Ctx cx, CParams& p, int item, char* smem) {
  const int tid = cx.tid, lane = tid & 63, w = tid >> 6, r = lane & 31, h = lane >> 5;
  const int bl = item >> 3, head = (item >> 1) & 3, dir = item & 1;
  const int base = bl * TPS;
  u16* sQ = (u16*)smem;
  u16* sK = sQ + 32 * 136;
  u16* sVT = sK + 32 * 136;
  u16* sKT = sVT + 128 * 40;
  float* sU = (float*)(sKT + 128 * 40);
  float* sM = sU + 32; float* sBc = sM + 32; float* sLast = sBc + 32;
  float* sN = sLast + 32;
  float* sRD = sN + 128;
  float* sWI = sRD + 128;
  const u16* Z = p.BIG;
  u16* Y = p.BIG + (size_t)R * ZW + (size_t)dir * R * 512;
  const float bgi = p.ev_b_gates[(2 * dir) * 4 + head], bgf = p.ev_b_gates[(2 * dir + 1) * 4 + head];
  f32x16 cacc[4];
#pragma unroll
  for (int a = 0; a < 4; ++a)
#pragma unroll
    for (int i = 0; i < 16; ++i) cacc[a][i] = 0.f;
  if (tid < 128) sN[tid] = 0.f;
  float m = 0.f;
  const bool act = tid < 256;
  const int lr = (tid >> 3) & 31, lc = tid & 7;
  for (int ch = 0; ch < TPS / 32; ++ch) {
    const int p0 = ch * 32;
    __syncthreads();
    uint4 q0, q1, k0, k1, v0, v1;
    if (act) {
      const int grow = scan_row(base, dir, p0 + lr);
      q0 = *(const uint4*)(p.QK + (size_t)grow * D + head * 128 + lc * 8);
      q1 = *(const uint4*)(p.QK + (size_t)grow * D + head * 128 + lc * 8 + 64);
      k0 = *(const uint4*)(p.QK + (size_t)grow * D + 512 + head * 128 + lc * 8);
      k1 = *(const uint4*)(p.QK + (size_t)grow * D + 512 + head * 128 + lc * 8 + 64);
      v0 = *(const uint4*)(Z + (size_t)grow * ZW + 1024 + head * 128 + lc * 8);
      v1 = *(const uint4*)(Z + (size_t)grow * ZW + 1024 + head * 128 + lc * 8 + 64);
    }
    if (w == 0) {
      const int t = lane & 31;
      const int row = scan_row(base, dir, p0 + t);
      const float zi = bf2f(Z[(size_t)row * ZW + 2048 + (2 * dir) * 4 + head]) + bgi;
      const float zf = bf2f(Z[(size_t)row * ZW + 2048 + (2 * dir + 1) * 4 + head]) + bgf;
      float bsum = logsigf_(zf);
      for (int o = 1; o < 32; o <<= 1) { const float v = __shfl_up(bsum, o); if (t >= o) bsum += v; }
      const float u = zi - bsum;
      float pm = u;
      for (int o = 1; o < 32; o <<= 1) { const float v = __shfl_up(pm, o); if (t >= o) pm = fmaxf(pm, v); }
      const float M = fmaxf(m, pm);
      if (lane < 32) { sU[t] = u; sM[t] = M; sBc[t] = bsum; if (t == 31) { sLast[0] = M; sLast[1] = bsum; } }
    }
    __syncthreads();
    const float Mlast = sLast[0], blast = sLast[1];
    if (act) {
      const float ws = __expf(sU[lr] - Mlast);
      *(uint4*)(sQ + lr * 136 + lc * 8) = q0; *(uint4*)(sQ + lr * 136 + lc * 8 + 64) = q1;
      *(uint4*)(sK + lr * 136 + lc * 8) = k0; *(uint4*)(sK + lr * 136 + lc * 8 + 64) = k1;
      float f[8];
      unpack8(k0, f);
#pragma unroll
      for (int e = 0; e < 8; ++e) sKT[(lc * 8 + e) * 40 + lr] = f2bf(f[e] * ws);
      unpack8(k1, f);
#pragma unroll
      for (int e = 0; e < 8; ++e) sKT[(lc * 8 + 64 + e) * 40 + lr] = f2bf(f[e] * ws);
      const u16* pv0 = (const u16*)&v0; const u16* pv1 = (const u16*)&v1;
#pragma unroll
      for (int e = 0; e < 8; ++e) { sVT[(lc * 8 + e) * 40 + lr] = pv0[e]; sVT[(lc * 8 + 64 + e) * 40 + lr] = pv1[e]; }
    }
    __syncthreads();
    f32x16 st;
#pragma unroll
    for (int i = 0; i < 16; ++i) st[i] = 0.f;
    if (act) {
#pragma unroll
    for (int ks = 0; ks < 8; ++ks) {
      const bf16x8 a = *(const bf16x8*)(sK + r * 136 + 16 * ks + 8 * h);
      const bf16x8 b = *(const bf16x8*)(sQ + r * 136 + 16 * ks + 8 * h);
      st = MFMA(a, b, st);
    }
    const float Mt = sM[r];
    float dsum = 0.f;
#pragma unroll
    for (int i = 0; i < 16; ++i) {
      const int s = crow(i, h);
      const float pv = (s <= r) ? st[i] * __expf(sU[s] - Mt) : 0.f;
      st[i] = pv; dsum += pv;
    }
    dsum += __shfl_xor(dsum, 32);
    float qn = 0.f;
#pragma unroll
    for (int d8 = 0; d8 < 8; ++d8) {
      float qf[8]; unpack8(*(const uint4*)(sQ + r * 136 + 64 * h + 8 * d8), qf);
#pragma unroll
      for (int e = 0; e < 8; ++e) qn += qf[e] * sN[64 * h + 8 * d8 + e];
    }
    qn += __shfl_xor(qn, 32);
    const float wi = __expf(m - Mt);
    const float den = dsum + wi * qn;
    const float dn = fmaxf(fabsf(den), __expf(-(sBc[r] + Mt)));
    if (h == 0) { sRD[w * 32 + r] = 1.f / dn; sWI[w * 32 + r] = wi; }
    }
    __syncthreads();
    const float wp = __expf(m - Mlast);
    if (act) {
    f32x16 o;
#pragma unroll
    for (int i = 0; i < 16; ++i) o[i] = 0.f;
#pragma unroll
    for (int mb = 0; mb < 4; ++mb)
#pragma unroll
      for (int s2 = 0; s2 < 2; ++s2) {
        const bf16x8 cb = pack_step(cacc[mb], s2);
        const u16* qp = sQ + r * 136 + 32 * mb + 16 * s2 + 4 * h;
        const bf16x8 a = cat4(*(const s16x4*)qp, *(const s16x4*)(qp + 8));
        o = MFMA(a, cb, o);
      }
#pragma unroll
    for (int i = 0; i < 16; ++i) o[i] *= sWI[w * 32 + crow(i, h)];
#pragma unroll
    for (int s2 = 0; s2 < 2; ++s2) {
      const bf16x8 a = pack_step(st, s2);
      const u16* vp = sVT + (32 * w + r) * 40 + 16 * s2 + 4 * h;
      const bf16x8 b = cat4(*(const s16x4*)vp, *(const s16x4*)(vp + 8));
      o = MFMA(a, b, o);
    }
#pragma unroll
    for (int i = 0; i < 16; ++i) {
      const int t = crow(i, h);
      const int row = scan_row(base, dir, p0 + t);
      Y[(size_t)row * 512 + head * 128 + 32 * w + r] = f2bf(o[i] * sRD[w * 32 + t]);
    }
#pragma unroll
    for (int mb = 0; mb < 4; ++mb) {
#pragma unroll
      for (int i = 0; i < 16; ++i) cacc[mb][i] *= wp;
#pragma unroll
      for (int s2 = 0; s2 < 2; ++s2) {
        const bf16x8 a = *(const bf16x8*)(sKT + (32 * mb + r) * 40 + 16 * s2 + 8 * h);
        const bf16x8 b = *(const bf16x8*)(sVT + (32 * w + r) * 40 + 16 * s2 + 8 * h);
        cacc[mb] = MFMA(a, b, cacc[mb]);
      }
    }
    }
    __syncthreads();
    if (tid < 128) {
      float s = 0.f;
#pragma unroll
      for (int e = 0; e < 32; ++e) s += bf2f(sKT[tid * 40 + e]);
      sN[tid] = wp * sN[tid] + s;
    }
    m = blast + Mlast;
  }
}

__device__ __forceinline__ void gla_item(const Ctx cx, CParams& p, int item, char* smem) {
  const int tid = cx.tid, lane = tid & 63, w = tid >> 6, r = lane & 31, h = lane >> 5;
  const int bl = item >> 3, head = (item >> 1) & 3, dir = item & 1;
  const int base = bl * TPS;
  u16* sQ = (u16*)smem;
  u16* sK = sQ + 32 * 72;
  u16* sKT = sK + 32 * 72;
  u16* sVT = sKT + 64 * 40;
  float* sLa = (float*)(sVT + 128 * 40);
  float* sW2 = sLa + 32 * 64;
  float* sBi = sW2 + 16 * 64;
  const u16* Z = p.BIG;
  u16* Y = p.BIG + (size_t)R * ZW + (size_t)(2 + dir) * R * 512;
  for (int i = tid; i < 16 * 64; i += NTHR) sW2[i] = p.ev_gla_w2[((size_t)dir * 16 + (i >> 6)) * 256 + head * 64 + (i & 63)];
  if (tid < 64) sBi[tid] = p.ev_gla_b[dir * 256 + head * 64 + tid];
  f32x16 sacc[2];
#pragma unroll
  for (int a = 0; a < 2; ++a)
#pragma unroll
    for (int i = 0; i < 16; ++i) sacc[a][i] = 0.f;
  const bool act = tid < 256;
  const int lr = (tid >> 3) & 31, lc = tid & 7;
  for (int ch = 0; ch < TPS / 32; ++ch) {
    const int p0 = ch * 32;
    __syncthreads();
    uint4 gq, gk, v0, v1;
    if (act) {
      const int grow = scan_row(base, dir, p0 + lr);
      const u16* zr = Z + (size_t)grow * ZW;
      gq = *(const uint4*)(zr + 2064 + head * 64 + lc * 8);
      gk = *(const uint4*)(zr + 2320 + head * 64 + lc * 8);
      v0 = *(const uint4*)(zr + 2576 + head * 128 + lc * 8);
      v1 = *(const uint4*)(zr + 2576 + head * 128 + lc * 8 + 64);
      float gl[16];
      unpack8(*(const uint4*)(zr + 3600 + dir * 16), gl); unpack8(*(const uint4*)(zr + 3600 + dir * 16 + 8), gl + 8);
#pragma unroll
      for (int e = 0; e < 8; ++e) {
        const int c = lc * 8 + e;
        float xv = sBi[c];
#pragma unroll
        for (int q = 0; q < 16; ++q) xv += gl[q] * sW2[q * 64 + c];
        sLa[lr * 64 + c] = logsigf_(xv) * (1.f / 16.f);
      }
    }
    __syncthreads();
    if (tid < 64) { float b = 0.f; for (int t = 0; t < 32; ++t) { b += sLa[t * 64 + tid]; sLa[t * 64 + tid] = b; } }
    __syncthreads();
    if (act) {
      float qf[8], kf[8], o[8];
      unpack8(gq, qf); unpack8(gk, kf);
#pragma unroll
      for (int e = 0; e < 8; ++e) { const float bb = sLa[lr * 64 + lc * 8 + e]; qf[e] *= 0.125f * __expf(bb); kf[e] *= __expf(-bb); }
      *(uint4*)(sQ + lr * 72 + lc * 8) = pack8(qf);
      *(uint4*)(sK + lr * 72 + lc * 8) = pack8(kf);
#pragma unroll
      for (int e = 0; e < 8; ++e) sKT[(lc * 8 + e) * 40 + lr] = f2bf(kf[e]);
      (void)o;
      const u16* pv0 = (const u16*)&v0; const u16* pv1 = (const u16*)&v1;
#pragma unroll
      for (int e = 0; e < 8; ++e) { sVT[(lc * 8 + e) * 40 + lr] = pv0[e]; sVT[(lc * 8 + 64 + e) * 40 + lr] = pv1[e]; }
    }
    __syncthreads();
    if (act) {
    f32x16 st;
#pragma unroll
    for (int i = 0; i < 16; ++i) st[i] = 0.f;
#pragma unroll
    for (int ks = 0; ks < 4; ++ks) {
      const bf16x8 a = *(const bf16x8*)(sK + r * 72 + 16 * ks + 8 * h);
      const bf16x8 b = *(const bf16x8*)(sQ + r * 72 + 16 * ks + 8 * h);
      st = MFMA(a, b, st);
    }
#pragma unroll
    for (int i = 0; i < 16; ++i) { if (crow(i, h) > r) st[i] = 0.f; }
    f32x16 o;
#pragma unroll
    for (int i = 0; i < 16; ++i) o[i] = 0.f;
#pragma unroll
    for (int mb = 0; mb < 2; ++mb)
#pragma unroll
      for (int s2 = 0; s2 < 2; ++s2) {
        const bf16x8 cb = pack_step(sacc[mb], s2);
        const u16* qp = sQ + r * 72 + 32 * mb + 16 * s2 + 4 * h;
        const bf16x8 a = cat4(*(const s16x4*)qp, *(const s16x4*)(qp + 8));
        o = MFMA(a, cb, o);
      }
#pragma unroll
    for (int s2 = 0; s2 < 2; ++s2) {
      const bf16x8 a = pack_step(st, s2);
      const u16* vp = sVT + (32 * w + r) * 40 + 16 * s2 + 4 * h;
      const bf16x8 b = cat4(*(const s16x4*)vp, *(const s16x4*)(vp + 8));
      o = MFMA(a, b, o);
    }
#pragma unroll
    for (int i = 0; i < 16; ++i) {
      const int row = scan_row(base, dir, p0 + crow(i, h));
      Y[(size_t)row * 512 + head * 128 + 32 * w + r] = f2bf(o[i]);
    }
#pragma unroll
    for (int mb = 0; mb < 2; ++mb) {
#pragma unroll
      for (int s2 = 0; s2 < 2; ++s2) {
        const bf16x8 a = *(const bf16x8*)(sKT + (32 * mb + r) * 40 + 16 * s2 + 8 * h);
        const bf16x8 b = *(const bf16x8*)(sVT + (32 * w + r) * 40 + 16 * s2 + 8 * h);
        sacc[mb] = MFMA(a, b, sacc[mb]);
      }
#pragma unroll
      for (int i = 0; i < 16; ++i) sacc[mb][i] *= __expf(sLa[31 * 64 + 32 * mb + crow(i, h)]);
    }
    }
  }
}

__device__ __forceinline__ void ph_scan0(const Ctx cx, CParams& p, char* smem) {
  for (int it = cx.bid; it < 2 * SPG * 8; it += gridDim.x) {
    __syncthreads();
    if (it < SPG * 8) mlstm_item(cx, p, it, smem); else gla_item(cx, p, it - SPG * 8, smem);
  }
}

__device__ __forceinline__ void ph_evout(const Ctx cx, CParams& p, int g) {
  const int lane = cx.tid & 63;
  const int gw = cx.bid * NWV + (cx.tid >> 6), nw = gridDim.x * NWV;
  const u16* Yb = p.BIG + (size_t)R * ZW;
  for (int row = gw; row < R; row += nw) {
    const int c0 = lane * 16;
    const int part = c0 >> 9, cc = c0 & 511;
    const u16* yf = Yb + ((size_t)(2 * part) * R + row) * 512 + cc;
    const u16* yb = Yb + ((size_t)(2 * part + 1) * R + row) * 512 + cc;
    float a[16], b[16];
    unpack8(*(const uint4*)yf, a); unpack8(*(const uint4*)(yf + 8), a + 8);
    unpack8(*(const uint4*)yb, b); unpack8(*(const uint4*)(yb + 8), b + 8);
    float ss = 0.f;
#pragma unroll
    for (int e = 0; e < 16; ++e) { a[e] += b[e]; ss += a[e] * a[e]; }
    ss += __shfl_xor(ss, 1); ss += __shfl_xor(ss, 2); ss += __shfl_xor(ss, 4);
    const float rstd = rsqrtf(ss * (1.f / 128.f) + 1e-6f);
    const u16* zg = p.BIG + (size_t)row * ZW + (part ? 3088 : 1536) + cc;
    float gt[16];
    unpack8(*(const uint4*)zg, gt); unpack8(*(const uint4*)(zg + 8), gt + 8);
#pragma unroll
    for (int e = 0; e < 16; ++e) {
      const float gv = part ? siluf_(gt[e]) : sigmoidf_(gt[e]);
      a[e] = a[e] * rstd * p.ev_head_g[c0 + e] * gv;
    }
    *(uint4*)(p.H + (size_t)row * D + c0) = pack8(a);
    *(uint4*)(p.H + (size_t)row * D + c0 + 8) = pack8(a + 8);
  }
}

__device__ __forceinline__ void ph_ffnact(const Ctx cx, CParams& p, int g, int layer, bool lat_only) {
  const float* cw = p.ffn_conv_w + (size_t)layer * 9 * DFF;
  const float* cb = p.ffn_conv_b + (size_t)layer * DFF;
  const size_t total = (size_t)R * 352;
  for (size_t i = (size_t)cx.bid * NTHR + cx.tid; i < total; i += (size_t)gridDim.x * NTHR) {
    const int row = (int)(i / 352), f0 = ((int)(i % 352)) * 8;
    int b, pos; rowinfo(g, row, b, pos);
    if (lat_only && pos < CTX) continue;
    float acc[8];
#pragma unroll
    for (int e = 0; e < 8; ++e) acc[e] = cb[f0 + e];
    u16* gu = p.BIG + (size_t)row * GUW;
    if (pos < CTX) {
#pragma unroll
      for (int dw = 0; dw < 3; ++dw) {
        const int pp = pos + dw - 1;
        if (pp < 0 || pp >= CTX) continue;
        float v[8]; unpack8(*(const uint4*)(gu + (ptrdiff_t)(dw - 1) * GUW + f0), v);
#pragma unroll
        for (int e = 0; e < 8; ++e) acc[e] += v[e] * cw[(3 + dw) * DFF + f0 + e];
      }
    } else {
      const int lp = pos - CTX, gr = lp >> 6, gc = lp & 63;
#pragma unroll
      for (int dh = 0; dh < 3; ++dh) {
        const int rr = gr + dh - 1;
        if (rr < 0 || rr >= 32) continue;
#pragma unroll
        for (int dw = 0; dw < 3; ++dw) {
          const int c2 = gc + dw - 1;
          if (c2 < 0 || c2 >= 64) continue;
          float v[8]; unpack8(*(const uint4*)(gu + (ptrdiff_t)((dh - 1) * 64 + (dw - 1)) * GUW + f0), v);
#pragma unroll
          for (int e = 0; e < 8; ++e) acc[e] += v[e] * cw[(dh * 3 + dw) * DFF + f0 + e];
        }
      }
    }
    float up[8]; unpack8(*(const uint4*)(gu + DFF + f0), up);
#pragma unroll
    for (int e = 0; e < 8; ++e) {
      const float xg = acc[e];
      const float t = tanhf(0.7978845608028654f * (xg + 0.044715f * xg * xg * xg));
      up[e] *= 0.5f * xg * (1.f + t);
    }
    *(uint4*)(gu + DFF + f0) = pack8(up);
  }
}

__device__ __forceinline__ void ph_xx(const Ctx cx, CParams& p, int g) {
  const size_t total = (size_t)R * 128;
  for (size_t i = (size_t)cx.bid * NTHR + cx.tid; i < total; i += (size_t)gridDim.x * NTHR) {
    const int row = (int)(i >> 7), c0 = ((int)(i & 127)) * 8;
    int b, pos; rowinfo(g, row, b, pos);
    const int q = c0 >> 8;
    int off = 0; bool ok;
    if (pos < CTX) {
      if ((q & 1) == 0) { off = -1; ok = pos > 0; } else { off = 1; ok = pos < CTX - 1; }
    } else {
      const int lp = pos - CTX, gr = lp >> 6, gc = lp & 63;
      if (q == 0) { off = -1; ok = gc > 0; }
      else if (q == 1) { off = 1; ok = gc < 63; }
      else if (q == 2) { off = -64; ok = gr > 0; }
      else { off = 64; ok = gr < 31; }
    }
    float hc[8], hs[8];
    unpack8(*(const uint4*)(p.H + (size_t)row * D + c0), hc);
    if (ok) unpack8(*(const uint4*)(p.H + (size_t)(row + off) * D + c0), hs); else { for (int e = 0; e < 8; ++e) hs[e] = 0.f; }
#pragma unroll
    for (int e = 0; e < 8; ++e) hs[e] -= hc[e];
    *(uint4*)(p.QK + (size_t)row * D + c0) = pack8(hs);
  }
}

__device__ __forceinline__ void ph_rwprep(const Ctx cx, CParams& p) {
  const int lane = cx.tid & 63;
  const int gw = cx.bid * NWV + (cx.tid >> 6), nw = gridDim.x * NWV;
  const size_t RS = (size_t)R * D;
  float* CS = (float*)p.LR;
  for (int row = gw; row < R; row += nw) {
    const int c0 = lane * 16;
    const size_t o = (size_t)row * D + c0;
    float rr[16], kk[16], aa[16], km[16], ka[16];
    unpack8(*(const uint4*)(p.BIG + o), rr); unpack8(*(const uint4*)(p.BIG + o + 8), rr + 8);
    unpack8(*(const uint4*)(p.BIG + RS + o), kk); unpack8(*(const uint4*)(p.BIG + RS + o + 8), kk + 8);
    unpack8(*(const uint4*)(p.BIG + 3 * RS + o), aa); unpack8(*(const uint4*)(p.BIG + 3 * RS + o + 8), aa + 8);
    float ss = 0.f;
#pragma unroll
    for (int e = 0; e < 16; ++e) {
      km[e] = bf2f(f2bf(kk[e] * (1.f + (aa[e] - 1.f) * p.rw_kvec[D + c0 + e])));
      kk[e] *= p.rw_kvec[c0 + e]; ss += kk[e] * kk[e];
    }
    ss += __shfl_xor(ss, 1); ss += __shfl_xor(ss, 2);
    const float inv = 1.f / fmaxf(sqrtf(ss), 1e-12f);
    float c1 = 0.f, c2 = 0.f;
#pragma unroll
    for (int e = 0; e < 16; ++e) {
      kk[e] *= inv; ka[e] = bf2f(f2bf(kk[e] * aa[e]));
      c1 += ka[e] * rr[e]; c2 += km[e] * rr[e];
    }
    c1 += __shfl_xor(c1, 1); c1 += __shfl_xor(c1, 2);
    c2 += __shfl_xor(c2, 1); c2 += __shfl_xor(c2, 2);
    *(uint4*)(p.BIG + RS + o) = pack8(kk); *(uint4*)(p.BIG + RS + o + 8) = pack8(kk + 8);
    *(uint4*)(p.BIG + 3 * RS + o) = pack8(ka); *(uint4*)(p.BIG + 3 * RS + o + 8) = pack8(ka + 8);
    *(uint4*)(p.H + o) = pack8(km); *(uint4*)(p.H + o + 8) = pack8(km + 8);
    if ((lane & 3) == 0) { float2 c; c.x = c1; c.y = c2; *(float2*)(CS + (size_t)row * 32 + (lane >> 2) * 2) = c; }
  }
}

__device__ __forceinline__ void ph_rwscan(const Ctx cx, CParams& p) {
  const int lane = cx.tid & 63, w = cx.tid >> 6;
  if (w >= 4) return;
  const int vq = lane >> 3, kq = lane & 7, hf = w & 1;
  const size_t RS = (size_t)R * D;
  const u16* Rb = p.BIG; const u16* KKb = p.BIG + RS; const u16* Vb = p.BIG + 2 * RS; const u16* KAb = p.BIG + 3 * RS; const u16* KMb = p.H;
  const float* CS = (const float*)p.LR;
  const int nblk = (SPG * 16 * 2) / 2;
  for (int bi = cx.bid; bi < nblk; bi += gridDim.x) {
    const int item = bi * 2 + (w >> 1);
    const int bl = item >> 5, head = (item >> 1) & 15, dir = item & 1;
    const u16* Wb = p.BIG + (size_t)(4 + dir) * RS;
    u16* Yb = (u16*)p.YO + (size_t)dir * RS;
    const int base = bl * TPS;
    const int colk = head * 64 + kq * 8, colv = head * 64 + hf * 32 + vq * 4;
    float S[4][8];
#pragma unroll
    for (int i = 0; i < 4; ++i)
#pragma unroll
      for (int e = 0; e < 8; ++e) S[i][e] = 0.f;
    char* dummy = (char*)p.LR + (size_t)R * 128 + (cx.tid & 511) * 8;
    constexpr int PF = 3;
    uint4 qr[PF], qkk[PF], qka[PF], qkm[PF], qw[PF]; uint2 qv[PF]; float2 qcs[PF]; int qrow[PF];
#define RW_LOAD(j, ps_) do { const int row_ = scan_row(base, dir, (ps_)); qrow[j] = row_; \
      const unsigned ok_ = (unsigned)(row_ * D + colk) * 2u, ov_ = (unsigned)(row_ * D + colv) * 2u, oc_ = (unsigned)(row_ * 32 + head * 2) * 4u; \
      qr[j] = *(const uint4*)((const char*)Rb + ok_); qkk[j] = *(const uint4*)((const char*)KKb + ok_); \
      qka[j] = *(const uint4*)((const char*)KAb + ok_); qkm[j] = *(const uint4*)((const char*)KMb + ok_); \
      qw[j] = *(const uint4*)((const char*)Wb + ok_); qv[j] = *(const uint2*)((const char*)Vb + ov_); \
      qcs[j] = *(const float2*)((const char*)CS + oc_); } while (0)
#pragma unroll
    for (int j = 0; j < PF; ++j) RW_LOAD(j, j);
    for (int ps0 = 0; ps0 < TPS; ps0 += PF) {
#pragma unroll
    for (int j = 0; j < PF; ++j) {
      const uint4 cr_ = qr[j], ckk = qkk[j], cka = qka[j], ckm = qkm[j], cw = qw[j]; const uint2 cv = qv[j]; const float2 cs = qcs[j];
      const int crow_ = qrow[j];
      { const int pn_ = ps0 + PF + j; RW_LOAD(j, pn_ < TPS ? pn_ : TPS - 1); }
      float wr[8], kk[8], wm1[8], vv[4], kka[8], km[8];
      unpack8(cr_, wr); unpack8(ckk, kk); unpack8(cka, kka); unpack8(ckm, km); unpack8(cw, wm1);
      vv[0] = lo16(cv.x); vv[1] = hi16(cv.x); vv[2] = lo16(cv.y); vv[3] = hi16(cv.y);
#pragma unroll
      for (int e = 0; e < 8; ++e) wr[e] += wr[e] * wm1[e];
      float sa[4], yo[4];
#pragma unroll
      for (int i = 0; i < 4; ++i) {
        float s = 0.f, t = 0.f;
#pragma unroll
        for (int e = 0; e < 8; ++e) { s += S[i][e] * kk[e]; t += S[i][e] * wr[e]; }
        sa[i] = s; yo[i] = t;
      }
#pragma unroll
      for (int i = 0; i < 4; ++i) { sa[i] = -red8(sa[i]); yo[i] = red8(yo[i]); }
#pragma unroll
      for (int i = 0; i < 4; ++i) {
#pragma unroll
        for (int e = 0; e < 8; ++e) {
          float t = S[i][e] + S[i][e] * wm1[e];
          t += sa[i] * kka[e];
          t += vv[i] * km[e];
          S[i][e] = t;
        }
        yo[i] += sa[i] * cs.x + vv[i] * cs.y;
      }
      { uint2 o; o.x = pack2(yo[0], yo[1]); o.y = pack2(yo[2], yo[3]);
        char* dst_ = (kq == 0) ? (char*)Yb + (unsigned)(crow_ * D + colv) * 2u : dummy;
        *(uint2*)dst_ = o; }
    }
    }
#undef RW_LOAD
  }
}

__device__ __forceinline__ void ph_rwout(const Ctx cx, CParams& p, int g) {
  const int lane = cx.tid & 63;
  const int gw = cx.bid * NWV + (cx.tid >> 6), nw = gridDim.x * NWV;
  const size_t RS = (size_t)R * D;
  for (int row = gw; row < R; row += nw) {
    int b, pos; rowinfo(g, row, b, pos);
    if (pos < CTX) continue;
    const int c0 = lane * 16;
    const size_t o = (size_t)row * D + c0;
    float yf[16], yb[16], rr[16], kk[16], vv[16], gg[16];
    const u16* Yy = (const u16*)p.YO;
    unpack8(*(const uint4*)(Yy + o), yf); unpack8(*(const uint4*)(Yy + o + 8), yf + 8);
    unpack8(*(const uint4*)(Yy + RS + o), yb); unpack8(*(const uint4*)(Yy + RS + o + 8), yb + 8);
    unpack8(*(const uint4*)(p.BIG + o), rr); unpack8(*(const uint4*)(p.BIG + o + 8), rr + 8);
    unpack8(*(const uint4*)(p.H + o), kk); unpack8(*(const uint4*)(p.H + o + 8), kk + 8);
    unpack8(*(const uint4*)(p.BIG + 2 * RS + o), vv); unpack8(*(const uint4*)(p.BIG + 2 * RS + o + 8), vv + 8);
    unpack8(*(const uint4*)(p.QK + o), gg); unpack8(*(const uint4*)(p.QK + o + 8), gg + 8);
    float s1 = 0.f, bon = 0.f;
#pragma unroll
    for (int e = 0; e < 16; ++e) {
      yf[e] += yb[e]; s1 += yf[e];
      bon += rr[e] * kk[e] * p.rw_kvec[2 * D + c0 + e];
    }
    s1 += __shfl_xor(s1, 1); s1 += __shfl_xor(s1, 2);
    bon += __shfl_xor(bon, 1); bon += __shfl_xor(bon, 2);
    const float mu = s1 * (1.f / 64.f);
    float s2 = 0.f;
#pragma unroll
    for (int e = 0; e < 16; ++e) { const float d = yf[e] - mu; s2 += d * d; }
    s2 += __shfl_xor(s2, 1); s2 += __shfl_xor(s2, 2);
    const float rstd = rsqrtf(s2 * (1.f / 64.f) + 64e-5f);
#pragma unroll
    for (int e = 0; e < 16; ++e) {
      const float yn = (yf[e] - mu) * rstd * p.rw_lnx[c0 + e] + p.rw_lnx[D + c0 + e];
      yf[e] = (yn + bon * vv[e]) * gg[e];
    }
    *(uint4*)(p.H + o) = pack8(yf);
    *(uint4*)(p.H + o + 8) = pack8(yf + 8);
  }
}

__global__ void __launch_bounds__(NTHR) fwd_megakernel(Params p_arg) {
  cg::grid_group grid = cg::this_grid();
  __shared__ __attribute__((aligned(1024))) char smem[2 * STAGE_B];
  const size_t RS = (size_t)R * D;
  (void)RS;
  {
    Ctx cx; cx.tid = threadIdx.x; cx.bid = blockIdx.x;
    CParams* pp = (CParams*)__builtin_amdgcn_kernarg_segment_ptr();
    ph_prologue(cx, *pp, (float*)smem);
  }
  grid.sync();
#pragma nounroll
  for (int it2 = 0; it2 < NG * NPH * 2; ++it2) {
    const int it = it2 >> 1;
    const int g = it / NPH, ph = it - g * NPH;
    if ((it2 & 1) && !((PROBE_MASK >> ph) & 1u)) continue;
    Ctx cx;
    { int t_ = threadIdx.x, b_ = blockIdx.x; asm volatile("" : "+v"(t_), "+s"(b_)); cx.tid = t_; cx.bid = b_; }
    CParams* pp = (CParams*)__builtin_amdgcn_kernarg_segment_ptr();
    asm volatile("" : "+s"(pp));
    CParams& p = *pp;
    switch (ph) {
      case 0: ph_norm0(cx, p, g); break;
      case 1: gemm256(cx, p.H, p.H, 1 << 30, D, p.wt_in, D, ZW / 256, false, EpBf16{p.BIG, ZW}, smem); break;
      case 2: ph_qkconv(cx, p, g); break;
      case 3: ph_scan0(cx, p, smem); break;
      case 4: ph_evout(cx, p, g); break;
      case 5: gemm256(cx, p.H, p.H, 1 << 30, D, p.wt_out, D, 4, false, EpF32{p.YO, D}, smem); break;
      case 6: ph_resid(cx, p, g, 0, 0, false); break;
      case 7: gemm256(cx, p.H, p.H, 1 << 30, D, p.wt_up, D, GUW / 256, false, EpBf16{p.BIG, GUW}, smem); break;
      case 8: ph_ffnact(cx, p, g, 0, false); break;
      case 9: gemm256(cx, p.BIG + DFF, p.BIG + DFF, 1 << 30, GUW, p.wt_down, DFF, 4, false, EpF32{p.YO, D}, smem); break;
      case 10: ph_resid(cx, p, g, 0, 1, false); break;
      case 11: ph_xx(cx, p, g); break;
      case 12: gemm256(cx, p.H, p.QK, D, D, p.wt_1, K1, N1 / 256, false, EpRw1{p.BIG, p.LR}, smem); break;
      case 13: gemm256(cx, p.LR, p.LR, 1 << 30, K2, p.wt_2, K2, N2 / 256, false, EpRw2{p.BIG, p.QK, p.rw_w0, p.rw_a0}, smem); break;
      case 14: ph_rwprep(cx, p); break;
      case 15: ph_rwscan(cx, p); break;
      case 16: ph_rwout(cx, p, g); break;
      case 17: gemm256(cx, p.H, p.H, 1 << 30, D, p.wt_o, D, 4, true, EpF32{p.YO, D}, smem); break;
      case 18: ph_resid(cx, p, g, 1, 0, true); break;
      case 19: gemm256(cx, p.H, p.H, 1 << 30, D, p.wt_up + (size_t)GUW * D, D, GUW / 256, true, EpBf16{p.BIG, GUW}, smem); break;
      case 20: ph_ffnact(cx, p, g, 1, true); break;
      case 21: gemm256(cx, p.BIG + DFF, p.BIG + DFF, 1 << 30, GUW, p.wt_down + (size_t)D * DFF, DFF, 4, true, EpF32{p.YO, D}, smem); break;
      default: ph_resid(cx, p, g, 1, 1, true); break;
    }
    grid.sync();
  }
}

extern "C" void kernel_launch(void* const* d_in, const int* in_sizes, int n_in, void* d_out, int out_size, void* d_ws,
                              size_t ws_size, hipStream_t stream) {
  static int grid_blocks = 0;
  if (!grid_blocks) {
    int dev = 0, cus = 0, per_cu = 0;
    hipGetDevice(&dev);
    hipDeviceGetAttribute(&cus, hipDeviceAttributeMultiprocessorCount, dev);
    hipOccupancyMaxActiveBlocksPerMultiprocessor(&per_cu, fwd_megakernel, NTHR, 0);
    if (per_cu > 1) per_cu = 1;
    if (per_cu < 1) per_cu = 1;
    grid_blocks = cus * per_cu;
  }
  Params p{};
  const float** f = (const float**)&p;
  for (int i = 0; i < 32; ++i) f[i] = (const float*)d_in[i];
  p.out = (float*)d_out;
  char* ws = (char*)d_ws;
  size_t off = 0;
  auto take = [&](size_t bytes) { char* q = ws + off; off += (bytes + 255) & ~(size_t)255; return q; };
  p.wt_in = (u16*)take((size_t)ZW * D * 2);
  p.wt_out = (u16*)take((size_t)D * D * 2);
  p.wt_up = (u16*)take((size_t)2 * GUW * D * 2);
  p.wt_down = (u16*)take((size_t)2 * D * DFF * 2);
  p.wt_o = (u16*)take((size_t)D * D * 2);
  p.wt_1 = (u16*)take((size_t)N1 * K1 * 2);
  p.wt_2 = (u16*)take((size_t)N2 * K2 * 2);
  p.mod = (float*)take((size_t)2 * 33 * 6144 * 4);
  p.xc = (float*)take((size_t)NB * CTX * D * 4);
  p.H = (u16*)take((size_t)R * D * 2);
  p.BIG = (u16*)take((size_t)6 * R * D * 2);
  p.QK = (u16*)take((size_t)R * D * 2);
  p.YO = (float*)take((size_t)R * D * 4);
  p.LR = (u16*)take((size_t)R * K2 * 2);
  if (off > ws_size) { fprintf(stderr, "workspace too small: need %zu have %zu\n", off, ws_size); return; }
  void* args[] = {&p};
  hipError_t e = hipLaunchCooperativeKernel((void*)fwd_megakernel, dim3(grid_blocks), dim3(NTHR), args, 0, stream);
  if (e != hipSuccess) fprintf(stderr, "cooperative launch failed: %s (grid %d)\n", hipGetErrorString(e), grid_blocks);
}
```

```cpp
#include <hip/hip_runtime.h>
#include <hip/hip_cooperative_groups.h>
#include <cstdio>
namespace cg = cooperative_groups;

typedef unsigned short u16;
using bf16x8 = __attribute__((ext_vector_type(8))) short;
using s16x4  = __attribute__((ext_vector_type(4))) short;
using f32x16 = __attribute__((ext_vector_type(16))) float;
#define DI __device__ __forceinline__
#define MFMA(a, b, c) __builtin_amdgcn_mfma_f32_32x32x16_bf16((a), (b), (c), 0, 0, 0)

constexpr int D = 1024, NB = 32, SEQ = 2048, CTX = 256, TPS = 2304;
constexpr int NG = 2, SPG = 16, R = SPG * TPS;
constexpr int ZW = 3840;
constexpr int DFF = 2816, GUW = 5632;
constexpr int NTHR = 512, NWV = NTHR / 64, NPH = 23;
constexpr int N1 = 3584, K1 = 2048, N2 = 4096, K2 = 320;
#ifndef PROBE_MASK_V
#define PROBE_MASK_V 0u
#endif
constexpr unsigned PROBE_MASK = PROBE_MASK_V;

struct Ctx { int tid, bid; };
struct Params {
  const float *x, *c, *ctx, *c_ctx, *w_mod, *b_mod, *norm_g, *ffn_w_up, *ffn_conv_w, *ffn_conv_b, *ffn_w_down,
      *ev_w_in, *ev_b_gates, *ev_conv_w, *ev_conv_b, *ev_gla_w2, *ev_gla_b, *ev_head_g, *ev_w_out,
      *rw_mu, *rw_w_rkv, *rw_w_o, *rw_w0, *rw_w1, *rw_w2, *rw_a0, *rw_a1, *rw_a2, *rw_g1, *rw_g2, *rw_kvec, *rw_lnx;
  float* out;
  u16 *wt_in, *wt_out, *wt_up, *wt_down, *wt_o, *wt_1, *wt_2;
  float* mod; float* xc;
  u16* H; u16* BIG; u16* QK; float* YO; u16* LR;
};

typedef const __attribute__((address_space(4))) Params CParams;

DI float bf2f(u16 v) { return __uint_as_float(((unsigned)v) << 16); }
typedef __bf16 bf16x2_t __attribute__((ext_vector_type(2)));
typedef float f32x2_t __attribute__((ext_vector_type(2)));
DI unsigned pack2(float a, float b) { f32x2_t v; v.x = a; v.y = b; return __builtin_bit_cast(unsigned, __builtin_convertvector(v, bf16x2_t)); }
DI u16 f2bf(float f) { return (u16)(pack2(f, 0.f) & 0xffffu); }
DI float lo16(unsigned u) { return __uint_as_float(u << 16); }
DI float hi16(unsigned u) { return __uint_as_float(u & 0xffff0000u); }
DI void unpack8(const uint4& v, float* o) {
  o[0] = lo16(v.x); o[1] = hi16(v.x); o[2] = lo16(v.y); o[3] = hi16(v.y);
  o[4] = lo16(v.z); o[5] = hi16(v.z); o[6] = lo16(v.w); o[7] = hi16(v.w);
}
DI uint4 pack8(const float* o) { uint4 v; v.x = pack2(o[0], o[1]); v.y = pack2(o[2], o[3]); v.z = pack2(o[4], o[5]); v.w = pack2(o[6], o[7]); return v; }
DI int crow(int reg, int h) { return (reg & 3) + 8 * (reg >> 2) + 4 * h; }
DI float wsum(float v) { for (int o = 32; o; o >>= 1) v += __shfl_xor(v, o); return v; }
DI float sigmoidf_(float x) { return 1.f / (1.f + __expf(-x)); }
DI float logsigf_(float x) { return fminf(x, 0.f) - log1pf(__expf(-fabsf(x))); }
DI float siluf_(float x) { return x / (1.f + __expf(-x)); }
DI bf16x8 cat4(s16x4 lo, s16x4 hi) { return __builtin_shufflevector(lo, hi, 0, 1, 2, 3, 4, 5, 6, 7); }
DI bf16x8 pack_step(const f32x16& x, int s) {
  uint4 v;
  v.x = pack2(x[8 * s + 0], x[8 * s + 1]); v.y = pack2(x[8 * s + 2], x[8 * s + 3]);
  v.z = pack2(x[8 * s + 4], x[8 * s + 5]); v.w = pack2(x[8 * s + 6], x[8 * s + 7]);
  return __builtin_bit_cast(bf16x8, v);
}
DI float dppf(float x, int) { return x; }
#define DPP_F(x, ctrl) __int_as_float(__builtin_amdgcn_update_dpp(0, __float_as_int(x), (ctrl), 0xF, 0xF, true))
DI float red8(float x) {
  x += DPP_F(x, 0x141);
  x += DPP_F(x, 0xB1);
  x += DPP_F(x, 0x4E);
  return x;
}

DI int scan_row(int base, int dir, int p) {
  if (dir == 0) return base + p;
  return (p < CTX) ? base + (CTX - 1 - p) : base + (TPS + CTX - 1 - p);
}

__device__ __forceinline__ void convert_job(const Ctx cx, const float* __restrict__ src, int K, int N, int Npad, u16* __restrict__ dst, int ldd, const float* __restrict__ mu, float* tile) {
  const int tx = cx.tid & 31, ty = cx.tid >> 5;
  const int tk = K >> 5, tn = Npad >> 5;
  for (int t = cx.bid; t < tk * tn; t += gridDim.x) {
    const int k0 = (t / tn) * 32, n0 = (t % tn) * 32;
#pragma unroll
    for (int i = 0; i < 2; ++i) {
      const int kk = k0 + ty + 16 * i, nn = n0 + tx;
      float v = (nn < N) ? src[(size_t)kk * N + nn] : 0.f;
      if (mu) v *= mu[kk];
      tile[(ty + 16 * i) * 33 + tx] = v;
    }
    __syncthreads();
#pragma unroll
    for (int i = 0; i < 2; ++i) {
      const int nn = n0 + ty + 16 * i, kk = k0 + tx;
      dst[(size_t)nn * ldd + kk] = f2bf(tile[tx * 33 + ty + 16 * i]);
    }
    __syncthreads();
  }
}

__device__ __forceinline__ void ph_mod(const Ctx cx, CParams& p, float* smem) {
  const int tid = cx.tid, lane = tid & 63, w = tid >> 6;
  float* sc = smem + w * (33 * 64);
  for (int u = cx.bid; u < 2 * 96; u += gridDim.x) {
    const int layer = u / 96, n = (u % 96) * 64 + lane;
    const float* W = p.w_mod + (size_t)layer * D * 6144;
    float acc[33];
#pragma unroll
    for (int i = 0; i < 33; ++i) acc[i] = 0.f;
    for (int kc = 0; kc < 2; ++kc) {
      const int k0 = w * 128 + kc * 64;
#pragma nounroll
      for (int cr = 0; cr < 33; ++cr) {
        const float v = (cr < 32) ? p.c[cr * D + k0 + lane] : p.c_ctx[k0 + lane];
        sc[cr * 64 + lane] = siluf_(v);
      }
      __syncthreads();
#pragma unroll 2
      for (int j = 0; j < 64; ++j) {
        const float wv = W[(size_t)(k0 + j) * 6144 + n];
#pragma unroll
        for (int cr = 0; cr < 33; ++cr) acc[cr] += sc[cr * 64 + j] * wv;
      }
      __syncthreads();
    }
#pragma unroll
    for (int cr = 0; cr < 33; ++cr) sc[cr * 64 + lane] = acc[cr];
    __syncthreads();
    if (w == 0) {
      const float bm = p.b_mod[layer * 6144 + n];
      for (int cr = 0; cr < 33; ++cr) {
        float s = 0.f;
#pragma unroll
        for (int q = 0; q < NWV; ++q) s += smem[q * 33 * 64 + cr * 64 + lane];
        p.mod[((size_t)layer * 33 + cr) * 6144 + n] = s + bm;
      }
    }
    __syncthreads();
  }
}

__device__ __forceinline__ void ph_prologue(const Ctx cx, CParams& p, float* smem) {
  ph_mod(cx, p, smem);
  convert_job(cx, p.ev_w_in, D, 3632, ZW, p.wt_in, D, nullptr, smem);
  convert_job(cx, p.ev_w_out, D, D, D, p.wt_out, D, nullptr, smem);
  for (int l = 0; l < 2; ++l) {
    convert_job(cx, p.ffn_w_up + (size_t)l * D * GUW, D, GUW, GUW, p.wt_up + (size_t)l * GUW * D, D, nullptr, smem);
    convert_job(cx, p.ffn_w_down + (size_t)l * DFF * D, DFF, D, D, p.wt_down + (size_t)l * D * DFF, DFF, nullptr, smem);
  }
  convert_job(cx, p.rw_w_o, D, D, D, p.wt_o, D, nullptr, smem);
  for (int half = 0; half < 2; ++half) {
    u16* dcol = p.wt_1 + half * D;
    const float* m0 = half ? p.rw_mu : nullptr;
    convert_job(cx, p.rw_w_rkv, D, D, D, dcol, K1, half ? m0 + 0 * D : nullptr, smem);
    convert_job(cx, p.rw_w_rkv + (size_t)D * D, D, D, D, dcol + (size_t)1024 * K1, K1, half ? m0 + 2 * D : nullptr, smem);
    convert_job(cx, p.rw_w_rkv + (size_t)2 * D * D, D, D, D, dcol + (size_t)2048 * K1, K1, half ? m0 + 3 * D : nullptr, smem);
    convert_job(cx, p.rw_w1, D, 64, 64, dcol + (size_t)3072 * K1, K1, half ? m0 + 1 * D : nullptr, smem);
    convert_job(cx, p.rw_w1 + D * 64, D, 64, 64, dcol + (size_t)3136 * K1, K1, half ? m0 + 1 * D : nullptr, smem);
    convert_job(cx, p.rw_a1, D, 64, 64, dcol + (size_t)3200 * K1, K1, half ? m0 + 4 * D : nullptr, smem);
    convert_job(cx, p.rw_g1, D, 128, 320, dcol + (size_t)3264 * K1, K1, half ? m0 + 5 * D : nullptr, smem);
  }
  for (size_t i = (size_t)cx.bid * NTHR + cx.tid; i < (size_t)N2 * K2; i += (size_t)gridDim.x * NTHR) {
    const int n = (int)(i / K2), c = (int)(i % K2), blk = n >> 10, nn = n & 1023;
    float v = 0.f;
    if (blk == 0) { if (c < 64) v = p.rw_w2[(size_t)c * D + nn]; }
    else if (blk == 1) { if (c >= 64 && c < 128) v = p.rw_w2[(size_t)(64 + c - 64) * D + nn]; }
    else if (blk == 2) { if (c >= 128 && c < 192) v = p.rw_a2[(size_t)(c - 128) * D + nn]; }
    else { if (c >= 192) v = p.rw_g2[(size_t)(c - 192) * D + nn]; }
    p.wt_2[i] = f2bf(v);
  }
}

DI void rowinfo(int g, int row, int& b, int& pos) { const int bl = row / TPS; pos = row - bl * TPS; b = g * SPG + bl; }

__device__ __forceinline__ void ph_norm0(const Ctx cx, CParams& p, int g) {
  const int lane = cx.tid & 63;
  const int gw = cx.bid * NWV + (cx.tid >> 6), nw = gridDim.x * NWV;
  for (int row = gw; row < R; row += nw) {
    int b, pos; rowinfo(g, row, b, pos);
    const float* src = (pos < CTX) ? p.ctx + ((size_t)(b * CTX + pos)) * D : p.x + ((size_t)(b * SEQ + pos - CTX)) * D;
    const float* md = p.mod + ((size_t)(pos < CTX ? 32 : b)) * 6144;
    float4 v[4]; float ss = 0.f;
#pragma unroll
    for (int j = 0; j < 4; ++j) { v[j] = ((const float4*)src)[j * 64 + lane]; ss += v[j].x * v[j].x + v[j].y * v[j].y + v[j].z * v[j].z + v[j].w * v[j].w; }
    ss = wsum(ss);
    const float rstd = rsqrtf(ss * (1.f / D) + 1e-6f);
#pragma unroll
    for (int j = 0; j < 4; ++j) {
      const int col = j * 256 + lane * 4;
      const float4 gg = *(const float4*)(p.norm_g + col);
      const float4 sh = *(const float4*)(md + col), sc = *(const float4*)(md + D + col);
      uint2 o;
      o.x = pack2(v[j].x * rstd * gg.x * (1.f + sc.x) + sh.x, v[j].y * rstd * gg.y * (1.f + sc.y) + sh.y);
      o.y = pack2(v[j].z * rstd * gg.z * (1.f + sc.z) + sh.z, v[j].w * rstd * gg.w * (1.f + sc.w) + sh.w);
      *(uint2*)(p.H + (size_t)row * D + col) = o;
    }
  }
}

__device__ __forceinline__ void ph_resid(const Ctx cx, CParams& p, int g, int layer, int which, bool lat_only) {
  const int lane = cx.tid & 63;
  const int gw = cx.bid * NWV + (cx.tid >> 6), nw = gridDim.x * NWV;
  const bool from_inputs = (layer == 0 && which == 0);
  const bool has_next = (which == 0) || (layer + 1 < 2);
  const float* ga = p.norm_g + (layer * 4 + (which ? 3 : 1)) * D;
  const float* gb = (which == 0) ? p.norm_g + (layer * 4 + 2) * D : p.norm_g + ((layer + 1) * 4 + 0) * D;
  for (int row = gw; row < R; row += nw) {
    int b, pos; rowinfo(g, row, b, pos);
    if (lat_only && pos < CTX) continue;
    const size_t ridx = (pos < CTX) ? ((size_t)(b * CTX + pos)) * D : ((size_t)(b * SEQ + pos - CTX)) * D;
    const float* src = from_inputs ? ((pos < CTX) ? p.ctx + ridx : p.x + ridx) : ((pos < CTX) ? p.xc + ridx : p.out + ridx);
    float* dst = (pos < CTX) ? p.xc + ridx : p.out + ridx;
    const int cr = (pos < CTX) ? 32 : b;
    const float* md = p.mod + ((size_t)layer * 33 + cr) * 6144;
    const float* mdn = (which == 0) ? md + 3 * D : p.mod + ((size_t)(layer + 1) * 33 + cr) * 6144;
    const float* gate = md + (which ? 5 : 2) * D;
    const u16* yo = (const u16*)p.YO + (size_t)row * D;
    float4 y[4], xv[4]; float ss = 0.f;
#pragma unroll
    for (int j = 0; j < 4; ++j) {
      const uint2 yb = ((const uint2*)yo)[j * 64 + lane];
      y[j].x = lo16(yb.x); y[j].y = hi16(yb.x); y[j].z = lo16(yb.y); y[j].w = hi16(yb.y);
      xv[j] = ((const float4*)src)[j * 64 + lane]; ss += y[j].x * y[j].x + y[j].y * y[j].y + y[j].z * y[j].z + y[j].w * y[j].w; }
    ss = wsum(ss);
    const float rstd = rsqrtf(ss * (1.f / D) + 1e-6f);
    float s2 = 0.f;
#pragma unroll
    for (int j = 0; j < 4; ++j) {
      const int col = j * 256 + lane * 4;
      const float4 g4 = *(const float4*)(ga + col), gt = *(const float4*)(gate + col);
      xv[j].x += gt.x * (y[j].x * rstd * g4.x); xv[j].y += gt.y * (y[j].y * rstd * g4.y);
      xv[j].z += gt.z * (y[j].z * rstd * g4.z); xv[j].w += gt.w * (y[j].w * rstd * g4.w);
      ((float4*)dst)[j * 64 + lane] = xv[j];
      s2 += xv[j].x * xv[j].x + xv[j].y * xv[j].y + xv[j].z * xv[j].z + xv[j].w * xv[j].w;
    }
    if (has_next) {
      s2 = wsum(s2);
      const float r2 = rsqrtf(s2 * (1.f / D) + 1e-6f);
#pragma unroll
      for (int j = 0; j < 4; ++j) {
        const int col = j * 256 + lane * 4;
        const float4 gg = *(const float4*)(gb + col);
        const float4 sh = *(const float4*)(mdn + col), sc = *(const float4*)(mdn + D + col);
        uint2 o;
        o.x = pack2(xv[j].x * r2 * gg.x * (1.f + sc.x) + sh.x, xv[j].y * r2 * gg.y * (1.f + sc.y) + sh.y);
        o.y = pack2(xv[j].z * r2 * gg.z * (1.f + sc.z) + sh.z, xv[j].w * r2 * gg.w * (1.f + sc.w) + sh.w);
        *(uint2*)(p.H + (size_t)row * D + col) = o;
      }
    }
  }
}

using f32x4 = __attribute__((ext_vector_type(4))) float;
using i32x4 = __attribute__((ext_vector_type(4))) int;
DI int lds_byte(int r, int c) {
  const int st = (r >> 4) * 2 + (c >> 5), ob = (r & 15) * 64 + (c & 31) * 2;
  return st * 1024 + (ob ^ (((ob >> 9) & 1) << 5));
}
DI void stage_rc(int b, int& Rr, int& Cc) {
  const int st = b >> 10, sb = b & 1023, swz = sb ^ (((sb >> 9) & 1) << 5);
  Rr = (st >> 1) * 16 + swz / 64;
  Cc = (st & 1) * 32 + (swz % 64) / 2;
}
constexpr int TILE_B = 256 * 64 * 2, STAGE_B = 2 * TILE_B;

template <bool RW1 = false, class EP>
__device__ __forceinline__ void gemm256(const Ctx cx, const u16* __restrict__ A0in, const u16* __restrict__ A1, int ksplit_in, int lda,
                        const u16* __restrict__ Bt, int Kin, int nN, bool lat_only, const EP& ep, char* shm, const u16* __restrict__ A2 = nullptr) {
  const int tid = cx.tid, wid = tid >> 6, lane = tid & 63, wr = wid >> 2, wc = wid & 3, fr = lane & 15, fq = lane >> 4;
  const int nM = lat_only ? SPG * 8 : R / 256;
  const int nwg = nM * nN;
  const int ldb = Kin;
  const int fragA = lds_byte(wr * 128 + fr, fq * 8), fragB = lds_byte(wc * 64 + fr, fq * 8);
  const int xcd = cx.bid & 7, slot = cx.bid >> 3, nslot = gridDim.x >> 3, per_xcd = (nM >> 3) * nN;
  (void)nwg;
  constexpr int GM = 4;
  const int nMx = nM >> 3;
  for (int u = slot; u < per_xcd; u += nslot) {
    const int grp = u / (GM * nN), fm = grp * GM, gsz = (nMx - fm) < GM ? (nMx - fm) : GM;
    const int rr_ = u - grp * (GM * nN);
    const int pn = rr_ / gsz, ml = fm + (rr_ - pn * gsz), pm = ml * 8 + xcd;
    const int brow = lat_only ? ((pm >> 3) * 9 + 1 + (pm & 7)) * 256 : pm * 256;
    const int bcol = pn * 256;
    const u16* A0 = A0in; int ksplit = ksplit_in, K = Kin;
    if constexpr (RW1) { if (pn < 12) { A0 = A2 + (size_t)(pn >> 2) * ((size_t)R * D); ksplit = 1 << 30; K = D; } }
    const int nt = K >> 6;
    const u16* Bb = Bt + (size_t)bcol * ldb;
    unsigned aoff[4], boff[4];
#pragma unroll
    for (int i = 0; i < 4; ++i) {
      int sR, sC; stage_rc(wid * 1024 + i * 8192 + lane * 16, sR, sC);
      aoff[i] = (unsigned)(((brow + sR) * lda + sC) * 2);
      boff[i] = (unsigned)((sR * ldb + sC) * 2);
    }
    f32x4 acc[8][4];
#pragma unroll
    for (int m = 0; m < 8; ++m)
#pragma unroll
      for (int n = 0; n < 4; ++n) acc[m][n] = (f32x4){0.f, 0.f, 0.f, 0.f};
#define G_STAGE(buf, kt) do { const int kb_ = (kt) * 64; const char* Ab_ = (const char*)((kb_ < ksplit) ? A0 + kb_ : A1 + (kb_ - ksplit)); \
    const char* Bb_ = (const char*)(Bb + kb_); \
    _Pragma("unroll") for (int i = 0; i < 4; ++i) { \
      __builtin_amdgcn_global_load_lds((const unsigned*)(Ab_ + aoff[i]), (__attribute__((address_space(3))) unsigned*)(shm + (buf) * STAGE_B + wid * 1024 + i * 8192), 16, 0, 0); \
      __builtin_amdgcn_global_load_lds((const unsigned*)(Bb_ + boff[i]), (__attribute__((address_space(3))) unsigned*)(shm + (buf) * STAGE_B + TILE_B + wid * 1024 + i * 8192), 16, 0, 0); } } while (0)
    G_STAGE(0, 0);
    asm volatile("s_waitcnt vmcnt(0)" ::: "memory");
    __syncthreads();
#pragma nounroll
    for (int t = 0; t < nt; ++t) {
      const int cur = t & 1;
      if (t + 1 < nt) G_STAGE(cur ^ 1, t + 1);
      const char* SAp = shm + cur * STAGE_B; const char* SBp = SAp + TILE_B;
      {
        bf16x8 At[8], Bf[4];
        const char* abase = SAp + fragA;
        const char* bbase = SBp + fragB;
#pragma unroll
        for (int n = 0; n < 4; ++n) Bf[n] = *(const bf16x8*)(bbase + n * 2048);
#pragma unroll
        for (int m = 0; m < 8; ++m) At[m] = *(const bf16x8*)(abase + m * 2048);
        __builtin_amdgcn_sched_barrier(0);
#pragma unroll
        for (int m = 0; m < 7; ++m) {
#pragma unroll
          for (int n = 0; n < 4; ++n) acc[m][n] = __builtin_amdgcn_mfma_f32_16x16x32_bf16(Bf[n], At[m], acc[m][n], 0, 0, 0);
          At[m] = *(const bf16x8*)(abase + m * 2048 + 1024);
          __builtin_amdgcn_sched_barrier(0);
        }
#pragma unroll
        for (int n = 0; n < 4; ++n) {
          acc[7][n] = __builtin_amdgcn_mfma_f32_16x16x32_bf16(Bf[n], At[7], acc[7][n], 0, 0, 0);
          Bf[n] = *(const bf16x8*)(bbase + n * 2048 + 1024);
          __builtin_amdgcn_sched_barrier(0);
        }
        At[7] = *(const bf16x8*)(abase + 7 * 2048 + 1024);
        __builtin_amdgcn_sched_barrier(0);
#pragma unroll
        for (int n = 0; n < 4; ++n) {
#pragma unroll
          for (int m = 0; m < 8; ++m) acc[m][n] = __builtin_amdgcn_mfma_f32_16x16x32_bf16(Bf[n], At[m], acc[m][n], 0, 0, 0);
          __builtin_amdgcn_sched_barrier(0);
        }
      }
      asm volatile("s_waitcnt vmcnt(0)" ::: "memory");
      __syncthreads();
    }
#undef G_STAGE
#pragma unroll
    for (int m = 0; m < 8; ++m) {
#pragma unroll
      for (int n = 0; n < 4; ++n) ep(brow + wr * 128 + m * 16 + fr, bcol + wc * 64 + n * 16 + fq * 4, acc[m][n]);
      __builtin_amdgcn_sched_barrier(0);
    }
  }
}

DI void st_bf4(u16* dst, f32x4 v) { uint2 o; o.x = pack2(v[0], v[1]); o.y = pack2(v[2], v[3]); *(uint2*)dst = o; }
struct EpBf16 { u16* dst; int ld; DI void operator()(int row, int col, f32x4 v) const { st_bf4(dst + (size_t)row * ld + col, v); } };
struct EpF32 { float* dst; int ld; DI void operator()(int row, int col, f32x4 v) const { *(f32x4*)(dst + (size_t)row * ld + col) = v; } };
DI float tanh_fast(float x) { x = fminf(fmaxf(x, -15.f), 15.f); const float t = __expf(2.f * x); return (t - 1.f) / (t + 1.f); }
DI float decay_m1(float lw) {
  const float el = __expf(-fabsf(lw));
  const float ls = fminf(lw, 0.f) - __logf(1.f + el);
  const float e = __expf(ls - 0.5f);
  return __expf(-e) - 1.f;
}
struct EpRw1 {
  u16* big; u16* lr;
  DI void operator()(int row, int col, f32x4 v) const {
    const int cu = __builtin_amdgcn_readfirstlane(col >> 6);
    if (cu < 48) { st_bf4(big + (size_t)(cu >> 4) * ((size_t)R * D) + (size_t)row * D + (col & 1023), v); }
    else if (cu < 53) {
      const int lc = col - 3072;
      float a = v[0], b = v[1], c = v[2], d = v[3];
      if (lc < 128) { a = tanh_fast(a); b = tanh_fast(b); c = tanh_fast(c); d = tanh_fast(d); }
      else if (lc >= 192) { a = sigmoidf_(a); b = sigmoidf_(b); c = sigmoidf_(c); d = sigmoidf_(d); }
      uint2 o; o.x = pack2(a, b); o.y = pack2(c, d);
      *(uint2*)(lr + (size_t)row * K2 + lc) = o;
    }
  }
};
struct EpRw2 {
  u16* big; u16* gq; const float* w0; const float* a0;
  DI void operator()(int row, int col, f32x4 v) const {
    const int blk = __builtin_amdgcn_readfirstlane(col >> 10), cc = col & 1023;
    float a = v[0], b = v[1], c = v[2], d = v[3];
    u16* dst;
    if (blk < 2) {
      const float4 ww = *(const float4*)(w0 + blk * D + cc);
      a = decay_m1(a + ww.x); b = decay_m1(b + ww.y); c = decay_m1(c + ww.z); d = decay_m1(d + ww.w);
      dst = big + (size_t)(4 + blk) * ((size_t)R * D);
    } else if (blk == 2) {
      const float4 ww = *(const float4*)(a0 + cc);
      a = sigmoidf_(a + ww.x); b = sigmoidf_(b + ww.y); c = sigmoidf_(c + ww.z); d = sigmoidf_(d + ww.w);
      dst = big + (size_t)3 * ((size_t)R * D);
    } else dst = gq;
    uint2 o; o.x = pack2(a, b); o.y = pack2(c, d);
    *(uint2*)(dst + (size_t)row * D + cc) = o;
  }
};

__device__ __forceinline__ void ph_qkconv(const Ctx cx, CParams& p, int g) {
  const size_t total = (size_t)R * 128;
  for (size_t i = (size_t)cx.bid * NTHR + cx.tid; i < total; i += (size_t)gridDim.x * NTHR) {
    const int row = (int)(i >> 7), c0 = ((int)(i & 127)) * 8;
    int b, pos; rowinfo(g, row, b, pos);
    const bool hasp = (pos != 0 && pos != CTX), hasn = (pos != CTX - 1 && pos != TPS - 1);
    const u16* Z = p.BIG + (size_t)row * ZW + c0;
    float cur[8], pv[8], nx[8];
    unpack8(*(const uint4*)Z, cur);
    if (hasp) unpack8(*(const uint4*)(Z - ZW), pv); else { for (int e = 0; e < 8; ++e) pv[e] = 0.f; }
    if (hasn) unpack8(*(const uint4*)(Z + ZW), nx); else { for (int e = 0; e < 8; ++e) nx[e] = 0.f; }
    const float scale = (c0 < 512) ? 0.08838834764831845f : 1.f;
    float o[8];
#pragma unroll
    for (int e = 0; e < 8; ++e) {
      const int c = c0 + e;
      const float v = pv[e] * p.ev_conv_w[c] + cur[e] * p.ev_conv_w[D + c] + nx[e] * p.ev_conv_w[2 * D + c] + p.ev_conv_b[c];
      o[e] = siluf_(v) * scale;
    }
    *(uint4*)(p.QK + (size_t)row * D + c0) = pack8(o);
  }
}

__device__ __forceinline__ void mlstm_item(const Ctx cx, CParams& p, int item, char* smem) {
  const int tid = cx.tid, lane = tid & 63, w = tid >> 6, r = lane & 31, h = lane >> 5;
  const int bl = item >> 3, head = (item >> 1) & 3, dir = item & 1;
  const int base = bl * TPS;
  u16* sQ = (u16*)smem;
  u16* sK = sQ + 32 * 136;
  u16* sVT = sK + 32 * 136;
  u16* sKT = sVT + 128 * 40;
  float* sU = (float*)(sKT + 128 * 40);
  float* sM = sU + 32; float* sBc = sM + 32; float* sLast = sBc + 32;
  float* sN = sLast + 32;
  float* sRD = sN + 128;
  float* sWI = sRD + 128;
  const u16* Z = p.BIG;
  u16* Y = p.BIG + (size_t)R * ZW + (size_t)dir * R * 512;
  const float bgi = p.ev_b_gates[(2 * dir) * 4 + head], bgf = p.ev_b_gates[(2 * dir + 1) * 4 + head];
  f32x16 cacc[4];
#pragma unroll
  for (int a = 0; a < 4; ++a)
#pragma unroll
    for (int i = 0; i < 16; ++i) cacc[a][i] = 0.f;
  if (tid < 128) sN[tid] = 0.f;
  float m = 0.f;
  const bool act = tid < 256;
  const int lr = (tid >> 3) & 31, lc = tid & 7;
  uint4 q0, q1, k0, k1, v0, v1;
  u16 gzi = 0, gzf = 0;
#define ML_LOAD(p0_) do { if (act) { const int grow = scan_row(base, dir, (p0_) + lr); \
      q0 = *(const uint4*)(p.QK + (size_t)grow * D + head * 128 + lc * 8); \
      q1 = *(const uint4*)(p.QK + (size_t)grow * D + head * 128 + lc * 8 + 64); \
      k0 = *(const uint4*)(p.QK + (size_t)grow * D + 512 + head * 128 + lc * 8); \
      k1 = *(const uint4*)(p.QK + (size_t)grow * D + 512 + head * 128 + lc * 8 + 64); \
      v0 = *(const uint4*)(Z + (size_t)grow * ZW + 1024 + head * 128 + lc * 8); \
      v1 = *(const uint4*)(Z + (size_t)grow * ZW + 1024 + head * 128 + lc * 8 + 64); } \
    if (w == 0) { const int row_ = scan_row(base, dir, (p0_) + (lane & 31)); \
      gzi = Z[(size_t)row_ * ZW + 2048 + (2 * dir) * 4 + head]; gzf = Z[(size_t)row_ * ZW + 2048 + (2 * dir + 1) * 4 + head]; } } while (0)
  ML_LOAD(0);
  for (int ch = 0; ch < TPS / 32; ++ch) {
    const int p0 = ch * 32;
    __syncthreads();
    if (w == 0) {
      const int t = lane & 31;
      const float zi = bf2f(gzi) + bgi;
      const float zf = bf2f(gzf) + bgf;
      float bsum = logsigf_(zf);
      for (int o = 1; o < 32; o <<= 1) { const float v = __shfl_up(bsum, o); if (t >= o) bsum += v; }
      const float u = zi - bsum;
      float pm = u;
      for (int o = 1; o < 32; o <<= 1) { const float v = __shfl_up(pm, o); if (t >= o) pm = fmaxf(pm, v); }
      const float M = fmaxf(m, pm);
      if (lane < 32) { sU[t] = u; sM[t] = M; sBc[t] = bsum; if (t == 31) { sLast[0] = M; sLast[1] = bsum; } }
    }
    __syncthreads();
    const float Mlast = sLast[0], blast = sLast[1];
    if (act) {
      const float ws = __expf(sU[lr] - Mlast);
      *(uint4*)(sQ + lr * 136 + lc * 8) = q0; *(uint4*)(sQ + lr * 136 + lc * 8 + 64) = q1;
      *(uint4*)(sK + lr * 136 + lc * 8) = k0; *(uint4*)(sK + lr * 136 + lc * 8 + 64) = k1;
      float f[8];
      unpack8(k0, f);
#pragma unroll
      for (int e = 0; e < 8; ++e) sKT[(lc * 8 + e) * 40 + lr] = f2bf(f[e] * ws);
      unpack8(k1, f);
#pragma unroll
      for (int e = 0; e < 8; ++e) sKT[(lc * 8 + 64 + e) * 40 + lr] = f2bf(f[e] * ws);
      const u16* pv0 = (const u16*)&v0; const u16* pv1 = (const u16*)&v1;
#pragma unroll
      for (int e = 0; e < 8; ++e) { sVT[(lc * 8 + e) * 40 + lr] = pv0[e]; sVT[(lc * 8 + 64 + e) * 40 + lr] = pv1[e]; }
    }
    if (ch + 1 < TPS / 32) ML_LOAD(p0 + 32);
    __syncthreads();
    f32x16 st;
#pragma unroll
    for (int i = 0; i < 16; ++i) st[i] = 0.f;
    if (act) {
#pragma unroll
    for (int ks = 0; ks < 8; ++ks) {
      const bf16x8 a = *(const bf16x8*)(sK + r * 136 + 16 * ks + 8 * h);
      const bf16x8 b = *(const bf16x8*)(sQ + r * 136 + 16 * ks + 8 * h);
      st = MFMA(a, b, st);
    }
    const float Mt = sM[r];
    float dsum = 0.f;
#pragma unroll
    for (int i = 0; i < 16; ++i) {
      const int s = crow(i, h);
      const float pv = (s <= r) ? st[i] * __expf(sU[s] - Mt) : 0.f;
      st[i] = pv; dsum += pv;
    }
    dsum += __shfl_xor(dsum, 32);
    float qn = 0.f;
#pragma unroll
    for (int d8 = 0; d8 < 8; ++d8) {
      float qf[8]; unpack8(*(const uint4*)(sQ + r * 136 + 64 * h + 8 * d8), qf);
#pragma unroll
      for (int e = 0; e < 8; ++e) qn += qf[e] * sN[64 * h + 8 * d8 + e];
    }
    qn += __shfl_xor(qn, 32);
    const float wi = __expf(m - Mt);
    const float den = dsum + wi * qn;
    const float dn = fmaxf(fabsf(den), __expf(-(sBc[r] + Mt)));
    if (h == 0) { sRD[w * 32 + r] = 1.f / dn; sWI[w * 32 + r] = wi; }
    }
    __syncthreads();
    const float wp = __expf(m - Mlast);
    if (act) {
    f32x16 o;
#pragma unroll
    for (int i = 0; i < 16; ++i) o[i] = 0.f;
#pragma unroll
    for (int mb = 0; mb < 4; ++mb)
#pragma unroll
      for (int s2 = 0; s2 < 2; ++s2) {
        const bf16x8 cb = pack_step(cacc[mb], s2);
        const u16* qp = sQ + r * 136 + 32 * mb + 16 * s2 + 4 * h;
        const bf16x8 a = cat4(*(const s16x4*)qp, *(const s16x4*)(qp + 8));
        o = MFMA(a, cb, o);
      }
#pragma unroll
    for (int i = 0; i < 16; ++i) o[i] *= sWI[w * 32 + crow(i, h)];
#pragma unroll
    for (int s2 = 0; s2 < 2; ++s2) {
      const bf16x8 a = pack_step(st, s2);
      const u16* vp = sVT + (32 * w + r) * 40 + 16 * s2 + 4 * h;
      const bf16x8 b = cat4(*(const s16x4*)vp, *(const s16x4*)(vp + 8));
      o = MFMA(a, b, o);
    }
#pragma unroll
    for (int i = 0; i < 16; ++i) {
      const int t = crow(i, h);
      const int row = scan_row(base, dir, p0 + t);
      Y[(size_t)row * 512 + head * 128 + 32 * w + r] = f2bf(o[i] * sRD[w * 32 + t]);
    }
#pragma unroll
    for (int mb = 0; mb < 4; ++mb) {
#pragma unroll
      for (int i = 0; i < 16; ++i) cacc[mb][i] *= wp;
#pragma unroll
      for (int s2 = 0; s2 < 2; ++s2) {
        const bf16x8 a = *(const bf16x8*)(sKT + (32 * mb + r) * 40 + 16 * s2 + 8 * h);
        const bf16x8 b = *(const bf16x8*)(sVT + (32 * w + r) * 40 + 16 * s2 + 8 * h);
        cacc[mb] = MFMA(a, b, cacc[mb]);
      }
    }
    }
    __syncthreads();
    if (tid < 128) {
      float s = 0.f;
#pragma unroll
      for (int e = 0; e < 32; ++e) s += bf2f(sKT[tid * 40 + e]);
      sN[tid] = wp * sN[tid] + s;
    }
    m = blast + Mlast;
  }
#undef ML_LOAD
}

__device__ __forceinline__ void gla_item(const Ctx cx, CParams& p, int item, char* smem) {
  const int tid = cx.tid, lane = tid & 63, w = tid >> 6, r = lane & 31, h = lane >> 5;
  const int bl = item >> 3, head = (item >> 1) & 3, dir = item & 1;
  const int base = bl * TPS;
  u16* sQ = (u16*)smem;
  u16* sK = sQ + 32 * 72;
  u16* sKT = sK + 32 * 72;
  u16* sVT = sKT + 64 * 40;
  float* sLa = (float*)(sVT + 128 * 40);
  float* sW2 = sLa + 32 * 64;
  float* sBi = sW2 + 16 * 64;
  const u16* Z = p.BIG;
  u16* Y = p.BIG + (size_t)R * ZW + (size_t)(2 + dir) * R * 512;
  for (int i = tid; i < 16 * 64; i += NTHR) sW2[i] = p.ev_gla_w2[((size_t)dir * 16 + (i >> 6)) * 256 + head * 64 + (i & 63)];
  if (tid < 64) sBi[tid] = p.ev_gla_b[dir * 256 + head * 64 + tid];
  f32x16 sacc[2];
#pragma unroll
  for (int a = 0; a < 2; ++a)
#pragma unroll
    for (int i = 0; i < 16; ++i) sacc[a][i] = 0.f;
  const bool act = tid < 256;
  const int lr = (tid >> 3) & 31, lc = tid & 7;
  uint4 gq, gk, v0, v1, gl0, gl1;
#define GLA_LOAD(p0_) do { if (act) { const int grow = scan_row(base, dir, (p0_) + lr); const u16* zr = Z + (size_t)grow * ZW; \
      gq = *(const uint4*)(zr + 2064 + head * 64 + lc * 8); gk = *(const uint4*)(zr + 2320 + head * 64 + lc * 8); \
      v0 = *(const uint4*)(zr + 2576 + head * 128 + lc * 8); v1 = *(const uint4*)(zr + 2576 + head * 128 + lc * 8 + 64); \
      gl0 = *(const uint4*)(zr + 3600 + dir * 16); gl1 = *(const uint4*)(zr + 3600 + dir * 16 + 8); } } while (0)
  GLA_LOAD(0);
  for (int ch = 0; ch < TPS / 32; ++ch) {
    const int p0 = ch * 32;
    __syncthreads();
    if (act) {
      float gl[16];
      unpack8(gl0, gl); unpack8(gl1, gl + 8);
#pragma unroll
      for (int e = 0; e < 8; ++e) {
        const int c = lc * 8 + e;
        float xv = sBi[c];
#pragma unroll
        for (int q = 0; q < 16; ++q) xv += gl[q] * sW2[q * 64 + c];
        sLa[lr * 64 + c] = logsigf_(xv) * (1.f / 16.f);
      }
    }
    __syncthreads();
    if (tid < 64) {
      float lv[32];
#pragma unroll
      for (int t = 0; t < 32; ++t) lv[t] = sLa[t * 64 + tid];
      float b = 0.f;
#pragma unroll
      for (int t = 0; t < 32; ++t) { b += lv[t]; sLa[t * 64 + tid] = b; }
    }
    __syncthreads();
    if (act) {
      float qf[8], kf[8], o[8];
      unpack8(gq, qf); unpack8(gk, kf);
#pragma unroll
      for (int e = 0; e < 8; ++e) { const float bb = sLa[lr * 64 + lc * 8 + e]; qf[e] *= 0.125f * __expf(bb); kf[e] *= __expf(-bb); }
      *(uint4*)(sQ + lr * 72 + lc * 8) = pack8(qf);
      *(uint4*)(sK + lr * 72 + lc * 8) = pack8(kf);
#pragma unroll
      for (int e = 0; e < 8; ++e) sKT[(lc * 8 + e) * 40 + lr] = f2bf(kf[e]);
      (void)o;
      const u16* pv0 = (const u16*)&v0; const u16* pv1 = (const u16*)&v1;
#pragma unroll
      for (int e = 0; e < 8; ++e) { sVT[(lc * 8 + e) * 40 + lr] = pv0[e]; sVT[(lc * 8 + 64 + e) * 40 + lr] = pv1[e]; }
    }
    if (ch + 1 < TPS / 32) GLA_LOAD(p0 + 32);
    __syncthreads();
    if (act) {
    f32x16 st;
#pragma unroll
    for (int i = 0; i < 16; ++i) st[i] = 0.f;
#pragma unroll
    for (int ks = 0; ks < 4; ++ks) {
      const bf16x8 a = *(const bf16x8*)(sK + r * 72 + 16 * ks + 8 * h);
      const bf16x8 b = *(const bf16x8*)(sQ + r * 72 + 16 * ks + 8 * h);
      st = MFMA(a, b, st);
    }
#pragma unroll
    for (int i = 0; i < 16; ++i) { if (crow(i, h) > r) st[i] = 0.f; }
    f32x16 o;
#pragma unroll
    for (int i = 0; i < 16; ++i) o[i] = 0.f;
#pragma unroll
    for (int mb = 0; mb < 2; ++mb)
#pragma unroll
      for (int s2 = 0; s2 < 2; ++s2) {
        const bf16x8 cb = pack_step(sacc[mb], s2);
        const u16* qp = sQ + r * 72 + 32 * mb + 16 * s2 + 4 * h;
        const bf16x8 a = cat4(*(const s16x4*)qp, *(const s16x4*)(qp + 8));
        o = MFMA(a, cb, o);
      }
#pragma unroll
    for (int s2 = 0; s2 < 2; ++s2) {
      const bf16x8 a = pack_step(st, s2);
      const u16* vp = sVT + (32 * w + r) * 40 + 16 * s2 + 4 * h;
      const bf16x8 b = cat4(*(const s16x4*)vp, *(const s16x4*)(vp + 8));
      o = MFMA(a, b, o);
    }
#pragma unroll
    for (int i = 0; i < 16; ++i) {
      const int row = scan_row(base, dir, p0 + crow(i, h));
      Y[(size_t)row * 512 + head * 128 + 32 * w + r] = f2bf(o[i]);
    }
#pragma unroll
    for (int mb = 0; mb < 2; ++mb) {
#pragma unroll
      for (int s2 = 0; s2 < 2; ++s2) {
        const bf16x8 a = *(const bf16x8*)(sKT + (32 * mb + r) * 40 + 16 * s2 + 8 * h);
        const bf16x8 b = *(const bf16x8*)(sVT + (32 * w + r) * 40 + 16 * s2 + 8 * h);
        sacc[mb] = MFMA(a, b, sacc[mb]);
      }
#pragma unroll
      for (int i = 0; i < 16; ++i) sacc[mb][i] *= __expf(sLa[31 * 64 + 32 * mb + crow(i, h)]);
    }
    }
  }
#undef GLA_LOAD
}

__device__ __forceinline__ void ph_scan0(const Ctx cx, CParams& p, char* smem) {
  for (int it = cx.bid; it < 2 * SPG * 8; it += gridDim.x) {
    __syncthreads();
    if (it < SPG * 8) mlstm_item(cx, p, it, smem); else gla_item(cx, p, it - SPG * 8, smem);
  }
}

__device__ __forceinline__ void ph_evout(const Ctx cx, CParams& p, int g) {
  const int lane = cx.tid & 63;
  const int gw = cx.bid * NWV + (cx.tid >> 6), nw = gridDim.x * NWV;
  const u16* Yb = p.BIG + (size_t)R * ZW;
  for (int row = gw; row < R; row += nw) {
    const int c0 = lane * 16;
    const int part = c0 >> 9, cc = c0 & 511;
    const u16* yf = Yb + ((size_t)(2 * part) * R + row) * 512 + cc;
    const u16* yb = Yb + ((size_t)(2 * part + 1) * R + row) * 512 + cc;
    float a[16], b[16];
    unpack8(*(const uint4*)yf, a); unpack8(*(const uint4*)(yf + 8), a + 8);
    unpack8(*(const uint4*)yb, b); unpack8(*(const uint4*)(yb + 8), b + 8);
    float ss = 0.f;
#pragma unroll
    for (int e = 0; e < 16; ++e) { a[e] += b[e]; ss += a[e] * a[e]; }
    ss += __shfl_xor(ss, 1); ss += __shfl_xor(ss, 2); ss += __shfl_xor(ss, 4);
    const float rstd = rsqrtf(ss * (1.f / 128.f) + 1e-6f);
    const u16* zg = p.BIG + (size_t)row * ZW + (part ? 3088 : 1536) + cc;
    float gt[16];
    unpack8(*(const uint4*)zg, gt); unpack8(*(const uint4*)(zg + 8), gt + 8);
#pragma unroll
    for (int e = 0; e < 16; ++e) {
      const float gv = part ? siluf_(gt[e]) : sigmoidf_(gt[e]);
      a[e] = a[e] * rstd * p.ev_head_g[c0 + e] * gv;
    }
    *(uint4*)(p.H + (size_t)row * D + c0) = pack8(a);
    *(uint4*)(p.H + (size_t)row * D + c0 + 8) = pack8(a + 8);
  }
}

__device__ __forceinline__ void ph_ffnact(const Ctx cx, CParams& p, int g, int layer, bool lat_only) {
  const float* cw = p.ffn_conv_w + (size_t)layer * 9 * DFF;
  const float* cb = p.ffn_conv_b + (size_t)layer * DFF;
  constexpr int SEG = 16, NSEG = TPS / SEG;
  const int total = SPG * NSEG * 352;
  for (int it = cx.bid * NTHR + cx.tid; it < total; it += gridDim.x * NTHR) {
    const int cg = it % 352, sg = (it / 352) % NSEG, s = it / (352 * NSEG);
    const int f0 = cg * 8;
    const int pos0 = sg * SEG;
    const bool isctx = pos0 < CTX;
    if (lat_only && isctx) continue;
    bool has_up = false, has_dn = false, has_l, has_r;
    if (isctx) { has_l = pos0 > 0; has_r = pos0 + SEG < CTX; }
    else { const int lp = pos0 - CTX, gr = lp >> 6, gc0 = lp & 63; has_up = gr > 0; has_dn = gr < 31; has_l = gc0 > 0; has_r = gc0 + SEG < 64; }
    float w[3][3][8], bias[8];
#pragma unroll
    for (int dh = 0; dh < 3; ++dh)
#pragma unroll
      for (int dw = 0; dw < 3; ++dw) {
        const float4 w0 = *(const float4*)(cw + (dh * 3 + dw) * DFF + f0), w1 = *(const float4*)(cw + (dh * 3 + dw) * DFF + f0 + 4);
        w[dh][dw][0] = w0.x; w[dh][dw][1] = w0.y; w[dh][dw][2] = w0.z; w[dh][dw][3] = w0.w;
        w[dh][dw][4] = w1.x; w[dh][dw][5] = w1.y; w[dh][dw][6] = w1.z; w[dh][dw][7] = w1.w;
      }
    { const float4 b0 = *(const float4*)(cb + f0), b1 = *(const float4*)(cb + f0 + 4);
      bias[0] = b0.x; bias[1] = b0.y; bias[2] = b0.z; bias[3] = b0.w; bias[4] = b1.x; bias[5] = b1.y; bias[6] = b1.z; bias[7] = b1.w; }
    u16* gu = p.BIG + (size_t)(s * TPS + pos0) * GUW + f0;
    float c0[3][8], c1[3][8], c2[3][8];
    uint4 nx[3];
#define FA_LD1(d, tok_, ok_) do { const bool o_ = (ok_); const uint4 r_ = *(const uint4*)(gu + (ptrdiff_t)(o_ ? (tok_) : 0) * GUW); \
      d.x = o_ ? r_.x : 0u; d.y = o_ ? r_.y : 0u; d.z = o_ ? r_.z : 0u; d.w = o_ ? r_.w : 0u; } while (0)
#define FA_LOAD(dst, tok, ok) do { FA_LD1(dst[1], (tok), (ok)); FA_LD1(dst[0], (tok) - 64, (ok) && has_up); FA_LD1(dst[2], (tok) + 64, (ok) && has_dn); } while (0)
    FA_LOAD(nx, -1, has_l);
    unpack8(nx[0], c0[0]); unpack8(nx[1], c0[1]); unpack8(nx[2], c0[2]);
    FA_LOAD(nx, 0, true);
    unpack8(nx[0], c1[0]); unpack8(nx[1], c1[1]); unpack8(nx[2], c1[2]);
    FA_LOAD(nx, 1, true);
#pragma unroll 2
    for (int t = 0; t < SEG; ++t) {
      unpack8(nx[0], c2[0]); unpack8(nx[1], c2[1]); unpack8(nx[2], c2[2]);
      const uint4 upraw = *(const uint4*)(gu + (ptrdiff_t)t * GUW + DFF);
      { const int tn = t + 2; const bool ok = (tn < SEG) || (tn == SEG && has_r); FA_LOAD(nx, tn, ok); }
      float acc[8];
#pragma unroll
      for (int e = 0; e < 8; ++e) {
        float a = bias[e];
#pragma unroll
        for (int dh = 0; dh < 3; ++dh) a += c0[dh][e] * w[dh][0][e] + c1[dh][e] * w[dh][1][e] + c2[dh][e] * w[dh][2][e];
        acc[e] = a;
      }
      float up[8]; unpack8(upraw, up);
#pragma unroll
      for (int e = 0; e < 8; ++e) {
        const float xg = acc[e];
        const float th = tanh_fast(0.7978845608028654f * (xg + 0.044715f * xg * xg * xg));
        up[e] *= 0.5f * xg * (1.f + th);
      }
      *(uint4*)(gu + (ptrdiff_t)t * GUW + DFF) = pack8(up);
#pragma unroll
      for (int dh = 0; dh < 3; ++dh)
#pragma unroll
        for (int e = 0; e < 8; ++e) { c0[dh][e] = c1[dh][e]; c1[dh][e] = c2[dh][e]; }
    }
#undef FA_LOAD
#undef FA_LD1
  }
}

__device__ __forceinline__ void ph_xx(const Ctx cx, CParams& p, int g) {
  const size_t total = (size_t)R * 128;
  for (size_t i = (size_t)cx.bid * NTHR + cx.tid; i < total; i += (size_t)gridDim.x * NTHR) {
    const int row = (int)(i >> 7), c0 = ((int)(i & 127)) * 8;
    int b, pos; rowinfo(g, row, b, pos);
    const int q = c0 >> 8;
    int off = 0; bool ok;
    if (pos < CTX) {
      if ((q & 1) == 0) { off = -1; ok = pos > 0; } else { off = 1; ok = pos < CTX - 1; }
    } else {
      const int lp = pos - CTX, gr = lp >> 6, gc = lp & 63;
      if (q == 0) { off = -1; ok = gc > 0; }
      else if (q == 1) { off = 1; ok = gc < 63; }
      else if (q == 2) { off = -64; ok = gr > 0; }
      else { off = 64; ok = gr < 31; }
    }
    float hc[8], hs[8];
    unpack8(*(const uint4*)(p.H + (size_t)row * D + c0), hc);
    if (ok) unpack8(*(const uint4*)(p.H + (size_t)(row + off) * D + c0), hs); else { for (int e = 0; e < 8; ++e) hs[e] = 0.f; }
#pragma unroll
    for (int e = 0; e < 8; ++e) hs[e] -= hc[e];
    *(uint4*)(p.QK + (size_t)row * D + c0) = pack8(hs);
    float m_[8];
    const size_t RS_ = (size_t)R * D;
#pragma unroll
    for (int e = 0; e < 8; ++e) m_[e] = hc[e] + hs[e] * p.rw_mu[0 * D + c0 + e];
    *(uint4*)(p.BIG + 3 * RS_ + (size_t)row * D + c0) = pack8(m_);
#pragma unroll
    for (int e = 0; e < 8; ++e) m_[e] = hc[e] + hs[e] * p.rw_mu[2 * D + c0 + e];
    *(uint4*)(p.BIG + 4 * RS_ + (size_t)row * D + c0) = pack8(m_);
#pragma unroll
    for (int e = 0; e < 8; ++e) m_[e] = hc[e] + hs[e] * p.rw_mu[3 * D + c0 + e];
    *(uint4*)(p.BIG + 5 * RS_ + (size_t)row * D + c0) = pack8(m_);
  }
}

__device__ __forceinline__ void ph_rwprep(const Ctx cx, CParams& p) {
  const int lane = cx.tid & 63;
  const int gw = cx.bid * NWV + (cx.tid >> 6), nw = gridDim.x * NWV;
  const size_t RS = (size_t)R * D;
  float* CS = (float*)p.LR;
  for (int row = gw; row < R; row += nw) {
    const int c0 = lane * 16;
    const size_t o = (size_t)row * D + c0;
    float rr[16], kk[16], aa[16], km[16], ka[16];
    unpack8(*(const uint4*)(p.BIG + o), rr); unpack8(*(const uint4*)(p.BIG + o + 8), rr + 8);
    unpack8(*(const uint4*)(p.BIG + RS + o), kk); unpack8(*(const uint4*)(p.BIG + RS + o + 8), kk + 8);
    unpack8(*(const uint4*)(p.BIG + 3 * RS + o), aa); unpack8(*(const uint4*)(p.BIG + 3 * RS + o + 8), aa + 8);
    float ss = 0.f;
#pragma unroll
    for (int e = 0; e < 16; ++e) {
      km[e] = bf2f(f2bf(kk[e] * (1.f + (aa[e] - 1.f) * p.rw_kvec[D + c0 + e])));
      kk[e] *= p.rw_kvec[c0 + e]; ss += kk[e] * kk[e];
    }
    ss += __shfl_xor(ss, 1); ss += __shfl_xor(ss, 2);
    const float inv = 1.f / fmaxf(sqrtf(ss), 1e-12f);
    float c1 = 0.f, c2 = 0.f;
#pragma unroll
    for (int e = 0; e < 16; ++e) {
      kk[e] *= inv; ka[e] = bf2f(f2bf(kk[e] * aa[e]));
      c1 += ka[e] * rr[e]; c2 += km[e] * rr[e];
    }
    c1 += __shfl_xor(c1, 1); c1 += __shfl_xor(c1, 2);
    c2 += __shfl_xor(c2, 1); c2 += __shfl_xor(c2, 2);
    *(uint4*)(p.BIG + RS + o) = pack8(kk); *(uint4*)(p.BIG + RS + o + 8) = pack8(kk + 8);
    *(uint4*)(p.BIG + 3 * RS + o) = pack8(ka); *(uint4*)(p.BIG + 3 * RS + o + 8) = pack8(ka + 8);
    *(uint4*)(p.H + o) = pack8(km); *(uint4*)(p.H + o + 8) = pack8(km + 8);
    if ((lane & 3) == 0) { float2 c; c.x = c1; c.y = c2; *(float2*)(CS + (size_t)row * 32 + (lane >> 2) * 2) = c; }
  }
}

__device__ __forceinline__ void ph_rwscan(const Ctx cx, CParams& p) {
  const int lane = cx.tid & 63, w = cx.tid >> 6;
  if (w >= 4) return;
  const int vq = lane >> 3, kq = lane & 7, hf = w & 1;
  const size_t RS = (size_t)R * D;
  const u16* Rb = p.BIG; const u16* KKb = p.BIG + RS; const u16* Vb = p.BIG + 2 * RS; const u16* KAb = p.BIG + 3 * RS; const u16* KMb = p.H;
  const float* CS = (const float*)p.LR;
  const int nblk = (SPG * 16 * 2) / 2;
  for (int bi = cx.bid; bi < nblk; bi += gridDim.x) {
    const int item = bi * 2 + (w >> 1);
    const int bl = item >> 5, head = (item >> 1) & 15, dir = item & 1;
    const u16* Wb = p.BIG + (size_t)(4 + dir) * RS;
    u16* Yb = (u16*)p.YO + (size_t)dir * RS;
    const int base = bl * TPS;
    const int colk = head * 64 + kq * 8, colv = head * 64 + hf * 32 + vq * 4;
    float S[4][8];
#pragma unroll
    for (int i = 0; i < 4; ++i)
#pragma unroll
      for (int e = 0; e < 8; ++e) S[i][e] = 0.f;
    char* dummy = (char*)p.LR + (size_t)R * 128 + (cx.tid & 511) * 8;
    constexpr int PF = 3;
    uint4 qr[PF], qkk[PF], qka[PF], qkm[PF], qw[PF]; uint2 qv[PF]; float2 qcs[PF]; int qrow[PF];
#define RW_LOAD(j, ps_) do { const int row_ = scan_row(base, dir, (ps_)); qrow[j] = row_; \
      const unsigned ok_ = (unsigned)(row_ * D + colk) * 2u, ov_ = (unsigned)(row_ * D + colv) * 2u, oc_ = (unsigned)(row_ * 32 + head * 2) * 4u; \
      qr[j] = *(const uint4*)((const char*)Rb + ok_); qkk[j] = *(const uint4*)((const char*)KKb + ok_); \
      qka[j] = *(const uint4*)((const char*)KAb + ok_); qkm[j] = *(const uint4*)((const char*)KMb + ok_); \
      qw[j] = *(const uint4*)((const char*)Wb + ok_); qv[j] = *(const uint2*)((const char*)Vb + ov_); \
      qcs[j] = *(const float2*)((const char*)CS + oc_); } while (0)
#pragma unroll
    for (int j = 0; j < PF; ++j) RW_LOAD(j, j);
    for (int ps0 = 0; ps0 < TPS; ps0 += PF) {
#pragma unroll
    for (int j = 0; j < PF; ++j) {
      const uint4 cr_ = qr[j], ckk = qkk[j], cka = qka[j], ckm = qkm[j], cw = qw[j]; const uint2 cv = qv[j]; const float2 cs = qcs[j];
      const int crow_ = qrow[j];
      { const int pn_ = ps0 + PF + j; RW_LOAD(j, pn_ < TPS ? pn_ : TPS - 1); }
      float wr[8], kk[8], wm1[8], vv[4], kka[8], km[8];
      unpack8(cr_, wr); unpack8(ckk, kk); unpack8(cka, kka); unpack8(ckm, km); unpack8(cw, wm1);
      vv[0] = lo16(cv.x); vv[1] = hi16(cv.x); vv[2] = lo16(cv.y); vv[3] = hi16(cv.y);
#pragma unroll
      for (int e = 0; e < 8; ++e) wr[e] += wr[e] * wm1[e];
      float sa[4], yo[4];
#pragma unroll
      for (int i = 0; i < 4; ++i) {
        float s = 0.f, t = 0.f;
#pragma unroll
        for (int e = 0; e < 8; ++e) { s += S[i][e] * kk[e]; t += S[i][e] * wr[e]; }
        sa[i] = s; yo[i] = t;
      }
#pragma unroll
      for (int i = 0; i < 4; ++i) { sa[i] = -red8(sa[i]); yo[i] = red8(yo[i]); }
#pragma unroll
      for (int i = 0; i < 4; ++i) {
#pragma unroll
        for (int e = 0; e < 8; ++e) {
          float t = S[i][e] + S[i][e] * wm1[e];
          t += sa[i] * kka[e];
          t += vv[i] * km[e];
          S[i][e] = t;
        }
        yo[i] += sa[i] * cs.x + vv[i] * cs.y;
      }
      { uint2 o; o.x = pack2(yo[0], yo[1]); o.y = pack2(yo[2], yo[3]);
        char* dst_ = (kq == 0) ? (char*)Yb + (unsigned)(crow_ * D + colv) * 2u : dummy;
        *(uint2*)dst_ = o; }
    }
    }
#undef RW_LOAD
  }
}

__device__ __forceinline__ void ph_rwout(const Ctx cx, CParams& p, int g) {
  const int lane = cx.tid & 63;
  const int gw = cx.bid * NWV + (cx.tid >> 6), nw = gridDim.x * NWV;
  const size_t RS = (size_t)R * D;
  for (int row = gw; row < R; row += nw) {
    int b, pos; rowinfo(g, row, b, pos);
    if (pos < CTX) continue;
    const int c0 = lane * 16;
    const size_t o = (size_t)row * D + c0;
    float yf[16], yb[16], rr[16], kk[16], vv[16], gg[16];
    const u16* Yy = (const u16*)p.YO;
    unpack8(*(const uint4*)(Yy + o), yf); unpack8(*(const uint4*)(Yy + o + 8), yf + 8);
    unpack8(*(const uint4*)(Yy + RS + o), yb); unpack8(*(const uint4*)(Yy + RS + o + 8), yb + 8);
    unpack8(*(const uint4*)(p.BIG + o), rr); unpack8(*(const uint4*)(p.BIG + o + 8), rr + 8);
    unpack8(*(const uint4*)(p.H + o), kk); unpack8(*(const uint4*)(p.H + o + 8), kk + 8);
    unpack8(*(const uint4*)(p.BIG + 2 * RS + o), vv); unpack8(*(const uint4*)(p.BIG + 2 * RS + o + 8), vv + 8);
    unpack8(*(const uint4*)(p.QK + o), gg); unpack8(*(const uint4*)(p.QK + o + 8), gg + 8);
    float s1 = 0.f, bon = 0.f;
#pragma unroll
    for (int e = 0; e < 16; ++e) {
      yf[e] += yb[e]; s1 += yf[e];
      bon += rr[e] * kk[e] * p.rw_kvec[2 * D + c0 + e];
    }
    s1 += __shfl_xor(s1, 1); s1 += __shfl_xor(s1, 2);
    bon += __shfl_xor(bon, 1); bon += __shfl_xor(bon, 2);
    const float mu = s1 * (1.f / 64.f);
    float s2 = 0.f;
#pragma unroll
    for (int e = 0; e < 16; ++e) { const float d = yf[e] - mu; s2 += d * d; }
    s2 += __shfl_xor(s2, 1); s2 += __shfl_xor(s2, 2);
    const float rstd = rsqrtf(s2 * (1.f / 64.f) + 64e-5f);
#pragma unroll
    for (int e = 0; e < 16; ++e) {
      const float yn = (yf[e] - mu) * rstd * p.rw_lnx[c0 + e] + p.rw_lnx[D + c0 + e];
      yf[e] = (yn + bon * vv[e]) * gg[e];
    }
    *(uint4*)(p.H + o) = pack8(yf);
    *(uint4*)(p.H + o + 8) = pack8(yf + 8);
  }
}

__global__ void __launch_bounds__(NTHR) fwd_megakernel(Params p_arg) {
  cg::grid_group grid = cg::this_grid();
  __shared__ __attribute__((aligned(1024))) char smem[2 * STAGE_B];
  const size_t RS = (size_t)R * D;
  (void)RS;
  {
    Ctx cx; cx.tid = threadIdx.x; cx.bid = blockIdx.x;
    CParams* pp = (CParams*)__builtin_amdgcn_kernarg_segment_ptr();
    ph_prologue(cx, *pp, (float*)smem);
  }
  grid.sync();
#pragma nounroll
  for (int it2 = 0; it2 < NG * NPH * 2; ++it2) {
    const int it = it2 >> 1;
    const int g = it / NPH, ph = it - g * NPH;
    if (it2 & 1) continue;
    const unsigned long long tp0 = PROBE_MASK ? wall_clock64() : 0ull;
    Ctx cx;
    { int t_ = threadIdx.x, b_ = blockIdx.x; asm volatile("" : "+v"(t_), "+s"(b_)); cx.tid = t_; cx.bid = b_; }
    CParams* pp = (CParams*)__builtin_amdgcn_kernarg_segment_ptr();
    asm volatile("" : "+s"(pp));
    CParams& p = *pp;
    switch (ph) {
      case 0: ph_norm0(cx, p, g); break;
      case 1: gemm256(cx, p.H, p.H, 1 << 30, D, p.wt_in, D, ZW / 256, false, EpBf16{p.BIG, ZW}, smem); break;
      case 2: ph_qkconv(cx, p, g); break;
      case 3: ph_scan0(cx, p, smem); break;
      case 4: ph_evout(cx, p, g); break;
      case 5: gemm256(cx, p.H, p.H, 1 << 30, D, p.wt_out, D, 4, false, EpBf16{(u16*)p.YO, D}, smem); break;
      case 6: ph_resid(cx, p, g, 0, 0, false); break;
      case 7: gemm256(cx, p.H, p.H, 1 << 30, D, p.wt_up, D, GUW / 256, false, EpBf16{p.BIG, GUW}, smem); break;
      case 8: ph_ffnact(cx, p, g, 0, false); break;
      case 9: gemm256(cx, p.BIG + DFF, p.BIG + DFF, 1 << 30, GUW, p.wt_down, DFF, 4, false, EpBf16{(u16*)p.YO, D}, smem); break;
      case 10: ph_resid(cx, p, g, 0, 1, false); break;
      case 11: ph_xx(cx, p, g); break;
      case 12: gemm256<true>(cx, p.H, p.QK, D, D, p.wt_1, K1, N1 / 256, false, EpRw1{p.BIG, p.LR}, smem, p.BIG + 3 * RS); break;
      case 13: gemm256(cx, p.LR, p.LR, 1 << 30, K2, p.wt_2, K2, N2 / 256, false, EpRw2{p.BIG, p.QK, p.rw_w0, p.rw_a0}, smem); break;
      case 14: ph_rwprep(cx, p); break;
      case 15: ph_rwscan(cx, p); break;
      case 16: ph_rwout(cx, p, g); break;
      case 17: gemm256(cx, p.H, p.H, 1 << 30, D, p.wt_o, D, 4, true, EpBf16{(u16*)p.YO, D}, smem); break;
      case 18: ph_resid(cx, p, g, 1, 0, true); break;
      case 19: gemm256(cx, p.H, p.H, 1 << 30, D, p.wt_up + (size_t)GUW * D, D, GUW / 256, true, EpBf16{p.BIG, GUW}, smem); break;
      case 20: ph_ffnact(cx, p, g, 1, true); break;
      case 21: gemm256(cx, p.BIG + DFF, p.BIG + DFF, 1 << 30, GUW, p.wt_down + (size_t)D * DFF, DFF, 4, true, EpBf16{(u16*)p.YO, D}, smem); break;
      default: ph_resid(cx, p, g, 1, 1, true); break;
    }
    grid.sync();
    if (PROBE_MASK && ((PROBE_MASK >> ph) & 1u)) {
      const unsigned long long tp1 = wall_clock64();
      while (wall_clock64() - tp1 < tp1 - tp0) __builtin_amdgcn_s_sleep(8);
    }
  }
}

extern "C" void kernel_launch(void* const* d_in, const int* in_sizes, int n_in, void* d_out, int out_size, void* d_ws,
                              size_t ws_size, hipStream_t stream) {
  static int grid_blocks = 0;
  if (!grid_blocks) {
    int dev = 0, cus = 0, per_cu = 0;
    hipGetDevice(&dev);
    hipDeviceGetAttribute(&cus, hipDeviceAttributeMultiprocessorCount, dev);
    hipOccupancyMaxActiveBlocksPerMultiprocessor(&per_cu, fwd_megakernel, NTHR, 0);
    if (per_cu > 1) per_cu = 1;
    if (per_cu < 1) per_cu = 1;
    grid_blocks = cus * per_cu;
  }
  Params p{};
  const float** f = (const float**)&p;
  for (int i = 0; i < 32; ++i) f[i] = (const float*)d_in[i];
  p.out = (float*)d_out;
  char* ws = (char*)d_ws;
  size_t off = 0;
  auto take = [&](size_t bytes) { char* q = ws + off; off += (bytes + 255) & ~(size_t)255; return q; };
  p.wt_in = (u16*)take((size_t)ZW * D * 2);
  p.wt_out = (u16*)take((size_t)D * D * 2);
  p.wt_up = (u16*)take((size_t)2 * GUW * D * 2);
  p.wt_down = (u16*)take((size_t)2 * D * DFF * 2);
  p.wt_o = (u16*)take((size_t)D * D * 2);
  p.wt_1 = (u16*)take((size_t)N1 * K1 * 2);
  p.wt_2 = (u16*)take((size_t)N2 * K2 * 2);
  p.mod = (float*)take((size_t)2 * 33 * 6144 * 4);
  p.xc = (float*)take((size_t)NB * CTX * D * 4);
  p.H = (u16*)take((size_t)R * D * 2);
  p.BIG = (u16*)take((size_t)6 * R * D * 2);
  p.QK = (u16*)take((size_t)R * D * 2);
  p.YO = (float*)take((size_t)R * D * 4);
  p.LR = (u16*)take((size_t)R * K2 * 2);
  if (off > ws_size) { fprintf(stderr, "workspace too small: need %zu have %zu\n", off, ws_size); return; }
  void* args[] = {&p};
  hipError_t e = hipLaunchCooperativeKernel((void*)fwd_megakernel, dim3(grid_blocks), dim3(NTHR), args, 0, stream);
  if (e != hipSuccess) fprintf(stderr, "cooperative launch failed: %s (grid %d)\n", hipGetErrorString(e), grid_blocks);
}
```

```cpp
#include <hip/hip_runtime.h>
#include <hip/hip_cooperative_groups.h>
#include <cstdio>
namespace cg = cooperative_groups;

typedef unsigned short u16;
using bf16x8 = __attribute__((ext_vector_type(8))) short;
using s16x4  = __attribute__((ext_vector_type(4))) short;
using f32x16 = __attribute__((ext_vector_type(16))) float;
#define DI __device__ __forceinline__
#define MFMA(a, b, c) __builtin_amdgcn_mfma_f32_32x32x16_bf16((a), (b), (c), 0, 0, 0)

constexpr int D = 1024, NB = 32, SEQ = 2048, CTX = 256, TPS = 2304;
constexpr int NG = 2, SPG = 16, R = SPG * TPS;
constexpr int ZW = 3840;
constexpr int DFF = 2816, GUW = 5632;
constexpr int NTHR = 512, NWV = NTHR / 64, NPH = 23;
constexpr int N1 = 3584, K1 = 2048, N2 = 4096, K2 = 320;
#ifndef PROBE_MASK_V
#define PROBE_MASK_V 0u
#endif
constexpr unsigned PROBE_MASK = PROBE_MASK_V;

struct Ctx { int tid, bid; };
struct Params {
  const float *x, *c, *ctx, *c_ctx, *w_mod, *b_mod, *norm_g, *ffn_w_up, *ffn_conv_w, *ffn_conv_b, *ffn_w_down,
      *ev_w_in, *ev_b_gates, *ev_conv_w, *ev_conv_b, *ev_gla_w2, *ev_gla_b, *ev_head_g, *ev_w_out,
      *rw_mu, *rw_w_rkv, *rw_w_o, *rw_w0, *rw_w1, *rw_w2, *rw_a0, *rw_a1, *rw_a2, *rw_g1, *rw_g2, *rw_kvec, *rw_lnx;
  float* out;
  u16 *wt_in, *wt_out, *wt_up, *wt_down, *wt_o, *wt_1, *wt_2;
  float* mod; float* xc;
  u16* H; u16* BIG; u16* QK; float* YO; u16* LR;
};

typedef const __attribute__((address_space(4))) Params CParams;

DI float bf2f(u16 v) { return __uint_as_float(((unsigned)v) << 16); }
typedef __bf16 bf16x2_t __attribute__((ext_vector_type(2)));
typedef float f32x2_t __attribute__((ext_vector_type(2)));
DI unsigned pack2(float a, float b) { f32x2_t v; v.x = a; v.y = b; return __builtin_bit_cast(unsigned, __builtin_convertvector(v, bf16x2_t)); }
DI u16 f2bf(float f) { return (u16)(pack2(f, 0.f) & 0xffffu); }
DI float lo16(unsigned u) { return __uint_as_float(u << 16); }
DI float hi16(unsigned u) { return __uint_as_float(u & 0xffff0000u); }
DI void unpack8(const uint4& v, float* o) {
  o[0] = lo16(v.x); o[1] = hi16(v.x); o[2] = lo16(v.y); o[3] = hi16(v.y);
  o[4] = lo16(v.z); o[5] = hi16(v.z); o[6] = lo16(v.w); o[7] = hi16(v.w);
}
DI uint4 pack8(const float* o) { uint4 v; v.x = pack2(o[0], o[1]); v.y = pack2(o[2], o[3]); v.z = pack2(o[4], o[5]); v.w = pack2(o[6], o[7]); return v; }
DI int crow(int reg, int h) { return (reg & 3) + 8 * (reg >> 2) + 4 * h; }
DI float wsum(float v) { for (int o = 32; o; o >>= 1) v += __shfl_xor(v, o); return v; }
DI float sigmoidf_(float x) { return 1.f / (1.f + __expf(-x)); }
DI float logsigf_(float x) { return fminf(x, 0.f) - log1pf(__expf(-fabsf(x))); }
DI float siluf_(float x) { return x / (1.f + __expf(-x)); }
DI bf16x8 cat4(s16x4 lo, s16x4 hi) { return __builtin_shufflevector(lo, hi, 0, 1, 2, 3, 4, 5, 6, 7); }
DI bf16x8 pack_step(const f32x16& x, int s) {
  uint4 v;
  v.x = pack2(x[8 * s + 0], x[8 * s + 1]); v.y = pack2(x[8 * s + 2], x[8 * s + 3]);
  v.z = pack2(x[8 * s + 4], x[8 * s + 5]); v.w = pack2(x[8 * s + 6], x[8 * s + 7]);
  return __builtin_bit_cast(bf16x8, v);
}
DI float dppf(float x, int) { return x; }
#define DPP_F(x, ctrl) __int_as_float(__builtin_amdgcn_update_dpp(0, __float_as_int(x), (ctrl), 0xF, 0xF, true))
DI float red8(float x) {
  x += DPP_F(x, 0x141);
  x += DPP_F(x, 0xB1);
  x += DPP_F(x, 0x4E);
  return x;
}

DI int scan_row(int base, int dir, int p) {
  if (dir == 0) return base + p;
  return (p < CTX) ? base + (CTX - 1 - p) : base + (TPS + CTX - 1 - p);
}

__device__ __forceinline__ void convert_job(const Ctx cx, const float* __restrict__ src, int K, int N, int Npad, u16* __restrict__ dst, int ldd, const float* __restrict__ mu, float* tile) {
  const int tx = cx.tid & 31, ty = cx.tid >> 5;
  const int tk = K >> 5, tn = Npad >> 5;
  for (int t = cx.bid; t < tk * tn; t += gridDim.x) {
    const int k0 = (t / tn) * 32, n0 = (t % tn) * 32;
#pragma unroll
    for (int i = 0; i < 2; ++i) {
      const int kk = k0 + ty + 16 * i, nn = n0 + tx;
      float v = (nn < N) ? src[(size_t)kk * N + nn] : 0.f;
      if (mu) v *= mu[kk];
      tile[(ty + 16 * i) * 33 + tx] = v;
    }
    __syncthreads();
#pragma unroll
    for (int i = 0; i < 2; ++i) {
      const int nn = n0 + ty + 16 * i, kk = k0 + tx;
      dst[(size_t)nn * ldd + kk] = f2bf(tile[tx * 33 + ty + 16 * i]);
    }
    __syncthreads();
  }
}

__device__ __forceinline__ void ph_mod(const Ctx cx, CParams& p, float* smem) {
  const int tid = cx.tid, lane = tid & 63, w = tid >> 6;
  float* sc = smem + w * (33 * 64);
  for (int u = cx.bid; u < 2 * 96; u += gridDim.x) {
    const int layer = u / 96, n = (u % 96) * 64 + lane;
    const float* W = p.w_mod + (size_t)layer * D * 6144;
    float acc[33];
#pragma unroll
    for (int i = 0; i < 33; ++i) acc[i] = 0.f;
    for (int kc = 0; kc < 2; ++kc) {
      const int k0 = w * 128 + kc * 64;
#pragma nounroll
      for (int cr = 0; cr < 33; ++cr) {
        const float v = (cr < 32) ? p.c[cr * D + k0 + lane] : p.c_ctx[k0 + lane];
        sc[cr * 64 + lane] = siluf_(v);
      }
      __syncthreads();
#pragma unroll 2
      for (int j = 0; j < 64; ++j) {
        const float wv = W[(size_t)(k0 + j) * 6144 + n];
#pragma unroll
        for (int cr = 0; cr < 33; ++cr) acc[cr] += sc[cr * 64 + j] * wv;
      }
      __syncthreads();
    }
#pragma unroll
    for (int cr = 0; cr < 33; ++cr) sc[cr * 64 + lane] = acc[cr];
    __syncthreads();
    if (w == 0) {
      const float bm = p.b_mod[layer * 6144 + n];
      for (int cr = 0; cr < 33; ++cr) {
        float s = 0.f;
#pragma unroll
        for (int q = 0; q < NWV; ++q) s += smem[q * 33 * 64 + cr * 64 + lane];
        p.mod[((size_t)layer * 33 + cr) * 6144 + n] = s + bm;
      }
    }
    __syncthreads();
  }
}

__device__ __forceinline__ void ph_prologue(const Ctx cx, CParams& p, float* smem) {
  ph_mod(cx, p, smem);
  convert_job(cx, p.ev_w_in, D, 3632, ZW, p.wt_in, D, nullptr, smem);
  convert_job(cx, p.ev_w_out, D, D, D, p.wt_out, D, nullptr, smem);
  for (int l = 0; l < 2; ++l) {
    convert_job(cx, p.ffn_w_up + (size_t)l * D * GUW, D, GUW, GUW, p.wt_up + (size_t)l * GUW * D, D, nullptr, smem);
    convert_job(cx, p.ffn_w_down + (size_t)l * DFF * D, DFF, D, D, p.wt_down + (size_t)l * D * DFF, DFF, nullptr, smem);
  }
  convert_job(cx, p.rw_w_o, D, D, D, p.wt_o, D, nullptr, smem);
  for (int half = 0; half < 2; ++half) {
    u16* dcol = p.wt_1 + half * D;
    const float* m0 = half ? p.rw_mu : nullptr;
    convert_job(cx, p.rw_w_rkv, D, D, D, dcol, K1, half ? m0 + 0 * D : nullptr, smem);
    convert_job(cx, p.rw_w_rkv + (size_t)D * D, D, D, D, dcol + (size_t)1024 * K1, K1, half ? m0 + 2 * D : nullptr, smem);
    convert_job(cx, p.rw_w_rkv + (size_t)2 * D * D, D, D, D, dcol + (size_t)2048 * K1, K1, half ? m0 + 3 * D : nullptr, smem);
    convert_job(cx, p.rw_w1, D, 64, 64, dcol + (size_t)3072 * K1, K1, half ? m0 + 1 * D : nullptr, smem);
    convert_job(cx, p.rw_w1 + D * 64, D, 64, 64, dcol + (size_t)3136 * K1, K1, half ? m0 + 1 * D : nullptr, smem);
    convert_job(cx, p.rw_a1, D, 64, 64, dcol + (size_t)3200 * K1, K1, half ? m0 + 4 * D : nullptr, smem);
    convert_job(cx, p.rw_g1, D, 128, 320, dcol + (size_t)3264 * K1, K1, half ? m0 + 5 * D : nullptr, smem);
  }
  for (size_t i = (size_t)cx.bid * NTHR + cx.tid; i < (size_t)N2 * K2; i += (size_t)gridDim.x * NTHR) {
    const int n = (int)(i / K2), c = (int)(i % K2), blk = n >> 10, nn = n & 1023;
    float v = 0.f;
    if (blk == 0) { if (c < 64) v = p.rw_w2[(size_t)c * D + nn]; }
    else if (blk == 1) { if (c >= 64 && c < 128) v = p.rw_w2[(size_t)(64 + c - 64) * D + nn]; }
    else if (blk == 2) { if (c >= 128 && c < 192) v = p.rw_a2[(size_t)(c - 128) * D + nn]; }
    else { if (c >= 192) v = p.rw_g2[(size_t)(c - 192) * D + nn]; }
    p.wt_2[i] = f2bf(v);
  }
}

DI void rowinfo(int g, int row, int& b, int& pos) { const int bl = row / TPS; pos = row - bl * TPS; b = g * SPG + bl; }

__device__ __forceinline__ void ph_norm0(const Ctx cx, CParams& p, int g) {
  const int lane = cx.tid & 63;
  const int gw = cx.bid * NWV + (cx.tid >> 6), nw = gridDim.x * NWV;
  for (int row = gw; row < R; row += nw) {
    int b, pos; rowinfo(g, row, b, pos);
    const float* src = (pos < CTX) ? p.ctx + ((size_t)(b * CTX + pos)) * D : p.x + ((size_t)(b * SEQ + pos - CTX)) * D;
    const float* md = p.mod + ((size_t)(pos < CTX ? 32 : b)) * 6144;
    float4 v[4]; float ss = 0.f;
#pragma unroll
    for (int j = 0; j < 4; ++j) { v[j] = ((const float4*)src)[j * 64 + lane]; ss += v[j].x * v[j].x + v[j].y * v[j].y + v[j].z * v[j].z + v[j].w * v[j].w; }
    ss = wsum(ss);
    const float rstd = rsqrtf(ss * (1.f / D) + 1e-6f);
#pragma unroll
    for (int j = 0; j < 4; ++j) {
      const int col = j * 256 + lane * 4;
      const float4 gg = *(const float4*)(p.norm_g + col);
      const float4 sh = *(const float4*)(md + col), sc = *(const float4*)(md + D + col);
      uint2 o;
      o.x = pack2(v[j].x * rstd * gg.x * (1.f + sc.x) + sh.x, v[j].y * rstd * gg.y * (1.f + sc.y) + sh.y);
      o.y = pack2(v[j].z * rstd * gg.z * (1.f + sc.z) + sh.z, v[j].w * rstd * gg.w * (1.f + sc.w) + sh.w);
      *(uint2*)(p.H + (size_t)row * D + col) = o;
    }
  }
}

__device__ __forceinline__ void ph_resid(const Ctx cx, CParams& p, int g, int layer, int which, bool lat_only) {
  const int lane = cx.tid & 63;
  const int gw = cx.bid * NWV + (cx.tid >> 6), nw = gridDim.x * NWV;
  const bool from_inputs = (layer == 0 && which == 0);
  const bool has_next = (which == 0) || (layer + 1 < 2);
  const float* ga = p.norm_g + (layer * 4 + (which ? 3 : 1)) * D;
  const float* gb = (which == 0) ? p.norm_g + (layer * 4 + 2) * D : p.norm_g + ((layer + 1) * 4 + 0) * D;
  for (int row = gw; row < R; row += nw) {
    int b, pos; rowinfo(g, row, b, pos);
    if (lat_only && pos < CTX) continue;
    const size_t ridx = (pos < CTX) ? ((size_t)(b * CTX + pos)) * D : ((size_t)(b * SEQ + pos - CTX)) * D;
    const float* src = from_inputs ? ((pos < CTX) ? p.ctx + ridx : p.x + ridx) : ((pos < CTX) ? p.xc + ridx : p.out + ridx);
    float* dst = (pos < CTX) ? p.xc + ridx : p.out + ridx;
    const int cr = (pos < CTX) ? 32 : b;
    const float* md = p.mod + ((size_t)layer * 33 + cr) * 6144;
    const float* mdn = (which == 0) ? md + 3 * D : p.mod + ((size_t)(layer + 1) * 33 + cr) * 6144;
    const float* gate = md + (which ? 5 : 2) * D;
    const u16* yo = (const u16*)p.YO + (size_t)row * D;
    float4 y[4], xv[4]; float ss = 0.f;
#pragma unroll
    for (int j = 0; j < 4; ++j) {
      const uint2 yb = ((const uint2*)yo)[j * 64 + lane];
      y[j].x = lo16(yb.x); y[j].y = hi16(yb.x); y[j].z = lo16(yb.y); y[j].w = hi16(yb.y);
      xv[j] = ((const float4*)src)[j * 64 + lane]; ss += y[j].x * y[j].x + y[j].y * y[j].y + y[j].z * y[j].z + y[j].w * y[j].w; }
    ss = wsum(ss);
    const float rstd = rsqrtf(ss * (1.f / D) + 1e-6f);
    float s2 = 0.f;
#pragma unroll
    for (int j = 0; j < 4; ++j) {
      const int col = j * 256 + lane * 4;
      const float4 g4 = *(const float4*)(ga + col), gt = *(const float4*)(gate + col);
      xv[j].x += gt.x * (y[j].x * rstd * g4.x); xv[j].y += gt.y * (y[j].y * rstd * g4.y);
      xv[j].z += gt.z * (y[j].z * rstd * g4.z); xv[j].w += gt.w * (y[j].w * rstd * g4.w);
      ((float4*)dst)[j * 64 + lane] = xv[j];
      s2 += xv[j].x * xv[j].x + xv[j].y * xv[j].y + xv[j].z * xv[j].z + xv[j].w * xv[j].w;
    }
    if (has_next) {
      s2 = wsum(s2);
      const float r2 = rsqrtf(s2 * (1.f / D) + 1e-6f);
#pragma unroll
      for (int j = 0; j < 4; ++j) {
        const int col = j * 256 + lane * 4;
        const float4 gg = *(const float4*)(gb + col);
        const float4 sh = *(const float4*)(mdn + col), sc = *(const float4*)(mdn + D + col);
        uint2 o;
        o.x = pack2(xv[j].x * r2 * gg.x * (1.f + sc.x) + sh.x, xv[j].y * r2 * gg.y * (1.f + sc.y) + sh.y);
        o.y = pack2(xv[j].z * r2 * gg.z * (1.f + sc.z) + sh.z, xv[j].w * r2 * gg.w * (1.f + sc.w) + sh.w);
        *(uint2*)(p.H + (size_t)row * D + col) = o;
      }
    }
  }
}

using f32x4 = __attribute__((ext_vector_type(4))) float;
using i32x4 = __attribute__((ext_vector_type(4))) int;
DI int lds_byte(int r, int c) {
  const int st = (r >> 4) * 2 + (c >> 5), ob = (r & 15) * 64 + (c & 31) * 2;
  return st * 1024 + (ob ^ (((ob >> 9) & 1) << 5));
}
DI void stage_rc(int b, int& Rr, int& Cc) {
  const int st = b >> 10, sb = b & 1023, swz = sb ^ (((sb >> 9) & 1) << 5);
  Rr = (st >> 1) * 16 + swz / 64;
  Cc = (st & 1) * 32 + (swz % 64) / 2;
}
constexpr int TILE_B = 256 * 64 * 2, STAGE_B = 2 * TILE_B;

DI const char* uni_ptr(const char* q) {
  const unsigned long long a = (unsigned long long)q;
  const unsigned lo = (unsigned)__builtin_amdgcn_readfirstlane((int)(unsigned)a), hi = (unsigned)__builtin_amdgcn_readfirstlane((int)(unsigned)(a >> 32));
  return (const char*)(((unsigned long long)hi << 32) | lo);
}
struct GUnit { const u16* A0; const u16* Bb; int ksplit, nt, brow, bcol; };
template <bool RW1>
DI GUnit gemm_unit(int u, int nN, int nMx, int xcd, bool lat_only, const u16* A0in, const u16* A2, int ksplit_in, int Kin, const u16* Bt, int ldb) {
  constexpr int GM = 4;
  const int grp = u / (GM * nN), fm = grp * GM, gsz = (nMx - fm) < GM ? (nMx - fm) : GM;
  const int rr_ = u - grp * (GM * nN);
  const int pn = rr_ / gsz, ml = fm + (rr_ - pn * gsz), pm = ml * 8 + xcd;
  GUnit g;
  g.brow = lat_only ? ((pm >> 3) * 9 + 1 + (pm & 7)) * 256 : pm * 256;
  g.bcol = pn * 256;
  g.A0 = A0in; g.ksplit = ksplit_in; int K = Kin;
  if constexpr (RW1) { if (pn < 12) { g.A0 = A2 + (size_t)(pn >> 2) * ((size_t)R * D); g.ksplit = 1 << 30; K = D; } }
  g.nt = K >> 6;
  g.Bb = Bt + (size_t)g.bcol * ldb;
  return g;
}
template <bool RW1 = false, class EP>
__device__ __forceinline__ void gemm256(const Ctx cx, const u16* __restrict__ A0in, const u16* __restrict__ A1, int ksplit_in, int lda,
                        const u16* __restrict__ Bt, int Kin, int nN, bool lat_only, const EP& ep, char* shm, const u16* __restrict__ A2 = nullptr) {
  const int wsg = __builtin_amdgcn_readfirstlane(cx.tid >> 6);
  const int wid = wsg, lane = cx.tid & 63;
  const int nM = lat_only ? SPG * 8 : R / 256;
  const int ldb = Kin;
  const int fragA = lds_byte((wsg >> 2) * 128 + (lane & 15), (lane >> 4) * 8), fragB = lds_byte((wsg & 3) * 64 + (lane & 15), (lane >> 4) * 8);
  const int xcd = cx.bid & 7, slot = cx.bid >> 3, nslot = gridDim.x >> 3, per_xcd = (nM >> 3) * nN;
  const int nMx = nM >> 3;
  if (slot < per_xcd) {
#define G_STAGE(buf, kt, UU, AO, BO) do { const int kb_ = (kt) * 64; const size_t ro_ = (size_t)(UU).brow * lda; \
    const char* Ab0_ = (const char*)((kb_ < (UU).ksplit) ? (UU).A0 + ro_ + kb_ : A1 + ro_ + (kb_ - (UU).ksplit)); \
    const char* Bb0_ = (const char*)((UU).Bb + kb_); \
    _Pragma("unroll") for (int i = 0; i < 4; ++i) { \
      const char* Ab_ = uni_ptr(Ab0_ + (size_t)i * 128 * lda); const char* Bb_ = uni_ptr(Bb0_ + (size_t)i * 128 * ldb);     \
      __builtin_amdgcn_global_load_lds((const unsigned*)(Ab_ + AO), (__attribute__((address_space(3))) unsigned*)(shm + (buf) * STAGE_B + wid * 1024 + i * 8192), 16, 0, 0); \
      __builtin_amdgcn_global_load_lds((const unsigned*)(Bb_ + BO), (__attribute__((address_space(3))) unsigned*)(shm + (buf) * STAGE_B + TILE_B + wid * 1024 + i * 8192), 16, 0, 0); } } while (0)
#define G_OFFS(UU, AO, BO) do { int sR, sC; stage_rc(wid * 1024 + lane * 16, sR, sC); \
      AO = (unsigned)((sR * lda + sC) * 2); BO = (unsigned)((sR * ldb + sC) * 2); } while (0)
  int u = slot;
  GUnit cu = gemm_unit<RW1>(u, nN, nMx, xcd, lat_only, A0in, A2, ksplit_in, Kin, Bt, ldb);
  unsigned aoff, boff;
  G_OFFS(cu, aoff, boff);
  G_STAGE(0, 0, cu, aoff, boff);
  asm volatile("s_waitcnt vmcnt(0)" ::: "memory");
  __syncthreads();
  int gt = 0;
  for (;;) {
    const int un = u + nslot;
    const bool has_next = un < per_xcd;
    f32x4 acc[8][4];
#pragma unroll
    for (int m = 0; m < 8; ++m)
#pragma unroll
      for (int n = 0; n < 4; ++n) acc[m][n] = (f32x4){0.f, 0.f, 0.f, 0.f};
    const int nt = cu.nt;
#pragma nounroll
    for (int t = 0; t < nt; ++t) {
      const int cur = gt & 1;
      if (t + 1 < nt) G_STAGE(cur ^ 1, t + 1, cu, aoff, boff);
      else if (has_next) {
        const GUnit nu = gemm_unit<RW1>(un, nN, nMx, xcd, lat_only, A0in, A2, ksplit_in, Kin, Bt, ldb);
        G_STAGE(cur ^ 1, 0, nu, aoff, boff);
      }
      const char* SAp = shm + cur * STAGE_B; const char* SBp = SAp + TILE_B;
      {
        bf16x8 At[8], Bf[4];
        const char* abase = SAp + fragA;
        const char* bbase = SBp + fragB;
#pragma unroll
        for (int n = 0; n < 4; ++n) Bf[n] = *(const bf16x8*)(bbase + n * 2048);
#pragma unroll
        for (int m = 0; m < 8; ++m) At[m] = *(const bf16x8*)(abase + m * 2048);
        __builtin_amdgcn_sched_barrier(0);
#pragma unroll
        for (int m = 0; m < 7; ++m) {
#pragma unroll
          for (int n = 0; n < 4; ++n) acc[m][n] = __builtin_amdgcn_mfma_f32_16x16x32_bf16(Bf[n], At[m], acc[m][n], 0, 0, 0);
          At[m] = *(const bf16x8*)(abase + m * 2048 + 1024);
          __builtin_amdgcn_sched_barrier(0);
        }
#pragma unroll
        for (int n = 0; n < 4; ++n) {
          acc[7][n] = __builtin_amdgcn_mfma_f32_16x16x32_bf16(Bf[n], At[7], acc[7][n], 0, 0, 0);
          Bf[n] = *(const bf16x8*)(bbase + n * 2048 + 1024);
          __builtin_amdgcn_sched_barrier(0);
        }
        At[7] = *(const bf16x8*)(abase + 7 * 2048 + 1024);
        __builtin_amdgcn_sched_barrier(0);
#pragma unroll
        for (int n = 0; n < 4; ++n) {
#pragma unroll
          for (int m = 0; m < 8; ++m) acc[m][n] = __builtin_amdgcn_mfma_f32_16x16x32_bf16(Bf[n], At[m], acc[m][n], 0, 0, 0);
          __builtin_amdgcn_sched_barrier(0);
        }
      }
      asm volatile("s_waitcnt vmcnt(0)" ::: "memory");
      __syncthreads();
      ++gt;
    }
    {
      char* ob = shm + ((gt - 1) & 1) * STAGE_B;
      int lane_ = (int)__builtin_amdgcn_mbcnt_hi(~0u, __builtin_amdgcn_mbcnt_lo(~0u, 0u));
      asm volatile("" : "+v"(lane_));
      const int tid = (wsg << 6) | lane_, wr = wsg >> 2, wc = wsg & 3, fr = lane_ & 15, fq = lane_ >> 4;
#pragma unroll
      for (int half = 0; half < 2; ++half) {
        if (wr == half) {
#pragma unroll
          for (int m = 0; m < 8; ++m) {
#pragma unroll
            for (int n = 0; n < 4; ++n) {
              const int rl = m * 16 + fr, cl = wc * 64 + n * 16 + fq * 4;
              const f32x4 v = ep.conv(cu.brow + half * 128 + rl, cu.bcol + cl, acc[m][n]);
              uint2 o; o.x = pack2(v[0], v[1]); o.y = pack2(v[2], v[3]);
              *(uint2*)(ob + rl * 512 + ((((cl >> 3) ^ rl) & 31) << 4) + (cl & 7) * 2) = o;
            }
            __builtin_amdgcn_sched_barrier(0);
          }
        }
        __syncthreads();
#pragma unroll
        for (int j = 0; j < 8; ++j) {
          const int id = j * 512 + tid, rl = id >> 5, c16 = id & 31;
          const uint4 val = *(const uint4*)(ob + rl * 512 + (((c16 ^ rl) & 31) << 4));
          u16* dp = ep.dst(cu.brow + half * 128 + rl, cu.bcol + c16 * 8);
          if (dp) *(uint4*)dp = val;
        }
        __syncthreads();
      }
    }
    if (!has_next) break;
    u = un;
    cu = gemm_unit<RW1>(u, nN, nMx, xcd, lat_only, A0in, A2, ksplit_in, Kin, Bt, ldb);
  }
  }
#undef G_STAGE
#undef G_OFFS
}

DI float tanh_fast(float x) { x = fminf(fmaxf(x, -15.f), 15.f); const float t = __expf(2.f * x); return (t - 1.f) / (t + 1.f); }
DI float decay_m1(float lw) {
  const float el = __expf(-fabsf(lw));
  const float ls = fminf(lw, 0.f) - __logf(1.f + el);
  const float e = __expf(ls - 0.5f);
  return __expf(-e) - 1.f;
}
struct EpBf16 {
  u16* base; int ld;
  DI f32x4 conv(int, int, f32x4 v) const { return v; }
  DI u16* dst(int row, int col) const { return base + (size_t)row * ld + col; }
};
struct EpRw1 {
  u16* big; u16* lr;
  DI f32x4 conv(int, int col, f32x4 v) const {
    const int cu = __builtin_amdgcn_readfirstlane(col >> 6);
    if (cu >= 48 && cu < 50) { v[0] = tanh_fast(v[0]); v[1] = tanh_fast(v[1]); v[2] = tanh_fast(v[2]); v[3] = tanh_fast(v[3]); }
    else if (cu >= 51 && cu < 53) { v[0] = sigmoidf_(v[0]); v[1] = sigmoidf_(v[1]); v[2] = sigmoidf_(v[2]); v[3] = sigmoidf_(v[3]); }
    return v;
  }
  DI u16* dst(int row, int col) const {
    if (col < 3072) return big + (size_t)(col >> 10) * ((size_t)R * D) + (size_t)row * D + (col & 1023);
    if (col < 3392) return lr + (size_t)row * K2 + (col - 3072);
    return nullptr;
  }
};
struct EpRw2 {
  u16* big; u16* gq; const float* w0; const float* a0;
  DI f32x4 conv(int, int col, f32x4 v) const {
    const int blk = __builtin_amdgcn_readfirstlane(col >> 10), cc = col & 1023;
    if (blk < 2) {
      const float4 ww = *(const float4*)(w0 + blk * D + cc);
      v[0] = decay_m1(v[0] + ww.x); v[1] = decay_m1(v[1] + ww.y); v[2] = decay_m1(v[2] + ww.z); v[3] = decay_m1(v[3] + ww.w);
    } else if (blk == 2) {
      const float4 ww = *(const float4*)(a0 + cc);
      v[0] = sigmoidf_(v[0] + ww.x); v[1] = sigmoidf_(v[1] + ww.y); v[2] = sigmoidf_(v[2] + ww.z); v[3] = sigmoidf_(v[3] + ww.w);
    }
    return v;
  }
  DI u16* dst(int row, int col) const {
    const int blk = col >> 10, cc = col & 1023;
    if (blk < 2) return big + (size_t)(4 + blk) * ((size_t)R * D) + (size_t)row * D + cc;
    if (blk == 2) return big + (size_t)3 * ((size_t)R * D) + (size_t)row * D + cc;
    return gq + (size_t)row * D + cc;
  }
};

__device__ __forceinline__ void ph_qkconv(const Ctx cx, CParams& p, int g) {
  const size_t total = (size_t)R * 128;
  for (size_t i = (size_t)cx.bid * NTHR + cx.tid; i < total; i += (size_t)gridDim.x * NTHR) {
    const int row = (int)(i >> 7), c0 = ((int)(i & 127)) * 8;
    int b, pos; rowinfo(g, row, b, pos);
    const bool hasp = (pos != 0 && pos != CTX), hasn = (pos != CTX - 1 && pos != TPS - 1);
    const u16* Z = p.BIG + (size_t)row * ZW + c0;
    float cur[8], pv[8], nx[8];
    unpack8(*(const uint4*)Z, cur);
    if (hasp) unpack8(*(const uint4*)(Z - ZW), pv); else { for (int e = 0; e < 8; ++e) pv[e] = 0.f; }
    if (hasn) unpack8(*(const uint4*)(Z + ZW), nx); else { for (int e = 0; e < 8; ++e) nx[e] = 0.f; }
    const float scale = (c0 < 512) ? 0.08838834764831845f : 1.f;
    float o[8];
#pragma unroll
    for (int e = 0; e < 8; ++e) {
      const int c = c0 + e;
      const float v = pv[e] * p.ev_conv_w[c] + cur[e] * p.ev_conv_w[D + c] + nx[e] * p.ev_conv_w[2 * D + c] + p.ev_conv_b[c];
      o[e] = siluf_(v) * scale;
    }
    *(uint4*)(p.QK + (size_t)row * D + c0) = pack8(o);
  }
}

__device__ __forceinline__ void mlstm_item(const Ctx cx, CParams& p, int item, char* smem) {
  const int tid = cx.tid, lane = tid & 63, w = tid >> 6, r = lane & 31, h = lane >> 5;
  const int bl = item >> 3, head = (item >> 1) & 3, dir = item & 1;
  const int base = bl * TPS;
  u16* sQ = (u16*)smem;
  u16* sK = sQ + 32 * 136;
  u16* sVT = sK + 32 * 136;
  u16* sKT = sVT + 128 * 40;
  float* sU = (float*)(sKT + 128 * 40);
  float* sM = sU + 32; float* sBc = sM + 32; float* sLast = sBc + 32;
  float* sN = sLast + 32;
  float* sRD = sN + 128;
  float* sWI = sRD + 128;
  const u16* Z = p.BIG;
  u16* Y = p.BIG + (size_t)R * ZW + (size_t)dir * R * 512;
  const float bgi = p.ev_b_gates[(2 * dir) * 4 + head], bgf = p.ev_b_gates[(2 * dir + 1) * 4 + head];
  f32x16 cacc[4];
#pragma unroll
  for (int a = 0; a < 4; ++a)
#pragma unroll
    for (int i = 0; i < 16; ++i) cacc[a][i] = 0.f;
  if (tid < 128) sN[tid] = 0.f;
  float m = 0.f;
  const bool act = tid < 256;
  const int lr = (tid >> 3) & 31, lc = tid & 7;
  uint4 q0, q1, k0, k1, v0, v1;
  u16 gzi = 0, gzf = 0;
#define ML_LOAD(p0_) do { if (act) { const int grow = scan_row(base, dir, (p0_) + lr); \
      q0 = *(const uint4*)(p.QK + (size_t)grow * D + head * 128 + lc * 8); \
      q1 = *(const uint4*)(p.QK + (size_t)grow * D + head * 128 + lc * 8 + 64); \
      k0 = *(const uint4*)(p.QK + (size_t)grow * D + 512 + head * 128 + lc * 8); \
      k1 = *(const uint4*)(p.QK + (size_t)grow * D + 512 + head * 128 + lc * 8 + 64); \
      v0 = *(const uint4*)(Z + (size_t)grow * ZW + 1024 + head * 128 + lc * 8); \
      v1 = *(const uint4*)(Z + (size_t)grow * ZW + 1024 + head * 128 + lc * 8 + 64); } \
    if (w == 0) { const int row_ = scan_row(base, dir, (p0_) + (lane & 31)); \
      gzi = Z[(size_t)row_ * ZW + 2048 + (2 * dir) * 4 + head]; gzf = Z[(size_t)row_ * ZW + 2048 + (2 * dir + 1) * 4 + head]; } } while (0)
  ML_LOAD(0);
  for (int ch = 0; ch < TPS / 32; ++ch) {
    const int p0 = ch * 32;
    __syncthreads();
    if (w == 0) {
      const int t = lane & 31;
      const float zi = bf2f(gzi) + bgi;
      const float zf = bf2f(gzf) + bgf;
      float bsum = logsigf_(zf);
      for (int o = 1; o < 32; o <<= 1) { const float v = __shfl_up(bsum, o); if (t >= o) bsum += v; }
      const float u = zi - bsum;
      float pm = u;
      for (int o = 1; o < 32; o <<= 1) { const float v = __shfl_up(pm, o); if (t >= o) pm = fmaxf(pm, v); }
      const float M = fmaxf(m, pm);
      if (lane < 32) { sU[t] = u; sM[t] = M; sBc[t] = bsum; if (t == 31) { sLast[0] = M; sLast[1] = bsum; } }
    }
    __syncthreads();
    const float Mlast = sLast[0], blast = sLast[1];
    if (act) {
      const float ws = __expf(sU[lr] - Mlast);
      *(uint4*)(sQ + lr * 136 + lc * 8) = q0; *(uint4*)(sQ + lr * 136 + lc * 8 + 64) = q1;
      *(uint4*)(sK + lr * 136 + lc * 8) = k0; *(uint4*)(sK + lr * 136 + lc * 8 + 64) = k1;
      float f[8];
      unpack8(k0, f);
#pragma unroll
      for (int e = 0; e < 8; ++e) sKT[(lc * 8 + e) * 40 + lr] = f2bf(f[e] * ws);
      unpack8(k1, f);
#pragma unroll
      for (int e = 0; e < 8; ++e) sKT[(lc * 8 + 64 + e) * 40 + lr] = f2bf(f[e] * ws);
      const u16* pv0 = (const u16*)&v0; const u16* pv1 = (const u16*)&v1;
#pragma unroll
      for (int e = 0; e < 8; ++e) { sVT[(lc * 8 + e) * 40 + lr] = pv0[e]; sVT[(lc * 8 + 64 + e) * 40 + lr] = pv1[e]; }
    }
    if (ch + 1 < TPS / 32) ML_LOAD(p0 + 32);
    __syncthreads();
    f32x16 st;
#pragma unroll
    for (int i = 0; i < 16; ++i) st[i] = 0.f;
    if (act) {
#pragma unroll
    for (int ks = 0; ks < 8; ++ks) {
      const bf16x8 a = *(const bf16x8*)(sK + r * 136 + 16 * ks + 8 * h);
      const bf16x8 b = *(const bf16x8*)(sQ + r * 136 + 16 * ks + 8 * h);
      st = MFMA(a, b, st);
    }
    const float Mt = sM[r];
    float dsum = 0.f;
#pragma unroll
    for (int i = 0; i < 16; ++i) {
      const int s = crow(i, h);
      const float pv = (s <= r) ? st[i] * __expf(sU[s] - Mt) : 0.f;
      st[i] = pv; dsum += pv;
    }
    dsum += __shfl_xor(dsum, 32);
    float qn = 0.f;
#pragma unroll
    for (int d8 = 0; d8 < 8; ++d8) {
      float qf[8]; unpack8(*(const uint4*)(sQ + r * 136 + 64 * h + 8 * d8), qf);
#pragma unroll
      for (int e = 0; e < 8; ++e) qn += qf[e] * sN[64 * h + 8 * d8 + e];
    }
    qn += __shfl_xor(qn, 32);
    const float wi = __expf(m - Mt);
    const float den = dsum + wi * qn;
    const float dn = fmaxf(fabsf(den), __expf(-(sBc[r] + Mt)));
    if (h == 0) { sRD[w * 32 + r] = 1.f / dn; sWI[w * 32 + r] = wi; }
    }
    __syncthreads();
    const float wp = __expf(m - Mlast);
    if (act) {
    f32x16 o;
#pragma unroll
    for (int i = 0; i < 16; ++i) o[i] = 0.f;
#pragma unroll
    for (int mb = 0; mb < 4; ++mb)
#pragma unroll
      for (int s2 = 0; s2 < 2; ++s2) {
        const bf16x8 cb = pack_step(cacc[mb], s2);
        const u16* qp = sQ + r * 136 + 32 * mb + 16 * s2 + 4 * h;
        const bf16x8 a = cat4(*(const s16x4*)qp, *(const s16x4*)(qp + 8));
        o = MFMA(a, cb, o);
      }
#pragma unroll
    for (int i = 0; i < 16; ++i) o[i] *= sWI[w * 32 + crow(i, h)];
#pragma unroll
    for (int s2 = 0; s2 < 2; ++s2) {
      const bf16x8 a = pack_step(st, s2);
      const u16* vp = sVT + (32 * w + r) * 40 + 16 * s2 + 4 * h;
      const bf16x8 b = cat4(*(const s16x4*)vp, *(const s16x4*)(vp + 8));
      o = MFMA(a, b, o);
    }
#pragma unroll
    for (int i = 0; i < 16; ++i) {
      const int t = crow(i, h);
      const int row = scan_row(base, dir, p0 + t);
      Y[(size_t)row * 512 + head * 128 + 32 * w + r] = f2bf(o[i] * sRD[w * 32 + t]);
    }
#pragma unroll
    for (int mb = 0; mb < 4; ++mb) {
#pragma unroll
      for (int i = 0; i < 16; ++i) cacc[mb][i] *= wp;
#pragma unroll
      for (int s2 = 0; s2 < 2; ++s2) {
        const bf16x8 a = *(const bf16x8*)(sKT + (32 * mb + r) * 40 + 16 * s2 + 8 * h);
        const bf16x8 b = *(const bf16x8*)(sVT + (32 * w + r) * 40 + 16 * s2 + 8 * h);
        cacc[mb] = MFMA(a, b, cacc[mb]);
      }
    }
    }
    __syncthreads();
    if (tid < 128) {
      float s = 0.f;
#pragma unroll
      for (int e = 0; e < 32; ++e) s += bf2f(sKT[tid * 40 + e]);
      sN[tid] = wp * sN[tid] + s;
    }
    m = blast + Mlast;
  }
#undef ML_LOAD
}

__device__ __forceinline__ void gla_item(const Ctx cx, CParams& p, int item, char* smem) {
  const int tid = cx.tid, lane = tid & 63, w = tid >> 6, r = lane & 31, h = lane >> 5;
  const int bl = item >> 3, head = (item >> 1) & 3, dir = item & 1;
  const int base = bl * TPS;
  u16* sQ = (u16*)smem;
  u16* sK = sQ + 32 * 72;
  u16* sKT = sK + 32 * 72;
  u16* sVT = sKT + 64 * 40;
  float* sLa = (float*)(sVT + 128 * 40);
  float* sW2 = sLa + 32 * 64;
  float* sBi = sW2 + 16 * 64;
  const u16* Z = p.BIG;
  u16* Y = p.BIG + (size_t)R * ZW + (size_t)(2 + dir) * R * 512;
  for (int i = tid; i < 16 * 64; i += NTHR) sW2[i] = p.ev_gla_w2[((size_t)dir * 16 + (i >> 6)) * 256 + head * 64 + (i & 63)];
  if (tid < 64) sBi[tid] = p.ev_gla_b[dir * 256 + head * 64 + tid];
  f32x16 sacc[2];
#pragma unroll
  for (int a = 0; a < 2; ++a)
#pragma unroll
    for (int i = 0; i < 16; ++i) sacc[a][i] = 0.f;
  const bool act = tid < 256;
  const int lr = (tid >> 3) & 31, lc = tid & 7;
  uint4 gq, gk, v0, v1, gl0, gl1;
#define GLA_LOAD(p0_) do { if (act) { const int grow = scan_row(base, dir, (p0_) + lr); const u16* zr = Z + (size_t)grow * ZW; \
      gq = *(const uint4*)(zr + 2064 + head * 64 + lc * 8); gk = *(const uint4*)(zr + 2320 + head * 64 + lc * 8); \
      v0 = *(const uint4*)(zr + 2576 + head * 128 + lc * 8); v1 = *(const uint4*)(zr + 2576 + head * 128 + lc * 8 + 64); \
      gl0 = *(const uint4*)(zr + 3600 + dir * 16); gl1 = *(const uint4*)(zr + 3600 + dir * 16 + 8); } } while (0)
  GLA_LOAD(0);
  for (int ch = 0; ch < TPS / 32; ++ch) {
    const int p0 = ch * 32;
    __syncthreads();
    if (act) {
      float gl[16];
      unpack8(gl0, gl); unpack8(gl1, gl + 8);
#pragma unroll
      for (int e = 0; e < 8; ++e) {
        const int c = lc * 8 + e;
        float xv = sBi[c];
#pragma unroll
        for (int q = 0; q < 16; ++q) xv += gl[q] * sW2[q * 64 + c];
        sLa[lr * 64 + c] = logsigf_(xv) * (1.f / 16.f);
      }
    }
    __syncthreads();
    if (tid < 64) {
      float lv[32];
#pragma unroll
      for (int t = 0; t < 32; ++t) lv[t] = sLa[t * 64 + tid];
      float b = 0.f;
#pragma unroll
      for (int t = 0; t < 32; ++t) { b += lv[t]; sLa[t * 64 + tid] = b; }
    }
    __syncthreads();
    if (act) {
      float qf[8], kf[8], o[8];
      unpack8(gq, qf); unpack8(gk, kf);
#pragma unroll
      for (int e = 0; e < 8; ++e) { const float bb = sLa[lr * 64 + lc * 8 + e]; qf[e] *= 0.125f * __expf(bb); kf[e] *= __expf(-bb); }
      *(uint4*)(sQ + lr * 72 + lc * 8) = pack8(qf);
      *(uint4*)(sK + lr * 72 + lc * 8) = pack8(kf);
#pragma unroll
      for (int e = 0; e < 8; ++e) sKT[(lc * 8 + e) * 40 + lr] = f2bf(kf[e]);
      (void)o;
      const u16* pv0 = (const u16*)&v0; const u16* pv1 = (const u16*)&v1;
#pragma unroll
      for (int e = 0; e < 8; ++e) { sVT[(lc * 8 + e) * 40 + lr] = pv0[e]; sVT[(lc * 8 + 64 + e) * 40 + lr] = pv1[e]; }
    }
    if (ch + 1 < TPS / 32) GLA_LOAD(p0 + 32);
    __syncthreads();
    if (act) {
    f32x16 st;
#pragma unroll
    for (int i = 0; i < 16; ++i) st[i] = 0.f;
#pragma unroll
    for (int ks = 0; ks < 4; ++ks) {
      const bf16x8 a = *(const bf16x8*)(sK + r * 72 + 16 * ks + 8 * h);
      const bf16x8 b = *(const bf16x8*)(sQ + r * 72 + 16 * ks + 8 * h);
      st = MFMA(a, b, st);
    }
#pragma unroll
    for (int i = 0; i < 16; ++i) { if (crow(i, h) > r) st[i] = 0.f; }
    f32x16 o;
#pragma unroll
    for (int i = 0; i < 16; ++i) o[i] = 0.f;
#pragma unroll
    for (int mb = 0; mb < 2; ++mb)
#pragma unroll
      for (int s2 = 0; s2 < 2; ++s2) {
        const bf16x8 cb = pack_step(sacc[mb], s2);
        const u16* qp = sQ + r * 72 + 32 * mb + 16 * s2 + 4 * h;
        const bf16x8 a = cat4(*(const s16x4*)qp, *(const s16x4*)(qp + 8));
        o = MFMA(a, cb, o);
      }
#pragma unroll
    for (int s2 = 0; s2 < 2; ++s2) {
      const bf16x8 a = pack_step(st, s2);
      const u16* vp = sVT + (32 * w + r) * 40 + 16 * s2 + 4 * h;
      const bf16x8 b = cat4(*(const s16x4*)vp, *(const s16x4*)(vp + 8));
      o = MFMA(a, b, o);
    }
#pragma unroll
    for (int i = 0; i < 16; ++i) {
      const int row = scan_row(base, dir, p0 + crow(i, h));
      Y[(size_t)row * 512 + head * 128 + 32 * w + r] = f2bf(o[i]);
    }
#pragma unroll
    for (int mb = 0; mb < 2; ++mb) {
#pragma unroll
      for (int s2 = 0; s2 < 2; ++s2) {
        const bf16x8 a = *(const bf16x8*)(sKT + (32 * mb + r) * 40 + 16 * s2 + 8 * h);
        const bf16x8 b = *(const bf16x8*)(sVT + (32 * w + r) * 40 + 16 * s2 + 8 * h);
        sacc[mb] = MFMA(a, b, sacc[mb]);
      }
#pragma unroll
      for (int i = 0; i < 16; ++i) sacc[mb][i] *= __expf(sLa[31 * 64 + 32 * mb + crow(i, h)]);
    }
    }
  }
#undef GLA_LOAD
}

__device__ __forceinline__ void ph_scan0(const Ctx cx, CParams& p, char* smem) {
  for (int it = cx.bid; it < 2 * SPG * 8; it += gridDim.x) {
    __syncthreads();
    if (it < SPG * 8) mlstm_item(cx, p, it, smem); else gla_item(cx, p, it - SPG * 8, smem);
  }
}

__device__ __forceinline__ void ph_evout(const Ctx cx, CParams& p, int g) {
  const int lane = cx.tid & 63;
  const int gw = cx.bid * NWV + (cx.tid >> 6), nw = gridDim.x * NWV;
  const u16* Yb = p.BIG + (size_t)R * ZW;
  for (int row = gw; row < R; row += nw) {
    const int c0 = lane * 16;
    const int part = c0 >> 9, cc = c0 & 511;
    const u16* yf = Yb + ((size_t)(2 * part) * R + row) * 512 + cc;
    const u16* yb = Yb + ((size_t)(2 * part + 1) * R + row) * 512 + cc;
    float a[16], b[16];
    unpack8(*(const uint4*)yf, a); unpack8(*(const uint4*)(yf + 8), a + 8);
    unpack8(*(const uint4*)yb, b); unpack8(*(const uint4*)(yb + 8), b + 8);
    float ss = 0.f;
#pragma unroll
    for (int e = 0; e < 16; ++e) { a[e] += b[e]; ss += a[e] * a[e]; }
    ss += __shfl_xor(ss, 1); ss += __shfl_xor(ss, 2); ss += __shfl_xor(ss, 4);
    const float rstd = rsqrtf(ss * (1.f / 128.f) + 1e-6f);
    const u16* zg = p.BIG + (size_t)row * ZW + (part ? 3088 : 1536) + cc;
    float gt[16];
    unpack8(*(const uint4*)zg, gt); unpack8(*(const uint4*)(zg + 8), gt + 8);
#pragma unroll
    for (int e = 0; e < 16; ++e) {
      const float gv = part ? siluf_(gt[e]) : sigmoidf_(gt[e]);
      a[e] = a[e] * rstd * p.ev_head_g[c0 + e] * gv;
    }
    *(uint4*)(p.H + (size_t)row * D + c0) = pack8(a);
    *(uint4*)(p.H + (size_t)row * D + c0 + 8) = pack8(a + 8);
  }
}

__device__ __forceinline__ void ph_ffnact(const Ctx cx, CParams& p, int g, int layer, bool lat_only) {
  const float* cw = p.ffn_conv_w + (size_t)layer * 9 * DFF;
  const float* cb = p.ffn_conv_b + (size_t)layer * DFF;
  constexpr int SEG = 16, NSEG = TPS / SEG;
  const int total = SPG * NSEG * 352;
  for (int it = cx.bid * NTHR + cx.tid; it < total; it += gridDim.x * NTHR) {
    const int cg = it % 352, sg = (it / 352) % NSEG, s = it / (352 * NSEG);
    const int f0 = cg * 8;
    const int pos0 = sg * SEG;
    const bool isctx = pos0 < CTX;
    if (lat_only && isctx) continue;
    bool has_up = false, has_dn = false, has_l, has_r;
    if (isctx) { has_l = pos0 > 0; has_r = pos0 + SEG < CTX; }
    else { const int lp = pos0 - CTX, gr = lp >> 6, gc0 = lp & 63; has_up = gr > 0; has_dn = gr < 31; has_l = gc0 > 0; has_r = gc0 + SEG < 64; }
    float w[3][3][8], bias[8];
#pragma unroll
    for (int dh = 0; dh < 3; ++dh)
#pragma unroll
      for (int dw = 0; dw < 3; ++dw) {
        const float4 w0 = *(const float4*)(cw + (dh * 3 + dw) * DFF + f0), w1 = *(const float4*)(cw + (dh * 3 + dw) * DFF + f0 + 4);
        w[dh][dw][0] = w0.x; w[dh][dw][1] = w0.y; w[dh][dw][2] = w0.z; w[dh][dw][3] = w0.w;
        w[dh][dw][4] = w1.x; w[dh][dw][5] = w1.y; w[dh][dw][6] = w1.z; w[dh][dw][7] = w1.w;
      }
    { const float4 b0 = *(const float4*)(cb + f0), b1 = *(const float4*)(cb + f0 + 4);
      bias[0] = b0.x; bias[1] = b0.y; bias[2] = b0.z; bias[3] = b0.w; bias[4] = b1.x; bias[5] = b1.y; bias[6] = b1.z; bias[7] = b1.w; }
    u16* gu = p.BIG + (size_t)(s * TPS + pos0) * GUW + f0;
    float c0[3][8], c1[3][8], c2[3][8];
    uint4 nx[3];
#define FA_LD1(d, tok_, ok_) do { const bool o_ = (ok_); const uint4 r_ = *(const uint4*)(gu + (ptrdiff_t)(o_ ? (tok_) : 0) * GUW); \
      d.x = o_ ? r_.x : 0u; d.y = o_ ? r_.y : 0u; d.z = o_ ? r_.z : 0u; d.w = o_ ? r_.w : 0u; } while (0)
#define FA_LOAD(dst, tok, ok) do { FA_LD1(dst[1], (tok), (ok)); FA_LD1(dst[0], (tok) - 64, (ok) && has_up); FA_LD1(dst[2], (tok) + 64, (ok) && has_dn); } while (0)
    FA_LOAD(nx, -1, has_l);
    unpack8(nx[0], c0[0]); unpack8(nx[1], c0[1]); unpack8(nx[2], c0[2]);
    FA_LOAD(nx, 0, true);
    unpack8(nx[0], c1[0]); unpack8(nx[1], c1[1]); unpack8(nx[2], c1[2]);
    FA_LOAD(nx, 1, true);
#pragma unroll 2
    for (int t = 0; t < SEG; ++t) {
      unpack8(nx[0], c2[0]); unpack8(nx[1], c2[1]); unpack8(nx[2], c2[2]);
      const uint4 upraw = *(const uint4*)(gu + (ptrdiff_t)t * GUW + DFF);
      { const int tn = t + 2; const bool ok = (tn < SEG) || (tn == SEG && has_r); FA_LOAD(nx, tn, ok); }
      float acc[8];
#pragma unroll
      for (int e = 0; e < 8; ++e) {
        float a = bias[e];
#pragma unroll
        for (int dh = 0; dh < 3; ++dh) a += c0[dh][e] * w[dh][0][e] + c1[dh][e] * w[dh][1][e] + c2[dh][e] * w[dh][2][e];
        acc[e] = a;
      }
      float up[8]; unpack8(upraw, up);
#pragma unroll
      for (int e = 0; e < 8; ++e) {
        const float xg = acc[e];
        const float th = tanh_fast(0.7978845608028654f * (xg + 0.044715f * xg * xg * xg));
        up[e] *= 0.5f * xg * (1.f + th);
      }
      *(uint4*)(gu + (ptrdiff_t)t * GUW + DFF) = pack8(up);
#pragma unroll
      for (int dh = 0; dh < 3; ++dh)
#pragma unroll
        for (int e = 0; e < 8; ++e) { c0[dh][e] = c1[dh][e]; c1[dh][e] = c2[dh][e]; }
    }
#undef FA_LOAD
#undef FA_LD1
  }
}

__device__ __forceinline__ void ph_xx(const Ctx cx, CParams& p, int g) {
  const size_t total = (size_t)R * 128;
  for (size_t i = (size_t)cx.bid * NTHR + cx.tid; i < total; i += (size_t)gridDim.x * NTHR) {
    const int row = (int)(i >> 7), c0 = ((int)(i & 127)) * 8;
    int b, pos; rowinfo(g, row, b, pos);
    const int q = c0 >> 8;
    int off = 0; bool ok;
    if (pos < CTX) {
      if ((q & 1) == 0) { off = -1; ok = pos > 0; } else { off = 1; ok = pos < CTX - 1; }
    } else {
      const int lp = pos - CTX, gr = lp >> 6, gc = lp & 63;
      if (q == 0) { off = -1; ok = gc > 0; }
      else if (q == 1) { off = 1; ok = gc < 63; }
      else if (q == 2) { off = -64; ok = gr > 0; }
      else { off = 64; ok = gr < 31; }
    }
    float hc[8], hs[8];
    unpack8(*(const uint4*)(p.H + (size_t)row * D + c0), hc);
    if (ok) unpack8(*(const uint4*)(p.H + (size_t)(row + off) * D + c0), hs); else { for (int e = 0; e < 8; ++e) hs[e] = 0.f; }
#pragma unroll
    for (int e = 0; e < 8; ++e) hs[e] -= hc[e];
    *(uint4*)(p.QK + (size_t)row * D + c0) = pack8(hs);
    float m_[8];
    const size_t RS_ = (size_t)R * D;
#pragma unroll
    for (int e = 0; e < 8; ++e) m_[e] = hc[e] + hs[e] * p.rw_mu[0 * D + c0 + e];
    *(uint4*)(p.BIG + 3 * RS_ + (size_t)row * D + c0) = pack8(m_);
#pragma unroll
    for (int e = 0; e < 8; ++e) m_[e] = hc[e] + hs[e] * p.rw_mu[2 * D + c0 + e];
    *(uint4*)(p.BIG + 4 * RS_ + (size_t)row * D + c0) = pack8(m_);
#pragma unroll
    for (int e = 0; e < 8; ++e) m_[e] = hc[e] + hs[e] * p.rw_mu[3 * D + c0 + e];
    *(uint4*)(p.BIG + 5 * RS_ + (size_t)row * D + c0) = pack8(m_);
  }
}

__device__ __forceinline__ void ph_rwprep(const Ctx cx, CParams& p) {
  const int lane = cx.tid & 63;
  const int gw = cx.bid * NWV + (cx.tid >> 6), nw = gridDim.x * NWV;
  const size_t RS = (size_t)R * D;
  float* CS = (float*)p.LR;
  for (int row = gw; row < R; row += nw) {
    const int c0 = lane * 16;
    const size_t o = (size_t)row * D + c0;
    float rr[16], kk[16], aa[16], km[16], ka[16];
    unpack8(*(const uint4*)(p.BIG + o), rr); unpack8(*(const uint4*)(p.BIG + o + 8), rr + 8);
    unpack8(*(const uint4*)(p.BIG + RS + o), kk); unpack8(*(const uint4*)(p.BIG + RS + o + 8), kk + 8);
    unpack8(*(const uint4*)(p.BIG + 3 * RS + o), aa); unpack8(*(const uint4*)(p.BIG + 3 * RS + o + 8), aa + 8);
    float ss = 0.f;
#pragma unroll
    for (int e = 0; e < 16; ++e) {
      km[e] = bf2f(f2bf(kk[e] * (1.f + (aa[e] - 1.f) * p.rw_kvec[D + c0 + e])));
      kk[e] *= p.rw_kvec[c0 + e]; ss += kk[e] * kk[e];
    }
    ss += __shfl_xor(ss, 1); ss += __shfl_xor(ss, 2);
    const float inv = 1.f / fmaxf(sqrtf(ss), 1e-12f);
    float c1 = 0.f, c2 = 0.f;
#pragma unroll
    for (int e = 0; e < 16; ++e) {
      kk[e] *= inv; ka[e] = bf2f(f2bf(kk[e] * aa[e]));
      c1 += ka[e] * rr[e]; c2 += km[e] * rr[e];
    }
    c1 += __shfl_xor(c1, 1); c1 += __shfl_xor(c1, 2);
    c2 += __shfl_xor(c2, 1); c2 += __shfl_xor(c2, 2);
    *(uint4*)(p.BIG + RS + o) = pack8(kk); *(uint4*)(p.BIG + RS + o + 8) = pack8(kk + 8);
    *(uint4*)(p.BIG + 3 * RS + o) = pack8(ka); *(uint4*)(p.BIG + 3 * RS + o + 8) = pack8(ka + 8);
    *(uint4*)(p.H + o) = pack8(km); *(uint4*)(p.H + o + 8) = pack8(km + 8);
    if ((lane & 3) == 0) { float2 c; c.x = c1; c.y = c2; *(float2*)(CS + (size_t)row * 32 + (lane >> 2) * 2) = c; }
  }
}

__device__ __forceinline__ void ph_rwscan(const Ctx cx, CParams& p) {
  const int lane = cx.tid & 63, w = cx.tid >> 6;
  if (w >= 4) return;
  const int vq = lane >> 3, kq = lane & 7, hf = w & 1;
  const size_t RS = (size_t)R * D;
  const u16* Rb = p.BIG; const u16* KKb = p.BIG + RS; const u16* Vb = p.BIG + 2 * RS; const u16* KAb = p.BIG + 3 * RS; const u16* KMb = p.H;
  const float* CS = (const float*)p.LR;
  const int nblk = (SPG * 16 * 2) / 2;
  for (int bi = cx.bid; bi < nblk; bi += gridDim.x) {
    const int item = bi * 2 + (w >> 1);
    const int bl = item >> 5, head = (item >> 1) & 15, dir = item & 1;
    const u16* Wb = p.BIG + (size_t)(4 + dir) * RS;
    u16* Yb = (u16*)p.YO + (size_t)dir * RS;
    const int base = bl * TPS;
    const int colk = head * 64 + kq * 8, colv = head * 64 + hf * 32 + vq * 4;
    float S[4][8];
#pragma unroll
    for (int i = 0; i < 4; ++i)
#pragma unroll
      for (int e = 0; e < 8; ++e) S[i][e] = 0.f;
    char* dummy = (char*)p.LR + (size_t)R * 128 + (cx.tid & 511) * 8;
    constexpr int PF = 3;
    uint4 qr[PF], qkk[PF], qka[PF], qkm[PF], qw[PF]; uint2 qv[PF]; float2 qcs[PF]; int qrow[PF];
#define RW_LOAD(j, ps_) do { const int row_ = scan_row(base, dir, (ps_)); qrow[j] = row_; \
      const unsigned ok_ = (unsigned)(row_ * D + colk) * 2u, ov_ = (unsigned)(row_ * D + colv) * 2u, oc_ = (unsigned)(row_ * 32 + head * 2) * 4u; \
      qr[j] = *(const uint4*)((const char*)Rb + ok_); qkk[j] = *(const uint4*)((const char*)KKb + ok_); \
      qka[j] = *(const uint4*)((const char*)KAb + ok_); qkm[j] = *(const uint4*)((const char*)KMb + ok_); \
      qw[j] = *(const uint4*)((const char*)Wb + ok_); qv[j] = *(const uint2*)((const char*)Vb + ov_); \
      qcs[j] = *(const float2*)((const char*)CS + oc_); } while (0)
#pragma unroll
    for (int j = 0; j < PF; ++j) RW_LOAD(j, j);
    for (int ps0 = 0; ps0 < TPS; ps0 += PF) {
#pragma unroll
    for (int j = 0; j < PF; ++j) {
      const uint4 cr_ = qr[j], ckk = qkk[j], cka = qka[j], ckm = qkm[j], cw = qw[j]; const uint2 cv = qv[j]; const float2 cs = qcs[j];
      const int crow_ = qrow[j];
      { const int pn_ = ps0 + PF + j; RW_LOAD(j, pn_ < TPS ? pn_ : TPS - 1); }
      float wr[8], kk[8], wm1[8], vv[4], kka[8], km[8];
      unpack8(cr_, wr); unpack8(ckk, kk); unpack8(cka, kka); unpack8(ckm, km); unpack8(cw, wm1);
      vv[0] = lo16(cv.x); vv[1] = hi16(cv.x); vv[2] = lo16(cv.y); vv[3] = hi16(cv.y);
#pragma unroll
      for (int e = 0; e < 8; ++e) wr[e] += wr[e] * wm1[e];
      float sa[4], yo[4];
#pragma unroll
      for (int i = 0; i < 4; ++i) {
        float s = 0.f, t = 0.f;
#pragma unroll
        for (int e = 0; e < 8; ++e) { s += S[i][e] * kk[e]; t += S[i][e] * wr[e]; }
        sa[i] = s; yo[i] = t;
      }
#pragma unroll
      for (int i = 0; i < 4; ++i) { sa[i] = -red8(sa[i]); yo[i] = red8(yo[i]); }
#pragma unroll
      for (int i = 0; i < 4; ++i) {
#pragma unroll
        for (int e = 0; e < 8; ++e) {
          float t = S[i][e] + S[i][e] * wm1[e];
          t += sa[i] * kka[e];
          t += vv[i] * km[e];
          S[i][e] = t;
        }
        yo[i] += sa[i] * cs.x + vv[i] * cs.y;
      }
      { uint2 o; o.x = pack2(yo[0], yo[1]); o.y = pack2(yo[2], yo[3]);
        char* dst_ = (kq == 0) ? (char*)Yb + (unsigned)(crow_ * D + colv) * 2u : dummy;
        *(uint2*)dst_ = o; }
    }
    }
#undef RW_LOAD
  }
}

__device__ __forceinline__ void ph_rwout(const Ctx cx, CParams& p, int g) {
  const int lane = cx.tid & 63;
  const int gw = cx.bid * NWV + (cx.tid >> 6), nw = gridDim.x * NWV;
  const size_t RS = (size_t)R * D;
  for (int row = gw; row < R; row += nw) {
    int b, pos; rowinfo(g, row, b, pos);
    if (pos < CTX) continue;
    const int c0 = lane * 16;
    const size_t o = (size_t)row * D + c0;
    float yf[16], yb[16], rr[16], kk[16], vv[16], gg[16];
    const u16* Yy = (const u16*)p.YO;
    unpack8(*(const uint4*)(Yy + o), yf); unpack8(*(const uint4*)(Yy + o + 8), yf + 8);
    unpack8(*(const uint4*)(Yy + RS + o), yb); unpack8(*(const uint4*)(Yy + RS + o + 8), yb + 8);
    unpack8(*(const uint4*)(p.BIG + o), rr); unpack8(*(const uint4*)(p.BIG + o + 8), rr + 8);
    unpack8(*(const uint4*)(p.H + o), kk); unpack8(*(const uint4*)(p.H + o + 8), kk + 8);
    unpack8(*(const uint4*)(p.BIG + 2 * RS + o), vv); unpack8(*(const uint4*)(p.BIG + 2 * RS + o + 8), vv + 8);
    unpack8(*(const uint4*)(p.QK + o), gg); unpack8(*(const uint4*)(p.QK + o + 8), gg + 8);
    float s1 = 0.f, bon = 0.f;
#pragma unroll
    for (int e = 0; e < 16; ++e) {
      yf[e] += yb[e]; s1 += yf[e];
      bon += rr[e] * kk[e] * p.rw_kvec[2 * D + c0 + e];
    }
    s1 += __shfl_xor(s1, 1); s1 += __shfl_xor(s1, 2);
    bon += __shfl_xor(bon, 1); bon += __shfl_xor(bon, 2);
    const float mu = s1 * (1.f / 64.f);
    float s2 = 0.f;
#pragma unroll
    for (int e = 0; e < 16; ++e) { const float d = yf[e] - mu; s2 += d * d; }
    s2 += __shfl_xor(s2, 1); s2 += __shfl_xor(s2, 2);
    const float rstd = rsqrtf(s2 * (1.f / 64.f) + 64e-5f);
#pragma unroll
    for (int e = 0; e < 16; ++e) {
      const float yn = (yf[e] - mu) * rstd * p.rw_lnx[c0 + e] + p.rw_lnx[D + c0 + e];
      yf[e] = (yn + bon * vv[e]) * gg[e];
    }
    *(uint4*)(p.H + o) = pack8(yf);
    *(uint4*)(p.H + o + 8) = pack8(yf + 8);
  }
}

__global__ void __launch_bounds__(NTHR) fwd_megakernel(Params p_arg) {
  cg::grid_group grid = cg::this_grid();
  __shared__ __attribute__((aligned(1024))) char smem[2 * STAGE_B];
  const size_t RS = (size_t)R * D;
  (void)RS;
  {
    Ctx cx; cx.tid = threadIdx.x; cx.bid = blockIdx.x;
    CParams* pp = (CParams*)__builtin_amdgcn_kernarg_segment_ptr();
    ph_prologue(cx, *pp, (float*)smem);
  }
  const int wave_s = __builtin_amdgcn_readfirstlane((int)threadIdx.x >> 6);
  grid.sync();
#pragma nounroll
  for (int it2 = 0; it2 < NG * NPH * 2; ++it2) {
    const int it = it2 >> 1;
    const int g = it / NPH, ph = it - g * NPH;
    if (it2 & 1) continue;
    const unsigned long long tp0 = PROBE_MASK ? wall_clock64() : 0ull;
    Ctx cx;
    {
      int t_ = (wave_s << 6) | (int)__builtin_amdgcn_mbcnt_hi(~0u, __builtin_amdgcn_mbcnt_lo(~0u, 0u));
      int b_ = blockIdx.x; asm volatile("" : "+v"(t_), "+s"(b_)); cx.tid = t_; cx.bid = b_; }
    CParams* pp = (CParams*)__builtin_amdgcn_kernarg_segment_ptr();
    asm volatile("" : "+s"(pp));
    CParams& p = *pp;
    switch (ph) {
      case 0: ph_norm0(cx, p, g); break;
      case 1: gemm256(cx, p.H, p.H, 1 << 30, D, p.wt_in, D, ZW / 256, false, EpBf16{p.BIG, ZW}, smem); break;
      case 2: ph_qkconv(cx, p, g); break;
      case 3: ph_scan0(cx, p, smem); break;
      case 4: ph_evout(cx, p, g); break;
      case 5: gemm256(cx, p.H, p.H, 1 << 30, D, p.wt_out, D, 4, false, EpBf16{(u16*)p.YO, D}, smem); break;
      case 6: ph_resid(cx, p, g, 0, 0, false); break;
      case 7: gemm256(cx, p.H, p.H, 1 << 30, D, p.wt_up, D, GUW / 256, false, EpBf16{p.BIG, GUW}, smem); break;
      case 8: ph_ffnact(cx, p, g, 0, false); break;
      case 9: gemm256(cx, p.BIG + DFF, p.BIG + DFF, 1 << 30, GUW, p.wt_down, DFF, 4, false, EpBf16{(u16*)p.YO, D}, smem); break;
      case 10: ph_resid(cx, p, g, 0, 1, false); break;
      case 11: ph_xx(cx, p, g); break;
      case 12: gemm256<true>(cx, p.H, p.QK, D, D, p.wt_1, K1, N1 / 256, false, EpRw1{p.BIG, p.LR}, smem, p.BIG + 3 * RS); break;
      case 13: gemm256(cx, p.LR, p.LR, 1 << 30, K2, p.wt_2, K2, N2 / 256, false, EpRw2{p.BIG, p.QK, p.rw_w0, p.rw_a0}, smem); break;
      case 14: ph_rwprep(cx, p); break;
      case 15: ph_rwscan(cx, p); break;
      case 16: ph_rwout(cx, p, g); break;
      case 17: gemm256(cx, p.H, p.H, 1 << 30, D, p.wt_o, D, 4, true, EpBf16{(u16*)p.YO, D}, smem); break;
      case 18: ph_resid(cx, p, g, 1, 0, true); break;
      case 19: gemm256(cx, p.H, p.H, 1 << 30, D, p.wt_up + (size_t)GUW * D, D, GUW / 256, true, EpBf16{p.BIG, GUW}, smem); break;
      case 20: ph_ffnact(cx, p, g, 1, true); break;
      case 21: gemm256(cx, p.BIG + DFF, p.BIG + DFF, 1 << 30, GUW, p.wt_down + (size_t)D * DFF, DFF, 4, true, EpBf16{(u16*)p.YO, D}, smem); break;
      default: ph_resid(cx, p, g, 1, 1, true); break;
    }
    grid.sync();
    if (PROBE_MASK && ((PROBE_MASK >> ph) & 1u)) {
      const unsigned long long tp1 = wall_clock64();
      while (wall_clock64() - tp1 < tp1 - tp0) __builtin_amdgcn_s_sleep(8);
    }
  }
}

extern "C" void kernel_launch(void* const* d_in, const int* in_sizes, int n_in, void* d_out, int out_size, void* d_ws,
                              size_t ws_size, hipStream_t stream) {
  static int grid_blocks = 0;
  if (!grid_blocks) {
    int dev = 0, cus = 0, per_cu = 0;
    hipGetDevice(&dev);
    hipDeviceGetAttribute(&cus, hipDeviceAttributeMultiprocessorCount, dev);
    hipOccupancyMaxActiveBlocksPerMultiprocessor(&per_cu, fwd_megakernel, NTHR, 0);
    if (per_cu > 1) per_cu = 1;
    if (per_cu < 1) per_cu = 1;
    grid_blocks = cus * per_cu;
  }
  Params p{};
  const float** f = (const float**)&p;
  for (int i = 0; i < 32; ++i) f[i] = (const float*)d_in[i];
  p.out = (float*)d_out;
  char* ws = (char*)d_ws;
  size_t off = 0;
  auto take = [&](size_t bytes) { char* q = ws + off; off += (bytes + 255) & ~(size_t)255; return q; };
  p.wt_in = (u16*)take((size_t)ZW * D * 2);
  p.wt_out = (u16*)take((size_t)D * D * 2);
  p.wt_up = (u16*)take((size_t)2 * GUW * D * 2);
  p.wt_down = (u16*)take((size_t)2 * D * DFF * 2);
  p.wt_o = (u16*)take((size_t)D * D * 2);
  p.wt_1 = (u16*)take((size_t)N1 * K1 * 2);
  p.wt_2 = (u16*)take((size_t)N2 * K2 * 2);
  p.mod = (float*)take((size_t)2 * 33 * 6144 * 4);
  p.xc = (float*)take((size_t)NB * CTX * D * 4);
  p.H = (u16*)take((size_t)R * D * 2);
  p.BIG = (u16*)take((size_t)6 * R * D * 2);
  p.QK = (u16*)take((size_t)R * D * 2);
  p.YO = (float*)take((size_t)R * D * 4);
  p.LR = (u16*)take((size_t)R * K2 * 2);
  if (off > ws_size) { fprintf(stderr, "workspace too small: need %zu have %zu\n", off, ws_size); return; }
  void* args[] = {&p};
  hipError_t e = hipLaunchCooperativeKernel((void*)fwd_megakernel, dim3(grid_blocks), dim3(NTHR), args, 0, stream);
  if (e != hipSuccess) fprintf(stderr, "cooperative launch failed: %s (grid %d)\n", hipGetErrorString(e), grid_blocks);
}
```

```cpp
#include <hip/hip_runtime.h>
#include <hip/hip_cooperative_groups.h>
#include <cstdio>
namespace cg = cooperative_groups;

typedef unsigned short u16;
using bf16x8 = __attribute__((ext_vector_type(8))) short;
using s16x4  = __attribute__((ext_vector_type(4))) short;
using f32x16 = __attribute__((ext_vector_type(16))) float;
#define DI __device__ __forceinline__
#define MFMA(a, b, c) __builtin_amdgcn_mfma_f32_32x32x16_bf16((a), (b), (c), 0, 0, 0)

constexpr int D = 1024, NB = 32, SEQ = 2048, CTX = 256, TPS = 2304;
constexpr int NG = 2, SPG = 16, R = SPG * TPS;
constexpr int ZW = 3840;
constexpr int DFF = 2816, GUW = 5632;
constexpr int NTHR = 512, NWV = NTHR / 64, NPH = 23;
constexpr int N1 = 3584, K1 = 2048, N2 = 4096, K2 = 320;
#ifndef PROBE_MASK_V
#define PROBE_MASK_V 0u
#endif
constexpr unsigned PROBE_MASK = PROBE_MASK_V;

struct Ctx { int tid, bid; };
struct Params {
  const float *x, *c, *ctx, *c_ctx, *w_mod, *b_mod, *norm_g, *ffn_w_up, *ffn_conv_w, *ffn_conv_b, *ffn_w_down,
      *ev_w_in, *ev_b_gates, *ev_conv_w, *ev_conv_b, *ev_gla_w2, *ev_gla_b, *ev_head_g, *ev_w_out,
      *rw_mu, *rw_w_rkv, *rw_w_o, *rw_w0, *rw_w1, *rw_w2, *rw_a0, *rw_a1, *rw_a2, *rw_g1, *rw_g2, *rw_kvec, *rw_lnx;
  float* out;
  u16 *wt_in, *wt_out, *wt_up, *wt_down, *wt_o, *wt_1, *wt_2;
  float* mod; float* xc;
  u16* H; u16* BIG; u16* QK; float* YO; u16* LR;
};

typedef const __attribute__((address_space(4))) Params CParams;

DI float bf2f(u16 v) { return __uint_as_float(((unsigned)v) << 16); }
typedef __bf16 bf16x2_t __attribute__((ext_vector_type(2)));
typedef float f32x2_t __attribute__((ext_vector_type(2)));
DI unsigned pack2(float a, float b) { f32x2_t v; v.x = a; v.y = b; return __builtin_bit_cast(unsigned, __builtin_convertvector(v, bf16x2_t)); }
DI u16 f2bf(float f) { return (u16)(pack2(f, 0.f) & 0xffffu); }
DI float lo16(unsigned u) { return __uint_as_float(u << 16); }
DI float hi16(unsigned u) { return __uint_as_float(u & 0xffff0000u); }
DI void unpack8(const uint4& v, float* o) {
  o[0] = lo16(v.x); o[1] = hi16(v.x); o[2] = lo16(v.y); o[3] = hi16(v.y);
  o[4] = lo16(v.z); o[5] = hi16(v.z); o[6] = lo16(v.w); o[7] = hi16(v.w);
}
DI uint4 pack8(const float* o) { uint4 v; v.x = pack2(o[0], o[1]); v.y = pack2(o[2], o[3]); v.z = pack2(o[4], o[5]); v.w = pack2(o[6], o[7]); return v; }
DI int crow(int reg, int h) { return (reg & 3) + 8 * (reg >> 2) + 4 * h; }
DI float wsum(float v) { for (int o = 32; o; o >>= 1) v += __shfl_xor(v, o); return v; }
DI float sigmoidf_(float x) { return 1.f / (1.f + __expf(-x)); }
DI float logsigf_(float x) { return fminf(x, 0.f) - log1pf(__expf(-fabsf(x))); }
DI float siluf_(float x) { return x / (1.f + __expf(-x)); }
DI bf16x8 cat4(s16x4 lo, s16x4 hi) { return __builtin_shufflevector(lo, hi, 0, 1, 2, 3, 4, 5, 6, 7); }
DI bf16x8 pack_step(const f32x16& x, int s) {
  uint4 v;
  v.x = pack2(x[8 * s + 0], x[8 * s + 1]); v.y = pack2(x[8 * s + 2], x[8 * s + 3]);
  v.z = pack2(x[8 * s + 4], x[8 * s + 5]); v.w = pack2(x[8 * s + 6], x[8 * s + 7]);
  return __builtin_bit_cast(bf16x8, v);
}
DI float dppf(float x, int) { return x; }
#define DPP_F(x, ctrl) __int_as_float(__builtin_amdgcn_update_dpp(0, __float_as_int(x), (ctrl), 0xF, 0xF, true))
DI float red8(float x) {
  x += DPP_F(x, 0x141);
  x += DPP_F(x, 0xB1);
  x += DPP_F(x, 0x4E);
  return x;
}

DI int scan_row(int base, int dir, int p) {
  if (dir == 0) return base + p;
  return (p < CTX) ? base + (CTX - 1 - p) : base + (TPS + CTX - 1 - p);
}

__device__ __forceinline__ void convert_job(const Ctx cx, const float* __restrict__ src, int K, int N, int Npad, u16* __restrict__ dst, int ldd, const float* __restrict__ mu, float* tile) {
  const int tx = cx.tid & 31, ty = cx.tid >> 5;
  const int tk = K >> 5, tn = Npad >> 5;
  for (int t = cx.bid; t < tk * tn; t += gridDim.x) {
    const int k0 = (t / tn) * 32, n0 = (t % tn) * 32;
#pragma unroll
    for (int i = 0; i < 2; ++i) {
      const int kk = k0 + ty + 16 * i, nn = n0 + tx;
      float v = (nn < N) ? src[(size_t)kk * N + nn] : 0.f;
      if (mu) v *= mu[kk];
      tile[(ty + 16 * i) * 33 + tx] = v;
    }
    __syncthreads();
#pragma unroll
    for (int i = 0; i < 2; ++i) {
      const int nn = n0 + ty + 16 * i, kk = k0 + tx;
      dst[(size_t)nn * ldd + kk] = f2bf(tile[tx * 33 + ty + 16 * i]);
    }
    __syncthreads();
  }
}

__device__ __forceinline__ void ph_mod(const Ctx cx, CParams& p, float* smem) {
  const int tid = cx.tid, lane = tid & 63, w = tid >> 6;
  float* sc = smem + w * (33 * 64);
  for (int u = cx.bid; u < 2 * 96; u += gridDim.x) {
    const int layer = u / 96, n = (u % 96) * 64 + lane;
    const float* W = p.w_mod + (size_t)layer * D * 6144;
    float acc[33];
#pragma unroll
    for (int i = 0; i < 33; ++i) acc[i] = 0.f;
    for (int kc = 0; kc < 2; ++kc) {
      const int k0 = w * 128 + kc * 64;
#pragma nounroll
      for (int cr = 0; cr < 33; ++cr) {
        const float v = (cr < 32) ? p.c[cr * D + k0 + lane] : p.c_ctx[k0 + lane];
        sc[cr * 64 + lane] = siluf_(v);
      }
      __syncthreads();
#pragma unroll 2
      for (int j = 0; j < 64; ++j) {
        const float wv = W[(size_t)(k0 + j) * 6144 + n];
#pragma unroll
        for (int cr = 0; cr < 33; ++cr) acc[cr] += sc[cr * 64 + j] * wv;
      }
      __syncthreads();
    }
#pragma unroll
    for (int cr = 0; cr < 33; ++cr) sc[cr * 64 + lane] = acc[cr];
    __syncthreads();
    if (w == 0) {
      const float bm = p.b_mod[layer * 6144 + n];
      for (int cr = 0; cr < 33; ++cr) {
        float s = 0.f;
#pragma unroll
        for (int q = 0; q < NWV; ++q) s += smem[q * 33 * 64 + cr * 64 + lane];
        p.mod[((size_t)layer * 33 + cr) * 6144 + n] = s + bm;
      }
    }
    __syncthreads();
  }
}

__device__ __forceinline__ void ph_prologue(const Ctx cx, CParams& p, float* smem) {
  ph_mod(cx, p, smem);
  convert_job(cx, p.ev_w_in, D, 3632, ZW, p.wt_in, D, nullptr, smem);
  convert_job(cx, p.ev_w_out, D, D, D, p.wt_out, D, nullptr, smem);
  for (int l = 0; l < 2; ++l) {
    convert_job(cx, p.ffn_w_up + (size_t)l * D * GUW, D, GUW, GUW, p.wt_up + (size_t)l * GUW * D, D, nullptr, smem);
    convert_job(cx, p.ffn_w_down + (size_t)l * DFF * D, DFF, D, D, p.wt_down + (size_t)l * D * DFF, DFF, nullptr, smem);
  }
  convert_job(cx, p.rw_w_o, D, D, D, p.wt_o, D, nullptr, smem);
  for (int half = 0; half < 2; ++half) {
    u16* dcol = p.wt_1 + half * D;
    const float* m0 = half ? p.rw_mu : nullptr;
    convert_job(cx, p.rw_w_rkv, D, D, D, dcol, K1, half ? m0 + 0 * D : nullptr, smem);
    convert_job(cx, p.rw_w_rkv + (size_t)D * D, D, D, D, dcol + (size_t)1024 * K1, K1, half ? m0 + 2 * D : nullptr, smem);
    convert_job(cx, p.rw_w_rkv + (size_t)2 * D * D, D, D, D, dcol + (size_t)2048 * K1, K1, half ? m0 + 3 * D : nullptr, smem);
    convert_job(cx, p.rw_w1, D, 64, 64, dcol + (size_t)3072 * K1, K1, half ? m0 + 1 * D : nullptr, smem);
    convert_job(cx, p.rw_w1 + D * 64, D, 64, 64, dcol + (size_t)3136 * K1, K1, half ? m0 + 1 * D : nullptr, smem);
    convert_job(cx, p.rw_a1, D, 64, 64, dcol + (size_t)3200 * K1, K1, half ? m0 + 4 * D : nullptr, smem);
    convert_job(cx, p.rw_g1, D, 128, 320, dcol + (size_t)3264 * K1, K1, half ? m0 + 5 * D : nullptr, smem);
  }
  for (size_t i = (size_t)cx.bid * NTHR + cx.tid; i < (size_t)N2 * K2; i += (size_t)gridDim.x * NTHR) {
    const int n = (int)(i / K2), c = (int)(i % K2), blk = n >> 10, nn = n & 1023;
    float v = 0.f;
    if (blk == 0) { if (c < 64) v = p.rw_w2[(size_t)c * D + nn]; }
    else if (blk == 1) { if (c >= 64 && c < 128) v = p.rw_w2[(size_t)(64 + c - 64) * D + nn]; }
    else if (blk == 2) { if (c >= 128 && c < 192) v = p.rw_a2[(size_t)(c - 128) * D + nn]; }
    else { if (c >= 192) v = p.rw_g2[(size_t)(c - 192) * D + nn]; }
    p.wt_2[i] = f2bf(v);
  }
}

DI void rowinfo(int g, int row, int& b, int& pos) { const int bl = row / TPS; pos = row - bl * TPS; b = g * SPG + bl; }

__device__ __forceinline__ void ph_norm0(const Ctx cx, CParams& p, int g) {
  const int lane = cx.tid & 63;
  const int gw = cx.bid * NWV + (cx.tid >> 6), nw = gridDim.x * NWV;
  for (int row = gw; row < R; row += nw) {
    int b, pos; rowinfo(g, row, b, pos);
    const float* src = (pos < CTX) ? p.ctx + ((size_t)(b * CTX + pos)) * D : p.x + ((size_t)(b * SEQ + pos - CTX)) * D;
    const float* md = p.mod + ((size_t)(pos < CTX ? 32 : b)) * 6144;
    float4 v[4]; float ss = 0.f;
#pragma unroll
    for (int j = 0; j < 4; ++j) { v[j] = ((const float4*)src)[j * 64 + lane]; ss += v[j].x * v[j].x + v[j].y * v[j].y + v[j].z * v[j].z + v[j].w * v[j].w; }
    ss = wsum(ss);
    const float rstd = rsqrtf(ss * (1.f / D) + 1e-6f);
#pragma unroll
    for (int j = 0; j < 4; ++j) {
      const int col = j * 256 + lane * 4;
      const float4 gg = *(const float4*)(p.norm_g + col);
      const float4 sh = *(const float4*)(md + col), sc = *(const float4*)(md + D + col);
      uint2 o;
      o.x = pack2(v[j].x * rstd * gg.x * (1.f + sc.x) + sh.x, v[j].y * rstd * gg.y * (1.f + sc.y) + sh.y);
      o.y = pack2(v[j].z * rstd * gg.z * (1.f + sc.z) + sh.z, v[j].w * rstd * gg.w * (1.f + sc.w) + sh.w);
      *(uint2*)(p.H + (size_t)row * D + col) = o;
    }
  }
}

__device__ __forceinline__ void ph_resid(const Ctx cx, CParams& p, int g, int layer, int which, bool lat_only) {
  const int lane = cx.tid & 63;
  const int gw = cx.bid * NWV + (cx.tid >> 6), nw = gridDim.x * NWV;
  const bool from_inputs = (layer == 0 && which == 0);
  const bool has_next = (which == 0) || (layer + 1 < 2);
  const float* ga = p.norm_g + (layer * 4 + (which ? 3 : 1)) * D;
  const float* gb = (which == 0) ? p.norm_g + (layer * 4 + 2) * D : p.norm_g + ((layer + 1) * 4 + 0) * D;
  for (int row = gw; row < R; row += nw) {
    int b, pos; rowinfo(g, row, b, pos);
    if (lat_only && pos < CTX) continue;
    const size_t ridx = (pos < CTX) ? ((size_t)(b * CTX + pos)) * D : ((size_t)(b * SEQ + pos - CTX)) * D;
    const float* src = from_inputs ? ((pos < CTX) ? p.ctx + ridx : p.x + ridx) : ((pos < CTX) ? p.xc + ridx : p.out + ridx);
    float* dst = (pos < CTX) ? p.xc + ridx : p.out + ridx;
    const int cr = (pos < CTX) ? 32 : b;
    const float* md = p.mod + ((size_t)layer * 33 + cr) * 6144;
    const float* mdn = (which == 0) ? md + 3 * D : p.mod + ((size_t)(layer + 1) * 33 + cr) * 6144;
    const float* gate = md + (which ? 5 : 2) * D;
    const u16* yo = (const u16*)p.YO + (size_t)row * D;
    float4 y[4], xv[4]; float ss = 0.f;
#pragma unroll
    for (int j = 0; j < 4; ++j) {
      const uint2 yb = ((const uint2*)yo)[j * 64 + lane];
      y[j].x = lo16(yb.x); y[j].y = hi16(yb.x); y[j].z = lo16(yb.y); y[j].w = hi16(yb.y);
      xv[j] = ((const float4*)src)[j * 64 + lane]; ss += y[j].x * y[j].x + y[j].y * y[j].y + y[j].z * y[j].z + y[j].w * y[j].w; }
    ss = wsum(ss);
    const float rstd = rsqrtf(ss * (1.f / D) + 1e-6f);
    float s2 = 0.f;
#pragma unroll
    for (int j = 0; j < 4; ++j) {
      const int col = j * 256 + lane * 4;
      const float4 g4 = *(const float4*)(ga + col), gt = *(const float4*)(gate + col);
      xv[j].x += gt.x * (y[j].x * rstd * g4.x); xv[j].y += gt.y * (y[j].y * rstd * g4.y);
      xv[j].z += gt.z * (y[j].z * rstd * g4.z); xv[j].w += gt.w * (y[j].w * rstd * g4.w);
      ((float4*)dst)[j * 64 + lane] = xv[j];
      s2 += xv[j].x * xv[j].x + xv[j].y * xv[j].y + xv[j].z * xv[j].z + xv[j].w * xv[j].w;
    }
    if (has_next) {
      s2 = wsum(s2);
      const float r2 = rsqrtf(s2 * (1.f / D) + 1e-6f);
#pragma unroll
      for (int j = 0; j < 4; ++j) {
        const int col = j * 256 + lane * 4;
        const float4 gg = *(const float4*)(gb + col);
        const float4 sh = *(const float4*)(mdn + col), sc = *(const float4*)(mdn + D + col);
        uint2 o;
        o.x = pack2(xv[j].x * r2 * gg.x * (1.f + sc.x) + sh.x, xv[j].y * r2 * gg.y * (1.f + sc.y) + sh.y);
        o.y = pack2(xv[j].z * r2 * gg.z * (1.f + sc.z) + sh.z, xv[j].w * r2 * gg.w * (1.f + sc.w) + sh.w);
        *(uint2*)(p.H + (size_t)row * D + col) = o;
      }
    }
  }
}

using f32x4 = __attribute__((ext_vector_type(4))) float;
using i32x4 = __attribute__((ext_vector_type(4))) int;
DI int lds_byte(int r, int c) {
  const int st = (r >> 4) * 2 + (c >> 5), ob = (r & 15) * 64 + (c & 31) * 2;
  return st * 1024 + (ob ^ (((ob >> 9) & 1) << 5));
}
DI void stage_rc(int b, int& Rr, int& Cc) {
  const int st = b >> 10, sb = b & 1023, swz = sb ^ (((sb >> 9) & 1) << 5);
  Rr = (st >> 1) * 16 + swz / 64;
  Cc = (st & 1) * 32 + (swz % 64) / 2;
}
constexpr int TILE_B = 256 * 64 * 2, STAGE_B = 2 * TILE_B;

DI const char* uni_ptr(const char* q) {
  const unsigned long long a = (unsigned long long)q;
  const unsigned lo = (unsigned)__builtin_amdgcn_readfirstlane((int)(unsigned)a), hi = (unsigned)__builtin_amdgcn_readfirstlane((int)(unsigned)(a >> 32));
  return (const char*)(((unsigned long long)hi << 32) | lo);
}
struct GUnit { const u16* A0; const u16* Bb; int ksplit, nt, brow, bcol; };
template <bool RW1>
DI GUnit gemm_unit(int u, int nN, int nMx, int xcd, bool lat_only, const u16* A0in, const u16* A2, int ksplit_in, int Kin, const u16* Bt, int ldb) {
  constexpr int GM = 4;
  const int grp = u / (GM * nN), fm = grp * GM, gsz = (nMx - fm) < GM ? (nMx - fm) : GM;
  const int rr_ = u - grp * (GM * nN);
  const int pn = rr_ / gsz, ml = fm + (rr_ - pn * gsz), pm = ml * 8 + xcd;
  GUnit g;
  g.brow = lat_only ? ((pm >> 3) * 9 + 1 + (pm & 7)) * 256 : pm * 256;
  g.bcol = pn * 256;
  g.A0 = A0in; g.ksplit = ksplit_in; int K = Kin;
  if constexpr (RW1) { if (pn < 12) { g.A0 = A2 + (size_t)(pn >> 2) * ((size_t)R * D); g.ksplit = 1 << 30; K = D; } }
  g.nt = K >> 6;
  g.Bb = Bt + (size_t)g.bcol * ldb;
  return g;
}
template <bool RW1 = false, class EP>
__device__ __forceinline__ void gemm256(const Ctx cx, const u16* __restrict__ A0in, const u16* __restrict__ A1, int ksplit_in, int lda,
                        const u16* __restrict__ Bt, int Kin, int nN, bool lat_only, const EP& ep, char* shm, const u16* __restrict__ A2 = nullptr) {
  const int wsg = __builtin_amdgcn_readfirstlane(cx.tid >> 6);
  const int wid = wsg, lane = cx.tid & 63;
  const int nM = lat_only ? SPG * 8 : R / 256;
  const int ldb = Kin;
  const int fragA = lds_byte((wsg >> 2) * 128 + (lane & 15), (lane >> 4) * 8), fragB = lds_byte((wsg & 3) * 64 + (lane & 15), (lane >> 4) * 8);
  const int xcd = cx.bid & 7, slot = cx.bid >> 3, nslot = gridDim.x >> 3, per_xcd = (nM >> 3) * nN;
  const int nMx = nM >> 3;
  if (slot < per_xcd) {
#define G_STAGE(buf, kt, UU, AO, BO) do { const int kb_ = (kt) * 64; const size_t ro_ = (size_t)(UU).brow * lda; \
    const char* Ab0_ = (const char*)((kb_ < (UU).ksplit) ? (UU).A0 + ro_ + kb_ : A1 + ro_ + (kb_ - (UU).ksplit)); \
    const char* Bb0_ = (const char*)((UU).Bb + kb_); \
    _Pragma("unroll") for (int i = 0; i < 4; ++i) { \
      const char* Ab_ = uni_ptr(Ab0_ + (size_t)i * 128 * lda); const char* Bb_ = uni_ptr(Bb0_ + (size_t)i * 128 * ldb);     \
      __builtin_amdgcn_global_load_lds((const unsigned*)(Ab_ + AO), (__attribute__((address_space(3))) unsigned*)(shm + (buf) * STAGE_B + wid * 1024 + i * 8192), 16, 0, 0); \
      __builtin_amdgcn_global_load_lds((const unsigned*)(Bb_ + BO), (__attribute__((address_space(3))) unsigned*)(shm + (buf) * STAGE_B + TILE_B + wid * 1024 + i * 8192), 16, 0, 0); } } while (0)
#define G_OFFS(UU, AO, BO) do { int sR, sC; stage_rc(wid * 1024 + lane * 16, sR, sC); \
      AO = (unsigned)((sR * lda + sC) * 2); BO = (unsigned)((sR * ldb + sC) * 2); } while (0)
  int u = slot;
  GUnit cu = gemm_unit<RW1>(u, nN, nMx, xcd, lat_only, A0in, A2, ksplit_in, Kin, Bt, ldb);
  unsigned aoff, boff;
  G_OFFS(cu, aoff, boff);
  G_STAGE(0, 0, cu, aoff, boff);
  asm volatile("s_waitcnt vmcnt(0)" ::: "memory");
  __syncthreads();
  int gt = 0;
  for (;;) {
    const int un = u + nslot;
    const bool has_next = un < per_xcd;
    f32x4 acc[8][4];
#pragma unroll
    for (int m = 0; m < 8; ++m)
#pragma unroll
      for (int n = 0; n < 4; ++n) acc[m][n] = (f32x4){0.f, 0.f, 0.f, 0.f};
    const int nt = cu.nt;
#pragma nounroll
    for (int t = 0; t < nt; ++t) {
      const int cur = gt & 1;
      if (t + 1 < nt) G_STAGE(cur ^ 1, t + 1, cu, aoff, boff);
      else if (has_next) {
        const GUnit nu = gemm_unit<RW1>(un, nN, nMx, xcd, lat_only, A0in, A2, ksplit_in, Kin, Bt, ldb);
        G_STAGE(cur ^ 1, 0, nu, aoff, boff);
      }
      const char* SAp = shm + cur * STAGE_B; const char* SBp = SAp + TILE_B;
      {
        bf16x8 At[8], Bf[4];
        const char* abase = SAp + fragA;
        const char* bbase = SBp + fragB;
#pragma unroll
        for (int n = 0; n < 4; ++n) Bf[n] = *(const bf16x8*)(bbase + n * 2048);
#pragma unroll
        for (int m = 0; m < 8; ++m) At[m] = *(const bf16x8*)(abase + m * 2048);
        __builtin_amdgcn_sched_barrier(0);
#pragma unroll
        for (int m = 0; m < 7; ++m) {
#pragma unroll
          for (int n = 0; n < 4; ++n) acc[m][n] = __builtin_amdgcn_mfma_f32_16x16x32_bf16(Bf[n], At[m], acc[m][n], 0, 0, 0);
          At[m] = *(const bf16x8*)(abase + m * 2048 + 1024);
          __builtin_amdgcn_sched_barrier(0);
        }
#pragma unroll
        for (int n = 0; n < 4; ++n) {
          acc[7][n] = __builtin_amdgcn_mfma_f32_16x16x32_bf16(Bf[n], At[7], acc[7][n], 0, 0, 0);
          Bf[n] = *(const bf16x8*)(bbase + n * 2048 + 1024);
          __builtin_amdgcn_sched_barrier(0);
        }
        At[7] = *(const bf16x8*)(abase + 7 * 2048 + 1024);
        __builtin_amdgcn_sched_barrier(0);
#pragma unroll
        for (int n = 0; n < 4; ++n) {
#pragma unroll
          for (int m = 0; m < 8; ++m) acc[m][n] = __builtin_amdgcn_mfma_f32_16x16x32_bf16(Bf[n], At[m], acc[m][n], 0, 0, 0);
          __builtin_amdgcn_sched_barrier(0);
        }
      }
      asm volatile("s_waitcnt vmcnt(0)" ::: "memory");
      __syncthreads();
      ++gt;
    }
    {
      char* ob = shm + ((gt - 1) & 1) * STAGE_B;
      int lane_ = (int)__builtin_amdgcn_mbcnt_hi(~0u, __builtin_amdgcn_mbcnt_lo(~0u, 0u));
      asm volatile("" : "+v"(lane_));
      const int tid = (wsg << 6) | lane_, wr = wsg >> 2, wc = wsg & 3, fr = lane_ & 15, fq = lane_ >> 4;
#pragma unroll
      for (int half = 0; half < 2; ++half) {
        if (wr == half) {
#pragma unroll
          for (int m = 0; m < 8; ++m) {
#pragma unroll
            for (int n = 0; n < 4; ++n) {
              const int rl = m * 16 + fr, cl = wc * 64 + n * 16 + fq * 4;
              const f32x4 v = ep.conv(cu.brow + half * 128 + rl, cu.bcol + cl, acc[m][n]);
              uint2 o; o.x = pack2(v[0], v[1]); o.y = pack2(v[2], v[3]);
              *(uint2*)(ob + rl * 512 + ((((cl >> 3) ^ rl) & 31) << 4) + (cl & 7) * 2) = o;
            }
            __builtin_amdgcn_sched_barrier(0);
          }
        }
        __syncthreads();
#pragma unroll
        for (int j = 0; j < 8; ++j) {
          const int id = j * 512 + tid, rl = id >> 5, c16 = id & 31;
          const uint4 val = *(const uint4*)(ob + rl * 512 + (((c16 ^ rl) & 31) << 4));
          u16* dp = ep.dst(cu.brow + half * 128 + rl, cu.bcol + c16 * 8);
          if (dp) *(uint4*)dp = val;
        }
        __syncthreads();
      }
    }
    if (!has_next) break;
    u = un;
    cu = gemm_unit<RW1>(u, nN, nMx, xcd, lat_only, A0in, A2, ksplit_in, Kin, Bt, ldb);
  }
  }
#undef G_STAGE
#undef G_OFFS
}

DI float tanh_fast(float x) { x = fminf(fmaxf(x, -15.f), 15.f); const float t = __expf(2.f * x); return (t - 1.f) / (t + 1.f); }
DI float decay_m1(float lw) {
  const float el = __expf(-fabsf(lw));
  const float ls = fminf(lw, 0.f) - __logf(1.f + el);
  const float e = __expf(ls - 0.5f);
  return __expf(-e) - 1.f;
}
struct EpBf16 {
  u16* base; int ld;
  DI f32x4 conv(int, int, f32x4 v) const { return v; }
  DI u16* dst(int row, int col) const { return base + (size_t)row * ld + col; }
};
struct EpRw1 {
  u16* big; u16* lr;
  DI f32x4 conv(int, int col, f32x4 v) const {
    const int cu = __builtin_amdgcn_readfirstlane(col >> 6);
    if (cu >= 48 && cu < 50) { v[0] = tanh_fast(v[0]); v[1] = tanh_fast(v[1]); v[2] = tanh_fast(v[2]); v[3] = tanh_fast(v[3]); }
    else if (cu >= 51 && cu < 53) { v[0] = sigmoidf_(v[0]); v[1] = sigmoidf_(v[1]); v[2] = sigmoidf_(v[2]); v[3] = sigmoidf_(v[3]); }
    return v;
  }
  DI u16* dst(int row, int col) const {
    if (col < 3072) return big + (size_t)(col >> 10) * ((size_t)R * D) + (size_t)row * D + (col & 1023);
    if (col < 3392) return lr + (size_t)row * K2 + (col - 3072);
    return nullptr;
  }
};
struct EpRw2 {
  u16* big; u16* gq; const float* w0; const float* a0;
  DI f32x4 conv(int, int col, f32x4 v) const {
    const int blk = __builtin_amdgcn_readfirstlane(col >> 10), cc = col & 1023;
    if (blk < 2) {
      const float4 ww = *(const float4*)(w0 + blk * D + cc);
      v[0] = decay_m1(v[0] + ww.x); v[1] = decay_m1(v[1] + ww.y); v[2] = decay_m1(v[2] + ww.z); v[3] = decay_m1(v[3] + ww.w);
    } else if (blk == 2) {
      const float4 ww = *(const float4*)(a0 + cc);
      v[0] = sigmoidf_(v[0] + ww.x); v[1] = sigmoidf_(v[1] + ww.y); v[2] = sigmoidf_(v[2] + ww.z); v[3] = sigmoidf_(v[3] + ww.w);
    }
    return v;
  }
  DI u16* dst(int row, int col) const {
    const int blk = col >> 10, cc = col & 1023;
    if (blk < 2) return big + (size_t)(4 + blk) * ((size_t)R * D) + (size_t)row * D + cc;
    if (blk == 2) return big + (size_t)3 * ((size_t)R * D) + (size_t)row * D + cc;
    return gq + (size_t)row * D + cc;
  }
};

__device__ __forceinline__ void ph_qkconv(const Ctx cx, CParams& p, int g) {
  const size_t total = (size_t)R * 128;
  for (size_t i = (size_t)cx.bid * NTHR + cx.tid; i < total; i += (size_t)gridDim.x * NTHR) {
    const int row = (int)(i >> 7), c0 = ((int)(i & 127)) * 8;
    int b, pos; rowinfo(g, row, b, pos);
    const bool hasp = (pos != 0 && pos != CTX), hasn = (pos != CTX - 1 && pos != TPS - 1);
    const u16* Z = p.BIG + (size_t)row * ZW + c0;
    float cur[8], pv[8], nx[8];
    unpack8(*(const uint4*)Z, cur);
    if (hasp) unpack8(*(const uint4*)(Z - ZW), pv); else { for (int e = 0; e < 8; ++e) pv[e] = 0.f; }
    if (hasn) unpack8(*(const uint4*)(Z + ZW), nx); else { for (int e = 0; e < 8; ++e) nx[e] = 0.f; }
    const float scale = (c0 < 512) ? 0.08838834764831845f : 1.f;
    float o[8];
#pragma unroll
    for (int e = 0; e < 8; ++e) {
      const int c = c0 + e;
      const float v = pv[e] * p.ev_conv_w[c] + cur[e] * p.ev_conv_w[D + c] + nx[e] * p.ev_conv_w[2 * D + c] + p.ev_conv_b[c];
      o[e] = siluf_(v) * scale;
    }
    *(uint4*)(p.QK + (size_t)row * D + c0) = pack8(o);
  }
}

__device__ __forceinline__ void mlstm_item(const Ctx cx, CParams& p, int item, char* smem) {
  const int tid = cx.tid, lane = tid & 63, w = tid >> 6, r = lane & 31, h = lane >> 5;
  const int bl = item >> 3, head = (item >> 1) & 3, dir = item & 1;
  const int base = bl * TPS;
  u16* sQ = (u16*)smem;
  u16* sK = sQ + 32 * 136;
  u16* sVT = sK + 32 * 136;
  u16* sKT = sVT + 128 * 40;
  float* sU = (float*)(sKT + 128 * 40);
  float* sM = sU + 32; float* sBc = sM + 32; float* sLast = sBc + 32;
  float* sN = sLast + 32;
  float* sRD = sN + 128;
  float* sWI = sRD + 128;
  const u16* Z = p.BIG;
  u16* Y = p.BIG + (size_t)R * ZW + (size_t)dir * R * 512;
  const float bgi = p.ev_b_gates[(2 * dir) * 4 + head], bgf = p.ev_b_gates[(2 * dir + 1) * 4 + head];
  f32x16 cacc[4];
#pragma unroll
  for (int a = 0; a < 4; ++a)
#pragma unroll
    for (int i = 0; i < 16; ++i) cacc[a][i] = 0.f;
  if (tid < 128) sN[tid] = 0.f;
  float m = 0.f;
  const bool act = tid < 256;
  const int lr = (tid >> 3) & 31, lc = tid & 7;
  uint4 q0, q1, k0, k1, v0, v1;
  u16 gzi = 0, gzf = 0;
#define ML_LOAD(p0_) do { if (act) { const int grow = scan_row(base, dir, (p0_) + lr); \
      q0 = *(const uint4*)(p.QK + (size_t)grow * D + head * 128 + lc * 8); \
      q1 = *(const uint4*)(p.QK + (size_t)grow * D + head * 128 + lc * 8 + 64); \
      k0 = *(const uint4*)(p.QK + (size_t)grow * D + 512 + head * 128 + lc * 8); \
      k1 = *(const uint4*)(p.QK + (size_t)grow * D + 512 + head * 128 + lc * 8 + 64); \
      v0 = *(const uint4*)(Z + (size_t)grow * ZW + 1024 + head * 128 + lc * 8); \
      v1 = *(const uint4*)(Z + (size_t)grow * ZW + 1024 + head * 128 + lc * 8 + 64); } \
    if (w == 0) { const int row_ = scan_row(base, dir, (p0_) + (lane & 31)); \
      gzi = Z[(size_t)row_ * ZW + 2048 + (2 * dir) * 4 + head]; gzf = Z[(size_t)row_ * ZW + 2048 + (2 * dir + 1) * 4 + head]; } } while (0)
  ML_LOAD(0);
  for (int ch = 0; ch < TPS / 32; ++ch) {
    const int p0 = ch * 32;
    __syncthreads();
    if (w == 0) {
      const int t = lane & 31;
      const float zi = bf2f(gzi) + bgi;
      const float zf = bf2f(gzf) + bgf;
      float bsum = logsigf_(zf);
      for (int o = 1; o < 32; o <<= 1) { const float v = __shfl_up(bsum, o); if (t >= o) bsum += v; }
      const float u = zi - bsum;
      float pm = u;
      for (int o = 1; o < 32; o <<= 1) { const float v = __shfl_up(pm, o); if (t >= o) pm = fmaxf(pm, v); }
      const float M = fmaxf(m, pm);
      if (lane < 32) { sU[t] = u; sM[t] = M; sBc[t] = bsum; if (t == 31) { sLast[0] = M; sLast[1] = bsum; } }
    }
    __syncthreads();
    const float Mlast = sLast[0], blast = sLast[1];
    if (act) {
      const float ws = __expf(sU[lr] - Mlast);
      *(uint4*)(sQ + lr * 136 + lc * 8) = q0; *(uint4*)(sQ + lr * 136 + lc * 8 + 64) = q1;
      *(uint4*)(sK + lr * 136 + lc * 8) = k0; *(uint4*)(sK + lr * 136 + lc * 8 + 64) = k1;
      float f[8];
      unpack8(k0, f);
#pragma unroll
      for (int e = 0; e < 8; ++e) sKT[(lc * 8 + e) * 40 + lr] = f2bf(f[e] * ws);
      unpack8(k1, f);
#pragma unroll
      for (int e = 0; e < 8; ++e) sKT[(lc * 8 + 64 + e) * 40 + lr] = f2bf(f[e] * ws);
      const u16* pv0 = (const u16*)&v0; const u16* pv1 = (const u16*)&v1;
#pragma unroll
      for (int e = 0; e < 8; ++e) { sVT[(lc * 8 + e) * 40 + lr] = pv0[e]; sVT[(lc * 8 + 64 + e) * 40 + lr] = pv1[e]; }
    }
    if (ch + 1 < TPS / 32) ML_LOAD(p0 + 32);
    __syncthreads();
    f32x16 st;
#pragma unroll
    for (int i = 0; i < 16; ++i) st[i] = 0.f;
    if (act) {
#pragma unroll
    for (int ks = 0; ks < 8; ++ks) {
      const bf16x8 a = *(const bf16x8*)(sK + r * 136 + 16 * ks + 8 * h);
      const bf16x8 b = *(const bf16x8*)(sQ + r * 136 + 16 * ks + 8 * h);
      st = MFMA(a, b, st);
    }
    const float Mt = sM[r];
    float dsum = 0.f;
#pragma unroll
    for (int i = 0; i < 16; ++i) {
      const int s = crow(i, h);
      const float pv = (s <= r) ? st[i] * __expf(sU[s] - Mt) : 0.f;
      st[i] = pv; dsum += pv;
    }
    dsum += __shfl_xor(dsum, 32);
    float qn = 0.f;
#pragma unroll
    for (int d8 = 0; d8 < 8; ++d8) {
      float qf[8]; unpack8(*(const uint4*)(sQ + r * 136 + 64 * h + 8 * d8), qf);
#pragma unroll
      for (int e = 0; e < 8; ++e) qn += qf[e] * sN[64 * h + 8 * d8 + e];
    }
    qn += __shfl_xor(qn, 32);
    const float wi = __expf(m - Mt);
    const float den = dsum + wi * qn;
    const float dn = fmaxf(fabsf(den), __expf(-(sBc[r] + Mt)));
    if (h == 0) { sRD[w * 32 + r] = 1.f / dn; sWI[w * 32 + r] = wi; }
    }
    __syncthreads();
    const float wp = __expf(m - Mlast);
    if (act) {
    f32x16 o;
#pragma unroll
    for (int i = 0; i < 16; ++i) o[i] = 0.f;
#pragma unroll
    for (int mb = 0; mb < 4; ++mb)
#pragma unroll
      for (int s2 = 0; s2 < 2; ++s2) {
        const bf16x8 cb = pack_step(cacc[mb], s2);
        const u16* qp = sQ + r * 136 + 32 * mb + 16 * s2 + 4 * h;
        const bf16x8 a = cat4(*(const s16x4*)qp, *(const s16x4*)(qp + 8));
        o = MFMA(a, cb, o);
      }
#pragma unroll
    for (int i = 0; i < 16; ++i) o[i] *= sWI[w * 32 + crow(i, h)];
#pragma unroll
    for (int s2 = 0; s2 < 2; ++s2) {
      const bf16x8 a = pack_step(st, s2);
      const u16* vp = sVT + (32 * w + r) * 40 + 16 * s2 + 4 * h;
      const bf16x8 b = cat4(*(const s16x4*)vp, *(const s16x4*)(vp + 8));
      o = MFMA(a, b, o);
    }
#pragma unroll
    for (int i = 0; i < 16; ++i) {
      const int t = crow(i, h);
      const int row = scan_row(base, dir, p0 + t);
      Y[(size_t)row * 512 + head * 128 + 32 * w + r] = f2bf(o[i] * sRD[w * 32 + t]);
    }
#pragma unroll
    for (int mb = 0; mb < 4; ++mb) {
#pragma unroll
      for (int i = 0; i < 16; ++i) cacc[mb][i] *= wp;
#pragma unroll
      for (int s2 = 0; s2 < 2; ++s2) {
        const bf16x8 a = *(const bf16x8*)(sKT + (32 * mb + r) * 40 + 16 * s2 + 8 * h);
        const bf16x8 b = *(const bf16x8*)(sVT + (32 * w + r) * 40 + 16 * s2 + 8 * h);
        cacc[mb] = MFMA(a, b, cacc[mb]);
      }
    }
    }
    __syncthreads();
    if (tid < 128) {
      float s = 0.f;
#pragma unroll
      for (int e = 0; e < 32; ++e) s += bf2f(sKT[tid * 40 + e]);
      sN[tid] = wp * sN[tid] + s;
    }
    m = blast + Mlast;
  }
#undef ML_LOAD
}

__device__ __forceinline__ void gla_item(const Ctx cx, CParams& p, int item, char* smem) {
  const int tid = cx.tid, lane = tid & 63, w = tid >> 6, r = lane & 31, h = lane >> 5;
  const int bl = item >> 3, head = (item >> 1) & 3, dir = item & 1;
  const int base = bl * TPS;
  u16* sQ = (u16*)smem;
  u16* sK = sQ + 32 * 72;
  u16* sKT = sK + 32 * 72;
  u16* sVT = sKT + 64 * 40;
  float* sLa = (float*)(sVT + 128 * 40);
  float* sW2 = sLa + 32 * 64;
  float* sBi = sW2 + 16 * 64;
  const u16* Z = p.BIG;
  u16* Y = p.BIG + (size_t)R * ZW + (size_t)(2 + dir) * R * 512;
  for (int i = tid; i < 16 * 64; i += NTHR) sW2[i] = p.ev_gla_w2[((size_t)dir * 16 + (i >> 6)) * 256 + head * 64 + (i & 63)];
  if (tid < 64) sBi[tid] = p.ev_gla_b[dir * 256 + head * 64 + tid];
  f32x16 sacc[2];
#pragma unroll
  for (int a = 0; a < 2; ++a)
#pragma unroll
    for (int i = 0; i < 16; ++i) sacc[a][i] = 0.f;
  const bool act = tid < 256;
  const int lr = (tid >> 3) & 31, lc = tid & 7;
  uint4 gq, gk, v0, v1, gl0, gl1;
#define GLA_LOAD(p0_) do { if (act) { const int grow = scan_row(base, dir, (p0_) + lr); const u16* zr = Z + (size_t)grow * ZW; \
      gq = *(const uint4*)(zr + 2064 + head * 64 + lc * 8); gk = *(const uint4*)(zr + 2320 + head * 64 + lc * 8); \
      v0 = *(const uint4*)(zr + 2576 + head * 128 + lc * 8); v1 = *(const uint4*)(zr + 2576 + head * 128 + lc * 8 + 64); \
      gl0 = *(const uint4*)(zr + 3600 + dir * 16); gl1 = *(const uint4*)(zr + 3600 + dir * 16 + 8); } } while (0)
  GLA_LOAD(0);
  for (int ch = 0; ch < TPS / 32; ++ch) {
    const int p0 = ch * 32;
    __syncthreads();
    if (act) {
      float gl[16];
      unpack8(gl0, gl); unpack8(gl1, gl + 8);
#pragma unroll
      for (int e = 0; e < 8; ++e) {
        const int c = lc * 8 + e;
        float xv = sBi[c];
#pragma unroll
        for (int q = 0; q < 16; ++q) xv += gl[q] * sW2[q * 64 + c];
        sLa[lr * 64 + c] = logsigf_(xv) * (1.f / 16.f);
      }
    }
    __syncthreads();
    if (tid < 64) {
      float lv[32];
#pragma unroll
      for (int t = 0; t < 32; ++t) lv[t] = sLa[t * 64 + tid];
      float b = 0.f;
#pragma unroll
      for (int t = 0; t < 32; ++t) { b += lv[t]; sLa[t * 64 + tid] = b; }
    }
    __syncthreads();
    if (act) {
      float qf[8], kf[8], o[8];
      unpack8(gq, qf); unpack8(gk, kf);
#pragma unroll
      for (int e = 0; e < 8; ++e) { const float bb = sLa[lr * 64 + lc * 8 + e]; qf[e] *= 0.125f * __expf(bb); kf[e] *= __expf(-bb); }
      *(uint4*)(sQ + lr * 72 + lc * 8) = pack8(qf);
      *(uint4*)(sK + lr * 72 + lc * 8) = pack8(kf);
#pragma unroll
      for (int e = 0; e < 8; ++e) sKT[(lc * 8 + e) * 40 + lr] = f2bf(kf[e]);
      (void)o;
      const u16* pv0 = (const u16*)&v0; const u16* pv1 = (const u16*)&v1;
#pragma unroll
      for (int e = 0; e < 8; ++e) { sVT[(lc * 8 + e) * 40 + lr] = pv0[e]; sVT[(lc * 8 + 64 + e) * 40 + lr] = pv1[e]; }
    }
    if (ch + 1 < TPS / 32) GLA_LOAD(p0 + 32);
    __syncthreads();
    if (act) {
    f32x16 st;
#pragma unroll
    for (int i = 0; i < 16; ++i) st[i] = 0.f;
#pragma unroll
    for (int ks = 0; ks < 4; ++ks) {
      const bf16x8 a = *(const bf16x8*)(sK + r * 72 + 16 * ks + 8 * h);
      const bf16x8 b = *(const bf16x8*)(sQ + r * 72 + 16 * ks + 8 * h);
      st = MFMA(a, b, st);
    }
#pragma unroll
    for (int i = 0; i < 16; ++i) { if (crow(i, h) > r) st[i] = 0.f; }
    f32x16 o;
#pragma unroll
    for (int i = 0; i < 16; ++i) o[i] = 0.f;
#pragma unroll
    for (int mb = 0; mb < 2; ++mb)
#pragma unroll
      for (int s2 = 0; s2 < 2; ++s2) {
        const bf16x8 cb = pack_step(sacc[mb], s2);
        const u16* qp = sQ + r * 72 + 32 * mb + 16 * s2 + 4 * h;
        const bf16x8 a = cat4(*(const s16x4*)qp, *(const s16x4*)(qp + 8));
        o = MFMA(a, cb, o);
      }
#pragma unroll
    for (int s2 = 0; s2 < 2; ++s2) {
      const bf16x8 a = pack_step(st, s2);
      const u16* vp = sVT + (32 * w + r) * 40 + 16 * s2 + 4 * h;
      const bf16x8 b = cat4(*(const s16x4*)vp, *(const s16x4*)(vp + 8));
      o = MFMA(a, b, o);
    }
#pragma unroll
    for (int i = 0; i < 16; ++i) {
      const int row = scan_row(base, dir, p0 + crow(i, h));
      Y[(size_t)row * 512 + head * 128 + 32 * w + r] = f2bf(o[i]);
    }
#pragma unroll
    for (int mb = 0; mb < 2; ++mb) {
#pragma unroll
      for (int s2 = 0; s2 < 2; ++s2) {
        const bf16x8 a = *(const bf16x8*)(sKT + (32 * mb + r) * 40 + 16 * s2 + 8 * h);
        const bf16x8 b = *(const bf16x8*)(sVT + (32 * w + r) * 40 + 16 * s2 + 8 * h);
        sacc[mb] = MFMA(a, b, sacc[mb]);
      }
#pragma unroll
      for (int i = 0; i < 16; ++i) sacc[mb][i] *= __expf(sLa[31 * 64 + 32 * mb + crow(i, h)]);
    }
    }
  }
#undef GLA_LOAD
}

__device__ __forceinline__ void ph_scan0(const Ctx cx, CParams& p, char* smem) {
  for (int it = cx.bid; it < 2 * SPG * 8; it += gridDim.x) {
    __syncthreads();
    if (it < SPG * 8) mlstm_item(cx, p, it, smem); else gla_item(cx, p, it - SPG * 8, smem);
  }
}

__device__ __forceinline__ void ph_evout(const Ctx cx, CParams& p, int g) {
  const int lane = cx.tid & 63;
  const int gw = cx.bid * NWV + (cx.tid >> 6), nw = gridDim.x * NWV;
  const u16* Yb = p.BIG + (size_t)R * ZW;
  for (int row = gw; row < R; row += nw) {
    const int c0 = lane * 16;
    const int part = c0 >> 9, cc = c0 & 511;
    const u16* yf = Yb + ((size_t)(2 * part) * R + row) * 512 + cc;
    const u16* yb = Yb + ((size_t)(2 * part + 1) * R + row) * 512 + cc;
    float a[16], b[16];
    unpack8(*(const uint4*)yf, a); unpack8(*(const uint4*)(yf + 8), a + 8);
    unpack8(*(const uint4*)yb, b); unpack8(*(const uint4*)(yb + 8), b + 8);
    float ss = 0.f;
#pragma unroll
    for (int e = 0; e < 16; ++e) { a[e] += b[e]; ss += a[e] * a[e]; }
    ss += __shfl_xor(ss, 1); ss += __shfl_xor(ss, 2); ss += __shfl_xor(ss, 4);
    const float rstd = rsqrtf(ss * (1.f / 128.f) + 1e-6f);
    const u16* zg = p.BIG + (size_t)row * ZW + (part ? 3088 : 1536) + cc;
    float gt[16];
    unpack8(*(const uint4*)zg, gt); unpack8(*(const uint4*)(zg + 8), gt + 8);
#pragma unroll
    for (int e = 0; e < 16; ++e) {
      const float gv = part ? siluf_(gt[e]) : sigmoidf_(gt[e]);
      a[e] = a[e] * rstd * p.ev_head_g[c0 + e] * gv;
    }
    *(uint4*)(p.H + (size_t)row * D + c0) = pack8(a);
    *(uint4*)(p.H + (size_t)row * D + c0 + 8) = pack8(a + 8);
  }
}

__device__ __forceinline__ void ph_ffnact(const Ctx cx, CParams& p, int g, int layer, bool lat_only) {
  const float* cw = p.ffn_conv_w + (size_t)layer * 9 * DFF;
  const float* cb = p.ffn_conv_b + (size_t)layer * DFF;
  constexpr int SEG = 16, NSEG = TPS / SEG;
  const int total = SPG * NSEG * 352;
  for (int it = cx.bid * NTHR + cx.tid; it < total; it += gridDim.x * NTHR) {
    const int cg = it % 352, sg = (it / 352) % NSEG, s = it / (352 * NSEG);
    const int f0 = cg * 8;
    const int pos0 = sg * SEG;
    const bool isctx = pos0 < CTX;
    if (lat_only && isctx) continue;
    bool has_up = false, has_dn = false, has_l, has_r;
    if (isctx) { has_l = pos0 > 0; has_r = pos0 + SEG < CTX; }
    else { const int lp = pos0 - CTX, gr = lp >> 6, gc0 = lp & 63; has_up = gr > 0; has_dn = gr < 31; has_l = gc0 > 0; has_r = gc0 + SEG < 64; }
    float w[3][3][8], bias[8];
#pragma unroll
    for (int dh = 0; dh < 3; ++dh)
#pragma unroll
      for (int dw = 0; dw < 3; ++dw) {
        const float4 w0 = *(const float4*)(cw + (dh * 3 + dw) * DFF + f0), w1 = *(const float4*)(cw + (dh * 3 + dw) * DFF + f0 + 4);
        w[dh][dw][0] = w0.x; w[dh][dw][1] = w0.y; w[dh][dw][2] = w0.z; w[dh][dw][3] = w0.w;
        w[dh][dw][4] = w1.x; w[dh][dw][5] = w1.y; w[dh][dw][6] = w1.z; w[dh][dw][7] = w1.w;
      }
    { const float4 b0 = *(const float4*)(cb + f0), b1 = *(const float4*)(cb + f0 + 4);
      bias[0] = b0.x; bias[1] = b0.y; bias[2] = b0.z; bias[3] = b0.w; bias[4] = b1.x; bias[5] = b1.y; bias[6] = b1.z; bias[7] = b1.w; }
    u16* gu = p.BIG + (size_t)(s * TPS + pos0) * GUW + f0;
    float c0[3][8], c1[3][8], c2[3][8];
    uint4 nx[3];
#define FA_LD1(d, tok_, ok_) do { const bool o_ = (ok_); const uint4 r_ = *(const uint4*)(gu + (ptrdiff_t)(o_ ? (tok_) : 0) * GUW); \
      d.x = o_ ? r_.x : 0u; d.y = o_ ? r_.y : 0u; d.z = o_ ? r_.z : 0u; d.w = o_ ? r_.w : 0u; } while (0)
#define FA_LOAD(dst, tok, ok) do { FA_LD1(dst[1], (tok), (ok)); FA_LD1(dst[0], (tok) - 64, (ok) && has_up); FA_LD1(dst[2], (tok) + 64, (ok) && has_dn); } while (0)
    FA_LOAD(nx, -1, has_l);
    unpack8(nx[0], c0[0]); unpack8(nx[1], c0[1]); unpack8(nx[2], c0[2]);
    FA_LOAD(nx, 0, true);
    unpack8(nx[0], c1[0]); unpack8(nx[1], c1[1]); unpack8(nx[2], c1[2]);
    FA_LOAD(nx, 1, true);
#pragma unroll 2
    for (int t = 0; t < SEG; ++t) {
      unpack8(nx[0], c2[0]); unpack8(nx[1], c2[1]); unpack8(nx[2], c2[2]);
      const uint4 upraw = *(const uint4*)(gu + (ptrdiff_t)t * GUW + DFF);
      { const int tn = t + 2; const bool ok = (tn < SEG) || (tn == SEG && has_r); FA_LOAD(nx, tn, ok); }
      float acc[8];
#pragma unroll
      for (int e = 0; e < 8; ++e) {
        float a = bias[e];
#pragma unroll
        for (int dh = 0; dh < 3; ++dh) a += c0[dh][e] * w[dh][0][e] + c1[dh][e] * w[dh][1][e] + c2[dh][e] * w[dh][2][e];
        acc[e] = a;
      }
      float up[8]; unpack8(upraw, up);
#pragma unroll
      for (int e = 0; e < 8; ++e) {
        const float xg = acc[e];
        const float th = tanh_fast(0.7978845608028654f * (xg + 0.044715f * xg * xg * xg));
        up[e] *= 0.5f * xg * (1.f + th);
      }
      *(uint4*)(gu + (ptrdiff_t)t * GUW + DFF) = pack8(up);
#pragma unroll
      for (int dh = 0; dh < 3; ++dh)
#pragma unroll
        for (int e = 0; e < 8; ++e) { c0[dh][e] = c1[dh][e]; c1[dh][e] = c2[dh][e]; }
    }
#undef FA_LOAD
#undef FA_LD1
  }
}

__device__ __forceinline__ void ph_xx(const Ctx cx, CParams& p, int g) {
  const size_t total = (size_t)R * 128;
  for (size_t i = (size_t)cx.bid * NTHR + cx.tid; i < total; i += (size_t)gridDim.x * NTHR) {
    const int row = (int)(i >> 7), c0 = ((int)(i & 127)) * 8;
    int b, pos; rowinfo(g, row, b, pos);
    const int q = c0 >> 8;
    int off = 0; bool ok;
    if (pos < CTX) {
      if ((q & 1) == 0) { off = -1; ok = pos > 0; } else { off = 1; ok = pos < CTX - 1; }
    } else {
      const int lp = pos - CTX, gr = lp >> 6, gc = lp & 63;
      if (q == 0) { off = -1; ok = gc > 0; }
      else if (q == 1) { off = 1; ok = gc < 63; }
      else if (q == 2) { off = -64; ok = gr > 0; }
      else { off = 64; ok = gr < 31; }
    }
    float hc[8], hs[8];
    unpack8(*(const uint4*)(p.H + (size_t)row * D + c0), hc);
    if (ok) unpack8(*(const uint4*)(p.H + (size_t)(row + off) * D + c0), hs); else { for (int e = 0; e < 8; ++e) hs[e] = 0.f; }
#pragma unroll
    for (int e = 0; e < 8; ++e) hs[e] -= hc[e];
    *(uint4*)(p.QK + (size_t)row * D + c0) = pack8(hs);
    float m_[8];
    const size_t RS_ = (size_t)R * D;
#pragma unroll
    for (int e = 0; e < 8; ++e) m_[e] = hc[e] + hs[e] * p.rw_mu[0 * D + c0 + e];
    *(uint4*)(p.BIG + 3 * RS_ + (size_t)row * D + c0) = pack8(m_);
#pragma unroll
    for (int e = 0; e < 8; ++e) m_[e] = hc[e] + hs[e] * p.rw_mu[2 * D + c0 + e];
    *(uint4*)(p.BIG + 4 * RS_ + (size_t)row * D + c0) = pack8(m_);
#pragma unroll
    for (int e = 0; e < 8; ++e) m_[e] = hc[e] + hs[e] * p.rw_mu[3 * D + c0 + e];
    *(uint4*)(p.BIG + 5 * RS_ + (size_t)row * D + c0) = pack8(m_);
  }
}

__device__ __forceinline__ void ph_rwprep(const Ctx cx, CParams& p) {
  const int lane = cx.tid & 63;
  const int gw = cx.bid * NWV + (cx.tid >> 6), nw = gridDim.x * NWV;
  const size_t RS = (size_t)R * D;
  float* CS = (float*)p.LR;
  for (int row = gw; row < R; row += nw) {
    const int c0 = lane * 16;
    const size_t o = (size_t)row * D + c0;
    float rr[16], kk[16], aa[16], km[16], ka[16];
    unpack8(*(const uint4*)(p.BIG + o), rr); unpack8(*(const uint4*)(p.BIG + o + 8), rr + 8);
    unpack8(*(const uint4*)(p.BIG + RS + o), kk); unpack8(*(const uint4*)(p.BIG + RS + o + 8), kk + 8);
    unpack8(*(const uint4*)(p.BIG + 3 * RS + o), aa); unpack8(*(const uint4*)(p.BIG + 3 * RS + o + 8), aa + 8);
    float ss = 0.f;
#pragma unroll
    for (int e = 0; e < 16; ++e) {
      km[e] = bf2f(f2bf(kk[e] * (1.f + (aa[e] - 1.f) * p.rw_kvec[D + c0 + e])));
      kk[e] *= p.rw_kvec[c0 + e]; ss += kk[e] * kk[e];
    }
    ss += __shfl_xor(ss, 1); ss += __shfl_xor(ss, 2);
    const float inv = 1.f / fmaxf(sqrtf(ss), 1e-12f);
    float c1 = 0.f, c2 = 0.f;
#pragma unroll
    for (int e = 0; e < 16; ++e) {
      kk[e] *= inv; ka[e] = bf2f(f2bf(kk[e] * aa[e]));
      c1 += ka[e] * rr[e]; c2 += km[e] * rr[e];
    }
    c1 += __shfl_xor(c1, 1); c1 += __shfl_xor(c1, 2);
    c2 += __shfl_xor(c2, 1); c2 += __shfl_xor(c2, 2);
    *(uint4*)(p.BIG + RS + o) = pack8(kk); *(uint4*)(p.BIG + RS + o + 8) = pack8(kk + 8);
    *(uint4*)(p.BIG + 3 * RS + o) = pack8(ka); *(uint4*)(p.BIG + 3 * RS + o + 8) = pack8(ka + 8);
    *(uint4*)(p.H + o) = pack8(km); *(uint4*)(p.H + o + 8) = pack8(km + 8);
    if ((lane & 3) == 0) { float2 c; c.x = c1; c.y = c2; *(float2*)(CS + (size_t)row * 32 + (lane >> 2) * 2) = c; }
  }
}

__device__ __forceinline__ void ph_rwscan(const Ctx cx, CParams& p) {
  const int lane = cx.tid & 63, w = cx.tid >> 6;
  if (w >= 4) return;
  const int vq = lane >> 3, kq = lane & 7, hf = w & 1;
  const size_t RS = (size_t)R * D;
  const u16* Rb = p.BIG; const u16* KKb = p.BIG + RS; const u16* Vb = p.BIG + 2 * RS; const u16* KAb = p.BIG + 3 * RS; const u16* KMb = p.H;
  const float* CS = (const float*)p.LR;
  const int nblk = (SPG * 16 * 2) / 2;
  for (int bi = cx.bid; bi < nblk; bi += gridDim.x) {
    const int item = bi * 2 + (w >> 1);
    const int bl = item >> 5, head = (item >> 1) & 15, dir = item & 1;
    const u16* Wb = p.BIG + (size_t)(4 + dir) * RS;
    u16* Yb = (u16*)p.YO + (size_t)dir * RS;
    const int base = bl * TPS;
    const int colk = head * 64 + kq * 8, colv = head * 64 + hf * 32 + vq * 4;
    float S[4][8];
#pragma unroll
    for (int i = 0; i < 4; ++i)
#pragma unroll
      for (int e = 0; e < 8; ++e) S[i][e] = 0.f;
    char* dummy = (char*)p.LR + (size_t)R * 128 + (cx.tid & 511) * 8;
    constexpr int PF = 4;
    uint4 qr[PF], qkk[PF], qka[PF], qkm[PF], qw[PF]; uint2 qv[PF]; float2 qcs[PF]; int qrow[PF];
#define RW_LOAD(j, ps_) do { const int row_ = scan_row(base, dir, (ps_)); qrow[j] = row_; \
      const unsigned ok_ = (unsigned)(row_ * D + colk) * 2u, ov_ = (unsigned)(row_ * D + colv) * 2u, oc_ = (unsigned)(row_ * 32 + head * 2) * 4u; \
      qr[j] = *(const uint4*)((const char*)Rb + ok_); qkk[j] = *(const uint4*)((const char*)KKb + ok_); \
      qka[j] = *(const uint4*)((const char*)KAb + ok_); qkm[j] = *(const uint4*)((const char*)KMb + ok_); \
      qw[j] = *(const uint4*)((const char*)Wb + ok_); qv[j] = *(const uint2*)((const char*)Vb + ov_); \
      qcs[j] = *(const float2*)((const char*)CS + oc_); } while (0)
#pragma unroll
    for (int j = 0; j < PF; ++j) RW_LOAD(j, j);
    for (int ps0 = 0; ps0 < TPS; ps0 += PF) {
#pragma unroll
    for (int j = 0; j < PF; ++j) {
      const uint4 cr_ = qr[j], ckk = qkk[j], cka = qka[j], ckm = qkm[j], cw = qw[j]; const uint2 cv = qv[j]; const float2 cs = qcs[j];
      const int crow_ = qrow[j];
      { const int pn_ = ps0 + PF + j; RW_LOAD(j, pn_ < TPS ? pn_ : TPS - 1); }
      float wr[8], kk[8], wm1[8], vv[4], kka[8], km[8];
      unpack8(cr_, wr); unpack8(ckk, kk); unpack8(cka, kka); unpack8(ckm, km); unpack8(cw, wm1);
      vv[0] = lo16(cv.x); vv[1] = hi16(cv.x); vv[2] = lo16(cv.y); vv[3] = hi16(cv.y);
#pragma unroll
      for (int e = 0; e < 8; ++e) wr[e] += wr[e] * wm1[e];
      float sa[4], yo[4];
#pragma unroll
      for (int i = 0; i < 4; ++i) {
        float s = 0.f, t = 0.f;
#pragma unroll
        for (int e = 0; e < 8; ++e) { s += S[i][e] * kk[e]; t += S[i][e] * wr[e]; }
        sa[i] = s; yo[i] = t;
      }
#pragma unroll
      for (int i = 0; i < 4; ++i) { sa[i] = -red8(sa[i]); yo[i] = red8(yo[i]); }
#pragma unroll
      for (int i = 0; i < 4; ++i) {
#pragma unroll
        for (int e = 0; e < 8; ++e) {
          float t = S[i][e] + S[i][e] * wm1[e];
          t += sa[i] * kka[e];
          t += vv[i] * km[e];
          S[i][e] = t;
        }
        yo[i] += sa[i] * cs.x + vv[i] * cs.y;
      }
      { uint2 o; o.x = pack2(yo[0], yo[1]); o.y = pack2(yo[2], yo[3]);
        char* dst_ = (kq == 0) ? (char*)Yb + (unsigned)(crow_ * D + colv) * 2u : dummy;
        *(uint2*)dst_ = o; }
    }
    }
#undef RW_LOAD
  }
}

__device__ __forceinline__ void ph_rwout(const Ctx cx, CParams& p, int g) {
  const int lane = cx.tid & 63;
  const int gw = cx.bid * NWV + (cx.tid >> 6), nw = gridDim.x * NWV;
  const size_t RS = (size_t)R * D;
  for (int row = gw; row < R; row += nw) {
    int b, pos; rowinfo(g, row, b, pos);
    if (pos < CTX) continue;
    const int c0 = lane * 16;
    const size_t o = (size_t)row * D + c0;
    float yf[16], yb[16], rr[16], kk[16], vv[16], gg[16];
    const u16* Yy = (const u16*)p.YO;
    unpack8(*(const uint4*)(Yy + o), yf); unpack8(*(const uint4*)(Yy + o + 8), yf + 8);
    unpack8(*(const uint4*)(Yy + RS + o), yb); unpack8(*(const uint4*)(Yy + RS + o + 8), yb + 8);
    unpack8(*(const uint4*)(p.BIG + o), rr); unpack8(*(const uint4*)(p.BIG + o + 8), rr + 8);
    unpack8(*(const uint4*)(p.H + o), kk); unpack8(*(const uint4*)(p.H + o + 8), kk + 8);
    unpack8(*(const uint4*)(p.BIG + 2 * RS + o), vv); unpack8(*(const uint4*)(p.BIG + 2 * RS + o + 8), vv + 8);
    unpack8(*(const uint4*)(p.QK + o), gg); unpack8(*(const uint4*)(p.QK + o + 8), gg + 8);
    float s1 = 0.f, bon = 0.f;
#pragma unroll
    for (int e = 0; e < 16; ++e) {
      yf[e] += yb[e]; s1 += yf[e];
      bon += rr[e] * kk[e] * p.rw_kvec[2 * D + c0 + e];
    }
    s1 += __shfl_xor(s1, 1); s1 += __shfl_xor(s1, 2);
    bon += __shfl_xor(bon, 1); bon += __shfl_xor(bon, 2);
    const float mu = s1 * (1.f / 64.f);
    float s2 = 0.f;
#pragma unroll
    for (int e = 0; e < 16; ++e) { const float d = yf[e] - mu; s2 += d * d; }
    s2 += __shfl_xor(s2, 1); s2 += __shfl_xor(s2, 2);
    const float rstd = rsqrtf(s2 * (1.f / 64.f) + 64e-5f);
#pragma unroll
    for (int e = 0; e < 16; ++e) {
      const float yn = (yf[e] - mu) * rstd * p.rw_lnx[c0 + e] + p.rw_lnx[D + c0 + e];
      yf[e] = (yn + bon * vv[e]) * gg[e];
    }
    *(uint4*)(p.H + o) = pack8(yf);
    *(uint4*)(p.H + o + 8) = pack8(yf + 8);
  }
}

__global__ void __launch_bounds__(NTHR) fwd_megakernel(Params p_arg) {
  cg::grid_group grid = cg::this_grid();
  __shared__ __attribute__((aligned(1024))) char smem[2 * STAGE_B];
  const size_t RS = (size_t)R * D;
  (void)RS;
  {
    Ctx cx; cx.tid = threadIdx.x; cx.bid = blockIdx.x;
    CParams* pp = (CParams*)__builtin_amdgcn_kernarg_segment_ptr();
    ph_prologue(cx, *pp, (float*)smem);
  }
  const int wave_s = __builtin_amdgcn_readfirstlane((int)threadIdx.x >> 6);
  grid.sync();
#pragma nounroll
  for (int it2 = 0; it2 < NG * NPH * 2; ++it2) {
    const int it = it2 >> 1;
    const int g = it / NPH, ph = it - g * NPH;
    if (it2 & 1) continue;
    const unsigned long long tp0 = PROBE_MASK ? wall_clock64() : 0ull;
    Ctx cx;
    {
      int t_ = (wave_s << 6) | (int)__builtin_amdgcn_mbcnt_hi(~0u, __builtin_amdgcn_mbcnt_lo(~0u, 0u));
      int b_ = blockIdx.x; asm volatile("" : "+v"(t_), "+s"(b_)); cx.tid = t_; cx.bid = b_; }
    CParams* pp = (CParams*)__builtin_amdgcn_kernarg_segment_ptr();
    asm volatile("" : "+s"(pp));
    CParams& p = *pp;
    switch (ph) {
      case 0: ph_norm0(cx, p, g); break;
      case 1: gemm256(cx, p.H, p.H, 1 << 30, D, p.wt_in, D, ZW / 256, false, EpBf16{p.BIG, ZW}, smem); break;
      case 2: ph_qkconv(cx, p, g); break;
      case 3: ph_scan0(cx, p, smem); break;
      case 4: ph_evout(cx, p, g); break;
      case 5: gemm256(cx, p.H, p.H, 1 << 30, D, p.wt_out, D, 4, false, EpBf16{(u16*)p.YO, D}, smem); break;
      case 6: ph_resid(cx, p, g, 0, 0, false); break;
      case 7: gemm256(cx, p.H, p.H, 1 << 30, D, p.wt_up, D, GUW / 256, false, EpBf16{p.BIG, GUW}, smem); break;
      case 8: ph_ffnact(cx, p, g, 0, false); break;
      case 9: gemm256(cx, p.BIG + DFF, p.BIG + DFF, 1 << 30, GUW, p.wt_down, DFF, 4, false, EpBf16{(u16*)p.YO, D}, smem); break;
      case 10: ph_resid(cx, p, g, 0, 1, false); break;
      case 11: ph_xx(cx, p, g); break;
      case 12: gemm256<true>(cx, p.H, p.QK, D, D, p.wt_1, K1, N1 / 256, false, EpRw1{p.BIG, p.LR}, smem, p.BIG + 3 * RS); break;
      case 13: gemm256(cx, p.LR, p.LR, 1 << 30, K2, p.wt_2, K2, N2 / 256, false, EpRw2{p.BIG, p.QK, p.rw_w0, p.rw_a0}, smem); break;
      case 14: ph_rwprep(cx, p); break;
      case 15: ph_rwscan(cx, p); break;
      case 16: ph_rwout(cx, p, g); break;
      case 17: gemm256(cx, p.H, p.H, 1 << 30, D, p.wt_o, D, 4, true, EpBf16{(u16*)p.YO, D}, smem); break;
      case 18: ph_resid(cx, p, g, 1, 0, true); break;
      case 19: gemm256(cx, p.H, p.H, 1 << 30, D, p.wt_up + (size_t)GUW * D, D, GUW / 256, true, EpBf16{p.BIG, GUW}, smem); break;
      case 20: ph_ffnact(cx, p, g, 1, true); break;
      case 21: gemm256(cx, p.BIG + DFF, p.BIG + DFF, 1 << 30, GUW, p.wt_down + (size_t)D * DFF, DFF, 4, true, EpBf16{(u16*)p.YO, D}, smem); break;
      default: ph_resid(cx, p, g, 1, 1, true); break;
    }
    grid.sync();
    if (PROBE_MASK && ((PROBE_MASK >> ph) & 1u)) {
      const unsigned long long tp1 = wall_clock64();
      while (wall_clock64() - tp1 < tp1 - tp0) __builtin_amdgcn_s_sleep(8);
    }
  }
}

extern "C" void kernel_launch(void* const* d_in, const int* in_sizes, int n_in, void* d_out, int out_size, void* d_ws,
                              size_t ws_size, hipStream_t stream) {
  static int grid_blocks = 0;
  if (!grid_blocks) {
    int dev = 0, cus = 0, per_cu = 0;
    hipGetDevice(&dev);
    hipDeviceGetAttribute(&cus, hipDeviceAttributeMultiprocessorCount, dev);
    hipOccupancyMaxActiveBlocksPerMultiprocessor(&per_cu, fwd_megakernel, NTHR, 0);
    if (per_cu > 1) per_cu = 1;
    if (per_cu < 1) per_cu = 1;
    grid_blocks = cus * per_cu;
  }
  Params p{};
  const float** f = (const float**)&p;
  for (int i = 0; i < 32; ++i) f[i] = (const float*)d_in[i];
  p.out = (float*)d_out;
  char* ws = (char*)d_ws;
  size_t off = 0;
  auto take = [&](size_t bytes) { char* q = ws + off; off += (bytes + 255) & ~(size_t)255; return q; };
  p.wt_in = (u16*)take((size_t)ZW * D * 2);
  p.wt_out = (u16*)take((size_t)D * D * 2);
  p.wt_up = (u16*)take((size_t)2 * GUW * D * 2);
  p.wt_down = (u16*)take((size_t)2 * D * DFF * 2);
  p.wt_o = (u16*)take((size_t)D * D * 2);
  p.wt_1 = (u16*)take((size_t)N1 * K1 * 2);
  p.wt_2 = (u16*)take((size_t)N2 * K2 * 2);
  p.mod = (float*)take((size_t)2 * 33 * 6144 * 4);
  p.xc = (float*)take((size_t)NB * CTX * D * 4);
  p.H = (u16*)take((size_t)R * D * 2);
  p.BIG = (u16*)take((size_t)6 * R * D * 2);
  p.QK = (u16*)take((size_t)R * D * 2);
  p.YO = (float*)take((size_t)R * D * 4);
  p.LR = (u16*)take((size_t)R * K2 * 2);
  if (off > ws_size) { fprintf(stderr, "workspace too small: need %zu have %zu\n", off, ws_size); return; }
  void* args[] = {&p};
  hipError_t e = hipLaunchCooperativeKernel((void*)fwd_megakernel, dim3(grid_blocks), dim3(NTHR), args, 0, stream);
  if (e != hipSuccess) fprintf(stderr, "cooperative launch failed: %s (grid %d)\n", hipGetErrorString(e), grid_blocks);
}
```

```cpp
#include <hip/hip_runtime.h>
#include <hip/hip_cooperative_groups.h>
#include <cstdio>
namespace cg = cooperative_groups;

typedef unsigned short u16;
using bf16x8 = __attribute__((ext_vector_type(8))) short;
using s16x4  = __attribute__((ext_vector_type(4))) short;
using f32x16 = __attribute__((ext_vector_type(16))) float;
#define DI __device__ __forceinline__
#define MFMA(a, b, c) __builtin_amdgcn_mfma_f32_32x32x16_bf16((a), (b), (c), 0, 0, 0)

constexpr int D = 1024, NB = 32, SEQ = 2048, CTX = 256, TPS = 2304;
constexpr int NG = 2, SPG = 16, R = SPG * TPS;
constexpr int ZW = 3840;
constexpr int DFF = 2816, GUW = 5632;
constexpr int NTHR = 512, NWV = NTHR / 64, NPH = 23;
constexpr int N1 = 3584, K1 = 2048, N2 = 4096, K2 = 320;
#ifndef PROBE_MASK_V
#define PROBE_MASK_V 0u
#endif
constexpr unsigned PROBE_MASK = PROBE_MASK_V;

struct Ctx { int tid, bid; };
struct Params {
  const float *x, *c, *ctx, *c_ctx, *w_mod, *b_mod, *norm_g, *ffn_w_up, *ffn_conv_w, *ffn_conv_b, *ffn_w_down,
      *ev_w_in, *ev_b_gates, *ev_conv_w, *ev_conv_b, *ev_gla_w2, *ev_gla_b, *ev_head_g, *ev_w_out,
      *rw_mu, *rw_w_rkv, *rw_w_o, *rw_w0, *rw_w1, *rw_w2, *rw_a0, *rw_a1, *rw_a2, *rw_g1, *rw_g2, *rw_kvec, *rw_lnx;
  float* out;
  u16 *wt_in, *wt_out, *wt_up, *wt_down, *wt_o, *wt_1, *wt_2;
  float* mod; float* xc;
  u16* H; u16* BIG; u16* QK; float* YO; u16* LR; unsigned* bar;
};

typedef const __attribute__((address_space(4))) Params CParams;

DI float bf2f(u16 v) { return __uint_as_float(((unsigned)v) << 16); }
typedef __bf16 bf16x2_t __attribute__((ext_vector_type(2)));
typedef float f32x2_t __attribute__((ext_vector_type(2)));
DI unsigned pack2(float a, float b) { f32x2_t v; v.x = a; v.y = b; return __builtin_bit_cast(unsigned, __builtin_convertvector(v, bf16x2_t)); }
DI u16 f2bf(float f) { return (u16)(pack2(f, 0.f) & 0xffffu); }
DI float lo16(unsigned u) { return __uint_as_float(u << 16); }
DI float hi16(unsigned u) { return __uint_as_float(u & 0xffff0000u); }
DI void unpack8(const uint4& v, float* o) {
  o[0] = lo16(v.x); o[1] = hi16(v.x); o[2] = lo16(v.y); o[3] = hi16(v.y);
  o[4] = lo16(v.z); o[5] = hi16(v.z); o[6] = lo16(v.w); o[7] = hi16(v.w);
}
DI uint4 pack8(const float* o) { uint4 v; v.x = pack2(o[0], o[1]); v.y = pack2(o[2], o[3]); v.z = pack2(o[4], o[5]); v.w = pack2(o[6], o[7]); return v; }
DI int crow(int reg, int h) { return (reg & 3) + 8 * (reg >> 2) + 4 * h; }
DI float wsum(float v) { for (int o = 32; o; o >>= 1) v += __shfl_xor(v, o); return v; }
DI float sigmoidf_(float x) { return 1.f / (1.f + __expf(-x)); }
DI float logsigf_(float x) { return fminf(x, 0.f) - log1pf(__expf(-fabsf(x))); }
DI float siluf_(float x) { return x / (1.f + __expf(-x)); }
DI bf16x8 cat4(s16x4 lo, s16x4 hi) { return __builtin_shufflevector(lo, hi, 0, 1, 2, 3, 4, 5, 6, 7); }
DI bf16x8 pack_step(const f32x16& x, int s) {
  uint4 v;
  v.x = pack2(x[8 * s + 0], x[8 * s + 1]); v.y = pack2(x[8 * s + 2], x[8 * s + 3]);
  v.z = pack2(x[8 * s + 4], x[8 * s + 5]); v.w = pack2(x[8 * s + 6], x[8 * s + 7]);
  return __builtin_bit_cast(bf16x8, v);
}
DI float dppf(float x, int) { return x; }
#define DPP_F(x, ctrl) __int_as_float(__builtin_amdgcn_update_dpp(0, __float_as_int(x), (ctrl), 0xF, 0xF, true))
DI float red8(float x) {
  x += DPP_F(x, 0x141);
  x += DPP_F(x, 0xB1);
  x += DPP_F(x, 0x4E);
  return x;
}

DI int scan_row(int base, int dir, int p) {
  if (dir == 0) return base + p;
  return (p < CTX) ? base + (CTX - 1 - p) : base + (TPS + CTX - 1 - p);
}

__device__ __forceinline__ void convert_job(const Ctx cx, const float* __restrict__ src, int K, int N, int Npad, u16* __restrict__ dst, int ldd, const float* __restrict__ mu, float* tile) {
  const int tx = cx.tid & 31, ty = cx.tid >> 5;
  const int tk = K >> 5, tn = Npad >> 5;
  for (int t = cx.bid; t < tk * tn; t += gridDim.x) {
    const int k0 = (t / tn) * 32, n0 = (t % tn) * 32;
#pragma unroll
    for (int i = 0; i < 2; ++i) {
      const int kk = k0 + ty + 16 * i, nn = n0 + tx;
      float v = (nn < N) ? src[(size_t)kk * N + nn] : 0.f;
      if (mu) v *= mu[kk];
      tile[(ty + 16 * i) * 33 + tx] = v;
    }
    __syncthreads();
#pragma unroll
    for (int i = 0; i < 2; ++i) {
      const int nn = n0 + ty + 16 * i, kk = k0 + tx;
      dst[(size_t)nn * ldd + kk] = f2bf(tile[tx * 33 + ty + 16 * i]);
    }
    __syncthreads();
  }
}

__device__ __forceinline__ void ph_mod(const Ctx cx, CParams& p, float* smem) {
  const int tid = cx.tid, lane = tid & 63, w = tid >> 6;
  float* sc = smem + w * (33 * 64);
  for (int u = cx.bid; u < 2 * 96; u += gridDim.x) {
    const int layer = u / 96, n = (u % 96) * 64 + lane;
    const float* W = p.w_mod + (size_t)layer * D * 6144;
    float acc[33];
#pragma unroll
    for (int i = 0; i < 33; ++i) acc[i] = 0.f;
    for (int kc = 0; kc < 2; ++kc) {
      const int k0 = w * 128 + kc * 64;
#pragma nounroll
      for (int cr = 0; cr < 33; ++cr) {
        const float v = (cr < 32) ? p.c[cr * D + k0 + lane] : p.c_ctx[k0 + lane];
        sc[cr * 64 + lane] = siluf_(v);
      }
      __syncthreads();
#pragma unroll 2
      for (int j = 0; j < 64; ++j) {
        const float wv = W[(size_t)(k0 + j) * 6144 + n];
#pragma unroll
        for (int cr = 0; cr < 33; ++cr) acc[cr] += sc[cr * 64 + j] * wv;
      }
      __syncthreads();
    }
#pragma unroll
    for (int cr = 0; cr < 33; ++cr) sc[cr * 64 + lane] = acc[cr];
    __syncthreads();
    if (w == 0) {
      const float bm = p.b_mod[layer * 6144 + n];
      for (int cr = 0; cr < 33; ++cr) {
        float s = 0.f;
#pragma unroll
        for (int q = 0; q < NWV; ++q) s += smem[q * 33 * 64 + cr * 64 + lane];
        p.mod[((size_t)layer * 33 + cr) * 6144 + n] = s + bm;
      }
    }
    __syncthreads();
  }
}

__device__ __forceinline__ void ph_prologue(const Ctx cx, CParams& p, float* smem) {
  ph_mod(cx, p, smem);
  convert_job(cx, p.ev_w_in, D, 3632, ZW, p.wt_in, D, nullptr, smem);
  convert_job(cx, p.ev_w_out, D, D, D, p.wt_out, D, nullptr, smem);
  for (int l = 0; l < 2; ++l) {
    convert_job(cx, p.ffn_w_up + (size_t)l * D * GUW, D, GUW, GUW, p.wt_up + (size_t)l * GUW * D, D, nullptr, smem);
    convert_job(cx, p.ffn_w_down + (size_t)l * DFF * D, DFF, D, D, p.wt_down + (size_t)l * D * DFF, DFF, nullptr, smem);
  }
  convert_job(cx, p.rw_w_o, D, D, D, p.wt_o, D, nullptr, smem);
  for (int half = 0; half < 2; ++half) {
    u16* dcol = p.wt_1 + half * D;
    const float* m0 = half ? p.rw_mu : nullptr;
    convert_job(cx, p.rw_w_rkv, D, D, D, dcol, K1, half ? m0 + 0 * D : nullptr, smem);
    convert_job(cx, p.rw_w_rkv + (size_t)D * D, D, D, D, dcol + (size_t)1024 * K1, K1, half ? m0 + 2 * D : nullptr, smem);
    convert_job(cx, p.rw_w_rkv + (size_t)2 * D * D, D, D, D, dcol + (size_t)2048 * K1, K1, half ? m0 + 3 * D : nullptr, smem);
    convert_job(cx, p.rw_w1, D, 64, 64, dcol + (size_t)3072 * K1, K1, half ? m0 + 1 * D : nullptr, smem);
    convert_job(cx, p.rw_w1 + D * 64, D, 64, 64, dcol + (size_t)3136 * K1, K1, half ? m0 + 1 * D : nullptr, smem);
    convert_job(cx, p.rw_a1, D, 64, 64, dcol + (size_t)3200 * K1, K1, half ? m0 + 4 * D : nullptr, smem);
    convert_job(cx, p.rw_g1, D, 128, 320, dcol + (size_t)3264 * K1, K1, half ? m0 + 5 * D : nullptr, smem);
  }
  for (size_t i = (size_t)cx.bid * NTHR + cx.tid; i < (size_t)N2 * K2; i += (size_t)gridDim.x * NTHR) {
    const int n = (int)(i / K2), c = (int)(i % K2), blk = n >> 10, nn = n & 1023;
    float v = 0.f;
    if (blk == 0) { if (c < 64) v = p.rw_w2[(size_t)c * D + nn]; }
    else if (blk == 1) { if (c >= 64 && c < 128) v = p.rw_w2[(size_t)(64 + c - 64) * D + nn]; }
    else if (blk == 2) { if (c >= 128 && c < 192) v = p.rw_a2[(size_t)(c - 128) * D + nn]; }
    else { if (c >= 192) v = p.rw_g2[(size_t)(c - 192) * D + nn]; }
    p.wt_2[i] = f2bf(v);
  }
}

DI void rowinfo(int g, int row, int& b, int& pos) { const int bl = row / TPS; pos = row - bl * TPS; b = g * SPG + bl; }

__device__ __forceinline__ void ph_norm0(const Ctx cx, CParams& p, int g) {
  const int lane = cx.tid & 63;
  const int gw = cx.bid * NWV + (cx.tid >> 6), nw = gridDim.x * NWV;
  for (int row = gw; row < R; row += nw) {
    int b, pos; rowinfo(g, row, b, pos);
    const float* src = (pos < CTX) ? p.ctx + ((size_t)(b * CTX + pos)) * D : p.x + ((size_t)(b * SEQ + pos - CTX)) * D;
    const float* md = p.mod + ((size_t)(pos < CTX ? 32 : b)) * 6144;
    float4 v[4]; float ss = 0.f;
#pragma unroll
    for (int j = 0; j < 4; ++j) { v[j] = ((const float4*)src)[j * 64 + lane]; ss += v[j].x * v[j].x + v[j].y * v[j].y + v[j].z * v[j].z + v[j].w * v[j].w; }
    ss = wsum(ss);
    const float rstd = rsqrtf(ss * (1.f / D) + 1e-6f);
#pragma unroll
    for (int j = 0; j < 4; ++j) {
      const int col = j * 256 + lane * 4;
      const float4 gg = *(const float4*)(p.norm_g + col);
      const float4 sh = *(const float4*)(md + col), sc = *(const float4*)(md + D + col);
      uint2 o;
      o.x = pack2(v[j].x * rstd * gg.x * (1.f + sc.x) + sh.x, v[j].y * rstd * gg.y * (1.f + sc.y) + sh.y);
      o.y = pack2(v[j].z * rstd * gg.z * (1.f + sc.z) + sh.z, v[j].w * rstd * gg.w * (1.f + sc.w) + sh.w);
      *(uint2*)(p.H + (size_t)row * D + col) = o;
    }
  }
}

__device__ __forceinline__ void ph_resid(const Ctx cx, CParams& p, int g, int layer, int which, bool lat_only) {
  const int lane = cx.tid & 63;
  const int gw = cx.bid * NWV + (cx.tid >> 6), nw = gridDim.x * NWV;
  const bool from_inputs = (layer == 0 && which == 0);
  const bool has_next = (which == 0) || (layer + 1 < 2);
  const float* ga = p.norm_g + (layer * 4 + (which ? 3 : 1)) * D;
  const float* gb = (which == 0) ? p.norm_g + (layer * 4 + 2) * D : p.norm_g + ((layer + 1) * 4 + 0) * D;
  for (int row = gw; row < R; row += nw) {
    int b, pos; rowinfo(g, row, b, pos);
    if (lat_only && pos < CTX) continue;
    const size_t ridx = (pos < CTX) ? ((size_t)(b * CTX + pos)) * D : ((size_t)(b * SEQ + pos - CTX)) * D;
    const float* src = from_inputs ? ((pos < CTX) ? p.ctx + ridx : p.x + ridx) : ((pos < CTX) ? p.xc + ridx : p.out + ridx);
    float* dst = (pos < CTX) ? p.xc + ridx : p.out + ridx;
    const int cr = (pos < CTX) ? 32 : b;
    const float* md = p.mod + ((size_t)layer * 33 + cr) * 6144;
    const float* mdn = (which == 0) ? md + 3 * D : p.mod + ((size_t)(layer + 1) * 33 + cr) * 6144;
    const float* gate = md + (which ? 5 : 2) * D;
    const u16* yo = (const u16*)p.YO + (size_t)row * D;
    float4 y[4], xv[4]; float ss = 0.f;
#pragma unroll
    for (int j = 0; j < 4; ++j) {
      const uint2 yb = ((const uint2*)yo)[j * 64 + lane];
      y[j].x = lo16(yb.x); y[j].y = hi16(yb.x); y[j].z = lo16(yb.y); y[j].w = hi16(yb.y);
      xv[j] = ((const float4*)src)[j * 64 + lane]; ss += y[j].x * y[j].x + y[j].y * y[j].y + y[j].z * y[j].z + y[j].w * y[j].w; }
    ss = wsum(ss);
    const float rstd = rsqrtf(ss * (1.f / D) + 1e-6f);
    float s2 = 0.f;
#pragma unroll
    for (int j = 0; j < 4; ++j) {
      const int col = j * 256 + lane * 4;
      const float4 g4 = *(const float4*)(ga + col), gt = *(const float4*)(gate + col);
      xv[j].x += gt.x * (y[j].x * rstd * g4.x); xv[j].y += gt.y * (y[j].y * rstd * g4.y);
      xv[j].z += gt.z * (y[j].z * rstd * g4.z); xv[j].w += gt.w * (y[j].w * rstd * g4.w);
      ((float4*)dst)[j * 64 + lane] = xv[j];
      s2 += xv[j].x * xv[j].x + xv[j].y * xv[j].y + xv[j].z * xv[j].z + xv[j].w * xv[j].w;
    }
    if (has_next) {
      s2 = wsum(s2);
      const float r2 = rsqrtf(s2 * (1.f / D) + 1e-6f);
#pragma unroll
      for (int j = 0; j < 4; ++j) {
        const int col = j * 256 + lane * 4;
        const float4 gg = *(const float4*)(gb + col);
        const float4 sh = *(const float4*)(mdn + col), sc = *(const float4*)(mdn + D + col);
        uint2 o;
        o.x = pack2(xv[j].x * r2 * gg.x * (1.f + sc.x) + sh.x, xv[j].y * r2 * gg.y * (1.f + sc.y) + sh.y);
        o.y = pack2(xv[j].z * r2 * gg.z * (1.f + sc.z) + sh.z, xv[j].w * r2 * gg.w * (1.f + sc.w) + sh.w);
        *(uint2*)(p.H + (size_t)row * D + col) = o;
      }
    }
  }
}

using f32x4 = __attribute__((ext_vector_type(4))) float;
using i32x4 = __attribute__((ext_vector_type(4))) int;
DI int lds_byte(int r, int c) {
  const int st = (r >> 4) * 2 + (c >> 5), ob = (r & 15) * 64 + (c & 31) * 2;
  return st * 1024 + (ob ^ (((ob >> 9) & 1) << 5));
}
DI void stage_rc(int b, int& Rr, int& Cc) {
  const int st = b >> 10, sb = b & 1023, swz = sb ^ (((sb >> 9) & 1) << 5);
  Rr = (st >> 1) * 16 + swz / 64;
  Cc = (st & 1) * 32 + (swz % 64) / 2;
}
constexpr int TILE_B = 256 * 64 * 2, STAGE_B = 2 * TILE_B;

DI const char* uni_ptr(const char* q) {
  const unsigned long long a = (unsigned long long)q;
  const unsigned lo = (unsigned)__builtin_amdgcn_readfirstlane((int)(unsigned)a), hi = (unsigned)__builtin_amdgcn_readfirstlane((int)(unsigned)(a >> 32));
  return (const char*)(((unsigned long long)hi << 32) | lo);
}
struct GUnit { const u16* A0; const u16* Bb; int ksplit, nt, brow, bcol; };
template <bool RW1>
DI GUnit gemm_unit(int u, int nN, int nMx, int xcd, bool lat_only, const u16* A0in, const u16* A2, int ksplit_in, int Kin, const u16* Bt, int ldb) {
  constexpr int GM = 4;
  const int grp = u / (GM * nN), fm = grp * GM, gsz = (nMx - fm) < GM ? (nMx - fm) : GM;
  const int rr_ = u - grp * (GM * nN);
  const int pn = rr_ / gsz, ml = fm + (rr_ - pn * gsz), pm = ml * 8 + xcd;
  GUnit g;
  g.brow = lat_only ? ((pm >> 3) * 9 + 1 + (pm & 7)) * 256 : pm * 256;
  g.bcol = pn * 256;
  g.A0 = A0in; g.ksplit = ksplit_in; int K = Kin;
  if constexpr (RW1) { if (pn < 12) { g.A0 = A2 + (size_t)(pn >> 2) * ((size_t)R * D); g.ksplit = 1 << 30; K = D; } }
  g.nt = K >> 6;
  g.Bb = Bt + (size_t)g.bcol * ldb;
  return g;
}
template <bool RW1 = false, class EP>
__device__ __forceinline__ void gemm256(const Ctx cx, const u16* __restrict__ A0in, const u16* __restrict__ A1, int ksplit_in, int lda,
                        const u16* __restrict__ Bt, int Kin, int nN, bool lat_only, const EP& ep, char* shm, const u16* __restrict__ A2 = nullptr) {
  const int wsg = __builtin_amdgcn_readfirstlane(cx.tid >> 6);
  const int wid = wsg, lane = cx.tid & 63;
  const int nM = lat_only ? SPG * 8 : R / 256;
  const int ldb = Kin;
  const int fragA = lds_byte((wsg >> 2) * 128 + (lane & 15), (lane >> 4) * 8), fragB = lds_byte((wsg & 3) * 64 + (lane & 15), (lane >> 4) * 8);
  const int xcd = cx.bid & 7, slot = cx.bid >> 3, nslot = gridDim.x >> 3, per_xcd = (nM >> 3) * nN;
  const int nMx = nM >> 3;
  if (slot < per_xcd) {
#define G_STAGE(buf, kt, UU, AO, BO) do { const int kb_ = (kt) * 64; const size_t ro_ = (size_t)(UU).brow * lda; \
    const char* Ab0_ = (const char*)((kb_ < (UU).ksplit) ? (UU).A0 + ro_ + kb_ : A1 + ro_ + (kb_ - (UU).ksplit)); \
    const char* Bb0_ = (const char*)((UU).Bb + kb_); \
    _Pragma("unroll") for (int i = 0; i < 4; ++i) { \
      const char* Ab_ = uni_ptr(Ab0_ + (size_t)i * 128 * lda); const char* Bb_ = uni_ptr(Bb0_ + (size_t)i * 128 * ldb);     \
      __builtin_amdgcn_global_load_lds((const unsigned*)(Ab_ + AO), (__attribute__((address_space(3))) unsigned*)(shm + (buf) * STAGE_B + wid * 1024 + i * 8192), 16, 0, 0); \
      __builtin_amdgcn_global_load_lds((const unsigned*)(Bb_ + BO), (__attribute__((address_space(3))) unsigned*)(shm + (buf) * STAGE_B + TILE_B + wid * 1024 + i * 8192), 16, 0, 0); } } while (0)
#define G_OFFS(UU, AO, BO) do { int sR, sC; stage_rc(wid * 1024 + lane * 16, sR, sC); \
      AO = (unsigned)((sR * lda + sC) * 2); BO = (unsigned)((sR * ldb + sC) * 2); } while (0)
  int u = slot;
  GUnit cu = gemm_unit<RW1>(u, nN, nMx, xcd, lat_only, A0in, A2, ksplit_in, Kin, Bt, ldb);
  unsigned aoff, boff;
  G_OFFS(cu, aoff, boff);
  G_STAGE(0, 0, cu, aoff, boff);
  asm volatile("s_waitcnt vmcnt(0)" ::: "memory");
  __syncthreads();
  int gt = 0;
  for (;;) {
    const int un = u + nslot;
    const bool has_next = un < per_xcd;
    f32x4 acc[8][4];
#pragma unroll
    for (int m = 0; m < 8; ++m)
#pragma unroll
      for (int n = 0; n < 4; ++n) acc[m][n] = (f32x4){0.f, 0.f, 0.f, 0.f};
    const int nt = cu.nt;
#pragma nounroll
    for (int t = 0; t < nt; ++t) {
      const int cur = gt & 1;
      if (t + 1 < nt) G_STAGE(cur ^ 1, t + 1, cu, aoff, boff);
      else if (has_next) {
        const GUnit nu = gemm_unit<RW1>(un, nN, nMx, xcd, lat_only, A0in, A2, ksplit_in, Kin, Bt, ldb);
        G_STAGE(cur ^ 1, 0, nu, aoff, boff);
      }
      const char* SAp = shm + cur * STAGE_B; const char* SBp = SAp + TILE_B;
      {
        bf16x8 At[8], Bf[4];
        const char* abase = SAp + fragA;
        const char* bbase = SBp + fragB;
#pragma unroll
        for (int n = 0; n < 4; ++n) Bf[n] = *(const bf16x8*)(bbase + n * 2048);
#pragma unroll
        for (int m = 0; m < 8; ++m) At[m] = *(const bf16x8*)(abase + m * 2048);
        __builtin_amdgcn_sched_barrier(0);
#pragma unroll
        for (int m = 0; m < 7; ++m) {
#pragma unroll
          for (int n = 0; n < 4; ++n) acc[m][n] = __builtin_amdgcn_mfma_f32_16x16x32_bf16(Bf[n], At[m], acc[m][n], 0, 0, 0);
          At[m] = *(const bf16x8*)(abase + m * 2048 + 1024);
          __builtin_amdgcn_sched_barrier(0);
        }
#pragma unroll
        for (int n = 0; n < 4; ++n) {
          acc[7][n] = __builtin_amdgcn_mfma_f32_16x16x32_bf16(Bf[n], At[7], acc[7][n], 0, 0, 0);
          Bf[n] = *(const bf16x8*)(bbase + n * 2048 + 1024);
          __builtin_amdgcn_sched_barrier(0);
        }
        At[7] = *(const bf16x8*)(abase + 7 * 2048 + 1024);
        __builtin_amdgcn_sched_barrier(0);
#pragma unroll
        for (int n = 0; n < 4; ++n) {
#pragma unroll
          for (int m = 0; m < 8; ++m) acc[m][n] = __builtin_amdgcn_mfma_f32_16x16x32_bf16(Bf[n], At[m], acc[m][n], 0, 0, 0);
          __builtin_amdgcn_sched_barrier(0);
        }
      }
      asm volatile("s_waitcnt vmcnt(0)" ::: "memory");
      __syncthreads();
      ++gt;
    }
    {
      int lane_ = (int)__builtin_amdgcn_mbcnt_hi(~0u, __builtin_amdgcn_mbcnt_lo(~0u, 0u));
      asm volatile("" : "+v"(lane_));
      const int wr = wsg >> 2, wc = wsg & 3, fr = lane_ & 15, fq = lane_ >> 4;
      char* ob = shm + 2 * STAGE_B + wsg * 2048;
      const int wofs = fr * 128 + (fq & 1) * 8, wch = fq >> 1, wsw = fr & 7;
      const int r8 = lane_ >> 3, c8 = lane_ & 7;
      const int rofs = r8 * 128 + ((c8 ^ (r8 & 7)) << 4);
#pragma unroll
      for (int m = 0; m < 8; ++m) {
#pragma unroll
        for (int n = 0; n < 4; ++n) {
          const f32x4 v = ep.conv(cu.brow + wr * 128 + m * 16 + fr, cu.bcol + wc * 64 + n * 16 + fq * 4, acc[m][n]);
          uint2 o; o.x = pack2(v[0], v[1]); o.y = pack2(v[2], v[3]);
          *(uint2*)(ob + wofs + ((((n << 1) | wch) ^ wsw) << 4)) = o;
        }
#pragma unroll
        for (int hh = 0; hh < 2; ++hh) {
          const uint4 val = *(const uint4*)(ob + hh * 1024 + rofs);
          u16* dp = ep.dst(cu.brow + wr * 128 + m * 16 + hh * 8 + r8, cu.bcol + wc * 64 + c8 * 8);
          if (dp) *(uint4*)dp = val;
        }
        __builtin_amdgcn_sched_barrier(0);
      }
    }
    if (!has_next) break;
    u = un;
    cu = gemm_unit<RW1>(u, nN, nMx, xcd, lat_only, A0in, A2, ksplit_in, Kin, Bt, ldb);
  }
  }
#undef G_STAGE
#undef G_OFFS
}

DI float tanh_fast(float x) { x = fminf(fmaxf(x, -15.f), 15.f); const float t = __expf(2.f * x); return (t - 1.f) / (t + 1.f); }
DI float decay_m1(float lw) {
  const float el = __expf(-fabsf(lw));
  const float ls = fminf(lw, 0.f) - __logf(1.f + el);
  const float e = __expf(ls - 0.5f);
  return __expf(-e) - 1.f;
}
struct EpBf16 {
  u16* base; int ld;
  DI f32x4 conv(int, int, f32x4 v) const { return v; }
  DI u16* dst(int row, int col) const { return base + (size_t)row * ld + col; }
};
struct EpRw1 {
  u16* big; u16* lr;
  DI f32x4 conv(int, int col, f32x4 v) const {
    const int cu = __builtin_amdgcn_readfirstlane(col >> 6);
    if (cu >= 48 && cu < 50) { v[0] = tanh_fast(v[0]); v[1] = tanh_fast(v[1]); v[2] = tanh_fast(v[2]); v[3] = tanh_fast(v[3]); }
    else if (cu >= 51 && cu < 53) { v[0] = sigmoidf_(v[0]); v[1] = sigmoidf_(v[1]); v[2] = sigmoidf_(v[2]); v[3] = sigmoidf_(v[3]); }
    return v;
  }
  DI u16* dst(int row, int col) const {
    if (col < 3072) return big + (size_t)(col >> 10) * ((size_t)R * D) + (size_t)row * D + (col & 1023);
    if (col < 3392) return lr + (size_t)row * K2 + (col - 3072);
    return nullptr;
  }
};
struct EpRw2 {
  u16* big; u16* gq; const float* w0; const float* a0;
  DI f32x4 conv(int, int col, f32x4 v) const {
    const int blk = __builtin_amdgcn_readfirstlane(col >> 10), cc = col & 1023;
    if (blk < 2) {
      const float4 ww = *(const float4*)(w0 + blk * D + cc);
      v[0] = decay_m1(v[0] + ww.x); v[1] = decay_m1(v[1] + ww.y); v[2] = decay_m1(v[2] + ww.z); v[3] = decay_m1(v[3] + ww.w);
    } else if (blk == 2) {
      const float4 ww = *(const float4*)(a0 + cc);
      v[0] = sigmoidf_(v[0] + ww.x); v[1] = sigmoidf_(v[1] + ww.y); v[2] = sigmoidf_(v[2] + ww.z); v[3] = sigmoidf_(v[3] + ww.w);
    }
    return v;
  }
  DI u16* dst(int row, int col) const {
    const int blk = col >> 10, cc = col & 1023;
    if (blk < 2) return big + (size_t)(4 + blk) * ((size_t)R * D) + (size_t)row * D + cc;
    if (blk == 2) return big + (size_t)3 * ((size_t)R * D) + (size_t)row * D + cc;
    return gq + (size_t)row * D + cc;
  }
};

__device__ __forceinline__ void ph_qkconv(const Ctx cx, CParams& p, int g) {
  const size_t total = (size_t)R * 128;
  for (size_t i = (size_t)cx.bid * NTHR + cx.tid; i < total; i += (size_t)gridDim.x * NTHR) {
    const int row = (int)(i >> 7), c0 = ((int)(i & 127)) * 8;
    int b, pos; rowinfo(g, row, b, pos);
    const bool hasp = (pos != 0 && pos != CTX), hasn = (pos != CTX - 1 && pos != TPS - 1);
    const u16* Z = p.BIG + (size_t)row * ZW + c0;
    float cur[8], pv[8], nx[8];
    unpack8(*(const uint4*)Z, cur);
    if (hasp) unpack8(*(const uint4*)(Z - ZW), pv); else { for (int e = 0; e < 8; ++e) pv[e] = 0.f; }
    if (hasn) unpack8(*(const uint4*)(Z + ZW), nx); else { for (int e = 0; e < 8; ++e) nx[e] = 0.f; }
    const float scale = (c0 < 512) ? 0.08838834764831845f : 1.f;
    float o[8];
#pragma unroll
    for (int e = 0; e < 8; ++e) {
      const int c = c0 + e;
      const float v = pv[e] * p.ev_conv_w[c] + cur[e] * p.ev_conv_w[D + c] + nx[e] * p.ev_conv_w[2 * D + c] + p.ev_conv_b[c];
      o[e] = siluf_(v) * scale;
    }
    *(uint4*)(p.QK + (size_t)row * D + c0) = pack8(o);
  }
}

__device__ __forceinline__ void mlstm_item(const Ctx cx, CParams& p, int item, char* smem) {
  const int tid = cx.tid, lane = tid & 63, w = tid >> 6, r = lane & 31, h = lane >> 5;
  const int bl = item >> 3, head = (item >> 1) & 3, dir = item & 1;
  const int base = bl * TPS;
  u16* sQ = (u16*)smem;
  u16* sK = sQ + 32 * 136;
  u16* sVT = sK + 32 * 136;
  u16* sKT = sVT + 128 * 40;
  float* sU = (float*)(sKT + 128 * 40);
  float* sM = sU + 32; float* sBc = sM + 32; float* sLast = sBc + 32;
  float* sN = sLast + 32;
  float* sRD = sN + 128;
  float* sWI = sRD + 128;
  const u16* Z = p.BIG;
  u16* Y = p.BIG + (size_t)R * ZW + (size_t)dir * R * 512;
  const float bgi = p.ev_b_gates[(2 * dir) * 4 + head], bgf = p.ev_b_gates[(2 * dir + 1) * 4 + head];
  f32x16 cacc[4];
#pragma unroll
  for (int a = 0; a < 4; ++a)
#pragma unroll
    for (int i = 0; i < 16; ++i) cacc[a][i] = 0.f;
  if (tid < 128) sN[tid] = 0.f;
  float m = 0.f;
  const bool act = tid < 256;
  const int lr = (tid >> 3) & 31, lc = tid & 7;
  uint4 q0, q1, k0, k1, v0, v1;
  u16 gzi = 0, gzf = 0;
#define ML_LOAD(p0_) do { if (act) { const int grow = scan_row(base, dir, (p0_) + lr); \
      q0 = *(const uint4*)(p.QK + (size_t)grow * D + head * 128 + lc * 8); \
      q1 = *(const uint4*)(p.QK + (size_t)grow * D + head * 128 + lc * 8 + 64); \
      k0 = *(const uint4*)(p.QK + (size_t)grow * D + 512 + head * 128 + lc * 8); \
      k1 = *(const uint4*)(p.QK + (size_t)grow * D + 512 + head * 128 + lc * 8 + 64); \
      v0 = *(const uint4*)(Z + (size_t)grow * ZW + 1024 + head * 128 + lc * 8); \
      v1 = *(const uint4*)(Z + (size_t)grow * ZW + 1024 + head * 128 + lc * 8 + 64); } \
    if (w == 0) { const int row_ = scan_row(base, dir, (p0_) + (lane & 31)); \
      gzi = Z[(size_t)row_ * ZW + 2048 + (2 * dir) * 4 + head]; gzf = Z[(size_t)row_ * ZW + 2048 + (2 * dir + 1) * 4 + head]; } } while (0)
  ML_LOAD(0);
  for (int ch = 0; ch < TPS / 32; ++ch) {
    const int p0 = ch * 32;
    __syncthreads();
    if (w == 0) {
      const int t = lane & 31;
      const float zi = bf2f(gzi) + bgi;
      const float zf = bf2f(gzf) + bgf;
      float bsum = logsigf_(zf);
      for (int o = 1; o < 32; o <<= 1) { const float v = __shfl_up(bsum, o); if (t >= o) bsum += v; }
      const float u = zi - bsum;
      float pm = u;
      for (int o = 1; o < 32; o <<= 1) { const float v = __shfl_up(pm, o); if (t >= o) pm = fmaxf(pm, v); }
      const float M = fmaxf(m, pm);
      if (lane < 32) { sU[t] = u; sM[t] = M; sBc[t] = bsum; if (t == 31) { sLast[0] = M; sLast[1] = bsum; } }
    }
    __syncthreads();
    const float Mlast = sLast[0], blast = sLast[1];
    if (act) {
      const float ws = __expf(sU[lr] - Mlast);
      *(uint4*)(sQ + lr * 136 + lc * 8) = q0; *(uint4*)(sQ + lr * 136 + lc * 8 + 64) = q1;
      *(uint4*)(sK + lr * 136 + lc * 8) = k0; *(uint4*)(sK + lr * 136 + lc * 8 + 64) = k1;
      float f[8];
      unpack8(k0, f);
#pragma unroll
      for (int e = 0; e < 8; ++e) sKT[(lc * 8 + e) * 40 + lr] = f2bf(f[e] * ws);
      unpack8(k1, f);
#pragma unroll
      for (int e = 0; e < 8; ++e) sKT[(lc * 8 + 64 + e) * 40 + lr] = f2bf(f[e] * ws);
      const u16* pv0 = (const u16*)&v0; const u16* pv1 = (const u16*)&v1;
#pragma unroll
      for (int e = 0; e < 8; ++e) { sVT[(lc * 8 + e) * 40 + lr] = pv0[e]; sVT[(lc * 8 + 64 + e) * 40 + lr] = pv1[e]; }
    }
    if (ch + 1 < TPS / 32) ML_LOAD(p0 + 32);
    __syncthreads();
    f32x16 st;
#pragma unroll
    for (int i = 0; i < 16; ++i) st[i] = 0.f;
    if (act) {
#pragma unroll
    for (int ks = 0; ks < 8; ++ks) {
      const bf16x8 a = *(const bf16x8*)(sK + r * 136 + 16 * ks + 8 * h);
      const bf16x8 b = *(const bf16x8*)(sQ + r * 136 + 16 * ks + 8 * h);
      st = MFMA(a, b, st);
    }
    const float Mt = sM[r];
    float dsum = 0.f;
#pragma unroll
    for (int i = 0; i < 16; ++i) {
      const int s = crow(i, h);
      const float pv = (s <= r) ? st[i] * __expf(sU[s] - Mt) : 0.f;
      st[i] = pv; dsum += pv;
    }
    dsum += __shfl_xor(dsum, 32);
    float qn = 0.f;
#pragma unroll
    for (int d8 = 0; d8 < 8; ++d8) {
      float qf[8]; unpack8(*(const uint4*)(sQ + r * 136 + 64 * h + 8 * d8), qf);
#pragma unroll
      for (int e = 0; e < 8; ++e) qn += qf[e] * sN[64 * h + 8 * d8 + e];
    }
    qn += __shfl_xor(qn, 32);
    const float wi = __expf(m - Mt);
    const float den = dsum + wi * qn;
    const float dn = fmaxf(fabsf(den), __expf(-(sBc[r] + Mt)));
    if (h == 0) { sRD[w * 32 + r] = 1.f / dn; sWI[w * 32 + r] = wi; }
    }
    __syncthreads();
    const float wp = __expf(m - Mlast);
    if (act) {
    f32x16 o;
#pragma unroll
    for (int i = 0; i < 16; ++i) o[i] = 0.f;
#pragma unroll
    for (int mb = 0; mb < 4; ++mb)
#pragma unroll
      for (int s2 = 0; s2 < 2; ++s2) {
        const bf16x8 cb = pack_step(cacc[mb], s2);
        const u16* qp = sQ + r * 136 + 32 * mb + 16 * s2 + 4 * h;
        const bf16x8 a = cat4(*(const s16x4*)qp, *(const s16x4*)(qp + 8));
        o = MFMA(a, cb, o);
      }
#pragma unroll
    for (int i = 0; i < 16; ++i) o[i] *= sWI[w * 32 + crow(i, h)];
#pragma unroll
    for (int s2 = 0; s2 < 2; ++s2) {
      const bf16x8 a = pack_step(st, s2);
      const u16* vp = sVT + (32 * w + r) * 40 + 16 * s2 + 4 * h;
      const bf16x8 b = cat4(*(const s16x4*)vp, *(const s16x4*)(vp + 8));
      o = MFMA(a, b, o);
    }
#pragma unroll
    for (int i = 0; i < 16; ++i) {
      const int t = crow(i, h);
      const int row = scan_row(base, dir, p0 + t);
      Y[(size_t)row * 512 + head * 128 + 32 * w + r] = f2bf(o[i] * sRD[w * 32 + t]);
    }
#pragma unroll
    for (int mb = 0; mb < 4; ++mb) {
#pragma unroll
      for (int i = 0; i < 16; ++i) cacc[mb][i] *= wp;
#pragma unroll
      for (int s2 = 0; s2 < 2; ++s2) {
        const bf16x8 a = *(const bf16x8*)(sKT + (32 * mb + r) * 40 + 16 * s2 + 8 * h);
        const bf16x8 b = *(const bf16x8*)(sVT + (32 * w + r) * 40 + 16 * s2 + 8 * h);
        cacc[mb] = MFMA(a, b, cacc[mb]);
      }
    }
    }
    __syncthreads();
    if (tid < 128) {
      float s = 0.f;
#pragma unroll
      for (int e = 0; e < 32; ++e) s += bf2f(sKT[tid * 40 + e]);
      sN[tid] = wp * sN[tid] + s;
    }
    m = blast + Mlast;
  }
#undef ML_LOAD
}

__device__ __forceinline__ void gla_item(const Ctx cx, CParams& p, int item, char* smem) {
  const int tid = cx.tid, lane = tid & 63, w = tid >> 6, r = lane & 31, h = lane >> 5;
  const int bl = item >> 3, head = (item >> 1) & 3, dir = item & 1;
  const int base = bl * TPS;
  u16* sQ = (u16*)smem;
  u16* sK = sQ + 32 * 72;
  u16* sKT = sK + 32 * 72;
  u16* sVT = sKT + 64 * 40;
  float* sLa = (float*)(sVT + 128 * 40);
  float* sW2 = sLa + 32 * 64;
  float* sBi = sW2 + 16 * 64;
  const u16* Z = p.BIG;
  u16* Y = p.BIG + (size_t)R * ZW + (size_t)(2 + dir) * R * 512;
  for (int i = tid; i < 16 * 64; i += NTHR) sW2[i] = p.ev_gla_w2[((size_t)dir * 16 + (i >> 6)) * 256 + head * 64 + (i & 63)];
  if (tid < 64) sBi[tid] = p.ev_gla_b[dir * 256 + head * 64 + tid];
  f32x16 sacc[2];
#pragma unroll
  for (int a = 0; a < 2; ++a)
#pragma unroll
    for (int i = 0; i < 16; ++i) sacc[a][i] = 0.f;
  const bool act = tid < 256;
  const int lr = (tid >> 3) & 31, lc = tid & 7;
  uint4 gq, gk, v0, v1, gl0, gl1;
#define GLA_LOAD(p0_) do { if (act) { const int grow = scan_row(base, dir, (p0_) + lr); const u16* zr = Z + (size_t)grow * ZW; \
      gq = *(const uint4*)(zr + 2064 + head * 64 + lc * 8); gk = *(const uint4*)(zr + 2320 + head * 64 + lc * 8); \
      v0 = *(const uint4*)(zr + 2576 + head * 128 + lc * 8); v1 = *(const uint4*)(zr + 2576 + head * 128 + lc * 8 + 64); \
      gl0 = *(const uint4*)(zr + 3600 + dir * 16); gl1 = *(const uint4*)(zr + 3600 + dir * 16 + 8); } } while (0)
  GLA_LOAD(0);
  for (int ch = 0; ch < TPS / 32; ++ch) {
    const int p0 = ch * 32;
    __syncthreads();
    if (act) {
      float gl[16];
      unpack8(gl0, gl); unpack8(gl1, gl + 8);
#pragma unroll
      for (int e = 0; e < 8; ++e) {
        const int c = lc * 8 + e;
        float xv = sBi[c];
#pragma unroll
        for (int q = 0; q < 16; ++q) xv += gl[q] * sW2[q * 64 + c];
        sLa[lr * 64 + c] = logsigf_(xv) * (1.f / 16.f);
      }
    }
    __syncthreads();
    if (tid < 64) {
      float lv[32];
#pragma unroll
      for (int t = 0; t < 32; ++t) lv[t] = sLa[t * 64 + tid];
      float b = 0.f;
#pragma unroll
      for (int t = 0; t < 32; ++t) { b += lv[t]; sLa[t * 64 + tid] = b; }
    }
    __syncthreads();
    if (act) {
      float qf[8], kf[8], o[8];
      unpack8(gq, qf); unpack8(gk, kf);
#pragma unroll
      for (int e = 0; e < 8; ++e) { const float bb = sLa[lr * 64 + lc * 8 + e]; qf[e] *= 0.125f * __expf(bb); kf[e] *= __expf(-bb); }
      *(uint4*)(sQ + lr * 72 + lc * 8) = pack8(qf);
      *(uint4*)(sK + lr * 72 + lc * 8) = pack8(kf);
#pragma unroll
      for (int e = 0; e < 8; ++e) sKT[(lc * 8 + e) * 40 + lr] = f2bf(kf[e]);
      (void)o;
      const u16* pv0 = (const u16*)&v0; const u16* pv1 = (const u16*)&v1;
#pragma unroll
      for (int e = 0; e < 8; ++e) { sVT[(lc * 8 + e) * 40 + lr] = pv0[e]; sVT[(lc * 8 + 64 + e) * 40 + lr] = pv1[e]; }
    }
    if (ch + 1 < TPS / 32) GLA_LOAD(p0 + 32);
    __syncthreads();
    if (act) {
    f32x16 st;
#pragma unroll
    for (int i = 0; i < 16; ++i) st[i] = 0.f;
#pragma unroll
    for (int ks = 0; ks < 4; ++ks) {
      const bf16x8 a = *(const bf16x8*)(sK + r * 72 + 16 * ks + 8 * h);
      const bf16x8 b = *(const bf16x8*)(sQ + r * 72 + 16 * ks + 8 * h);
      st = MFMA(a, b, st);
    }
#pragma unroll
    for (int i = 0; i < 16; ++i) { if (crow(i, h) > r) st[i] = 0.f; }
    f32x16 o;
#pragma unroll
    for (int i = 0; i < 16; ++i) o[i] = 0.f;
#pragma unroll
    for (int mb = 0; mb < 2; ++mb)
#pragma unroll
      for (int s2 = 0; s2 < 2; ++s2) {
        const bf16x8 cb = pack_step(sacc[mb], s2);
        const u16* qp = sQ + r * 72 + 32 * mb + 16 * s2 + 4 * h;
        const bf16x8 a = cat4(*(const s16x4*)qp, *(const s16x4*)(qp + 8));
        o = MFMA(a, cb, o);
      }
#pragma unroll
    for (int s2 = 0; s2 < 2; ++s2) {
      const bf16x8 a = pack_step(st, s2);
      const u16* vp = sVT + (32 * w + r) * 40 + 16 * s2 + 4 * h;
      const bf16x8 b = cat4(*(const s16x4*)vp, *(const s16x4*)(vp + 8));
      o = MFMA(a, b, o);
    }
#pragma unroll
    for (int i = 0; i < 16; ++i) {
      const int row = scan_row(base, dir, p0 + crow(i, h));
      Y[(size_t)row * 512 + head * 128 + 32 * w + r] = f2bf(o[i]);
    }
#pragma unroll
    for (int mb = 0; mb < 2; ++mb) {
#pragma unroll
      for (int s2 = 0; s2 < 2; ++s2) {
        const bf16x8 a = *(const bf16x8*)(sKT + (32 * mb + r) * 40 + 16 * s2 + 8 * h);
        const bf16x8 b = *(const bf16x8*)(sVT + (32 * w + r) * 40 + 16 * s2 + 8 * h);
        sacc[mb] = MFMA(a, b, sacc[mb]);
      }
#pragma unroll
      for (int i = 0; i < 16; ++i) sacc[mb][i] *= __expf(sLa[31 * 64 + 32 * mb + crow(i, h)]);
    }
    }
  }
#undef GLA_LOAD
}

__device__ __forceinline__ void ph_scan0(const Ctx cx, CParams& p, char* smem) {
  for (int it = cx.bid; it < 2 * SPG * 8; it += gridDim.x) {
    __syncthreads();
    if (it < SPG * 8) mlstm_item(cx, p, it, smem); else gla_item(cx, p, it - SPG * 8, smem);
  }
}

__device__ __forceinline__ void ph_evout(const Ctx cx, CParams& p, int g) {
  const int lane = cx.tid & 63;
  const int gw = cx.bid * NWV + (cx.tid >> 6), nw = gridDim.x * NWV;
  const u16* Yb = p.BIG + (size_t)R * ZW;
  for (int row = gw; row < R; row += nw) {
    const int c0 = lane * 16;
    const int part = c0 >> 9, cc = c0 & 511;
    const u16* yf = Yb + ((size_t)(2 * part) * R + row) * 512 + cc;
    const u16* yb = Yb + ((size_t)(2 * part + 1) * R + row) * 512 + cc;
    float a[16], b[16];
    unpack8(*(const uint4*)yf, a); unpack8(*(const uint4*)(yf + 8), a + 8);
    unpack8(*(const uint4*)yb, b); unpack8(*(const uint4*)(yb + 8), b + 8);
    float ss = 0.f;
#pragma unroll
    for (int e = 0; e < 16; ++e) { a[e] += b[e]; ss += a[e] * a[e]; }
    ss += __shfl_xor(ss, 1); ss += __shfl_xor(ss, 2); ss += __shfl_xor(ss, 4);
    const float rstd = rsqrtf(ss * (1.f / 128.f) + 1e-6f);
    const u16* zg = p.BIG + (size_t)row * ZW + (part ? 3088 : 1536) + cc;
    float gt[16];
    unpack8(*(const uint4*)zg, gt); unpack8(*(const uint4*)(zg + 8), gt + 8);
#pragma unroll
    for (int e = 0; e < 16; ++e) {
      const float gv = part ? siluf_(gt[e]) : sigmoidf_(gt[e]);
      a[e] = a[e] * rstd * p.ev_head_g[c0 + e] * gv;
    }
    *(uint4*)(p.H + (size_t)row * D + c0) = pack8(a);
    *(uint4*)(p.H + (size_t)row * D + c0 + 8) = pack8(a + 8);
  }
}

__device__ __forceinline__ void ph_ffnact(const Ctx cx, CParams& p, int g, int layer, bool lat_only) {
  const float* cw = p.ffn_conv_w + (size_t)layer * 9 * DFF;
  const float* cb = p.ffn_conv_b + (size_t)layer * DFF;
  constexpr int SEG = 16, NSEG = TPS / SEG;
  const int total = SPG * NSEG * 352;
  for (int it = cx.bid * NTHR + cx.tid; it < total; it += gridDim.x * NTHR) {
    const int cg = it % 352, sg = (it / 352) % NSEG, s = it / (352 * NSEG);
    const int f0 = cg * 8;
    const int pos0 = sg * SEG;
    const bool isctx = pos0 < CTX;
    if (lat_only && isctx) continue;
    bool has_up = false, has_dn = false, has_l, has_r;
    if (isctx) { has_l = pos0 > 0; has_r = pos0 + SEG < CTX; }
    else { const int lp = pos0 - CTX, gr = lp >> 6, gc0 = lp & 63; has_up = gr > 0; has_dn = gr < 31; has_l = gc0 > 0; has_r = gc0 + SEG < 64; }
    float w[3][3][8], bias[8];
#pragma unroll
    for (int dh = 0; dh < 3; ++dh)
#pragma unroll
      for (int dw = 0; dw < 3; ++dw) {
        const float4 w0 = *(const float4*)(cw + (dh * 3 + dw) * DFF + f0), w1 = *(const float4*)(cw + (dh * 3 + dw) * DFF + f0 + 4);
        w[dh][dw][0] = w0.x; w[dh][dw][1] = w0.y; w[dh][dw][2] = w0.z; w[dh][dw][3] = w0.w;
        w[dh][dw][4] = w1.x; w[dh][dw][5] = w1.y; w[dh][dw][6] = w1.z; w[dh][dw][7] = w1.w;
      }
    { const float4 b0 = *(const float4*)(cb + f0), b1 = *(const float4*)(cb + f0 + 4);
      bias[0] = b0.x; bias[1] = b0.y; bias[2] = b0.z; bias[3] = b0.w; bias[4] = b1.x; bias[5] = b1.y; bias[6] = b1.z; bias[7] = b1.w; }
    u16* gu = p.BIG + (size_t)(s * TPS + pos0) * GUW + f0;
    float c0[3][8], c1[3][8], c2[3][8];
    uint4 nx[3];
#define FA_LD1(d, tok_, ok_) do { const bool o_ = (ok_); const uint4 r_ = *(const uint4*)(gu + (ptrdiff_t)(o_ ? (tok_) : 0) * GUW); \
      d.x = o_ ? r_.x : 0u; d.y = o_ ? r_.y : 0u; d.z = o_ ? r_.z : 0u; d.w = o_ ? r_.w : 0u; } while (0)
#define FA_LOAD(dst, tok, ok) do { FA_LD1(dst[1], (tok), (ok)); FA_LD1(dst[0], (tok) - 64, (ok) && has_up); FA_LD1(dst[2], (tok) + 64, (ok) && has_dn); } while (0)
    FA_LOAD(nx, -1, has_l);
    unpack8(nx[0], c0[0]); unpack8(nx[1], c0[1]); unpack8(nx[2], c0[2]);
    FA_LOAD(nx, 0, true);
    unpack8(nx[0], c1[0]); unpack8(nx[1], c1[1]); unpack8(nx[2], c1[2]);
    FA_LOAD(nx, 1, true);
#pragma unroll 2
    for (int t = 0; t < SEG; ++t) {
      unpack8(nx[0], c2[0]); unpack8(nx[1], c2[1]); unpack8(nx[2], c2[2]);
      const uint4 upraw = *(const uint4*)(gu + (ptrdiff_t)t * GUW + DFF);
      { const int tn = t + 2; const bool ok = (tn < SEG) || (tn == SEG && has_r); FA_LOAD(nx, tn, ok); }
      float acc[8];
#pragma unroll
      for (int e = 0; e < 8; ++e) {
        float a = bias[e];
#pragma unroll
        for (int dh = 0; dh < 3; ++dh) a += c0[dh][e] * w[dh][0][e] + c1[dh][e] * w[dh][1][e] + c2[dh][e] * w[dh][2][e];
        acc[e] = a;
      }
      float up[8]; unpack8(upraw, up);
#pragma unroll
      for (int e = 0; e < 8; ++e) {
        const float xg = acc[e];
        const float th = tanh_fast(0.7978845608028654f * (xg + 0.044715f * xg * xg * xg));
        up[e] *= 0.5f * xg * (1.f + th);
      }
      *(uint4*)(gu + (ptrdiff_t)t * GUW + DFF) = pack8(up);
#pragma unroll
      for (int dh = 0; dh < 3; ++dh)
#pragma unroll
        for (int e = 0; e < 8; ++e) { c0[dh][e] = c1[dh][e]; c1[dh][e] = c2[dh][e]; }
    }
#undef FA_LOAD
#undef FA_LD1
  }
}

__device__ __forceinline__ void ph_xx(const Ctx cx, CParams& p, int g) {
  const size_t total = (size_t)R * 128;
  for (size_t i = (size_t)cx.bid * NTHR + cx.tid; i < total; i += (size_t)gridDim.x * NTHR) {
    const int row = (int)(i >> 7), c0 = ((int)(i & 127)) * 8;
    int b, pos; rowinfo(g, row, b, pos);
    const int q = c0 >> 8;
    int off = 0; bool ok;
    if (pos < CTX) {
      if ((q & 1) == 0) { off = -1; ok = pos > 0; } else { off = 1; ok = pos < CTX - 1; }
    } else {
      const int lp = pos - CTX, gr = lp >> 6, gc = lp & 63;
      if (q == 0) { off = -1; ok = gc > 0; }
      else if (q == 1) { off = 1; ok = gc < 63; }
      else if (q == 2) { off = -64; ok = gr > 0; }
      else { off = 64; ok = gr < 31; }
    }
    float hc[8], hs[8];
    unpack8(*(const uint4*)(p.H + (size_t)row * D + c0), hc);
    if (ok) unpack8(*(const uint4*)(p.H + (size_t)(row + off) * D + c0), hs); else { for (int e = 0; e < 8; ++e) hs[e] = 0.f; }
#pragma unroll
    for (int e = 0; e < 8; ++e) hs[e] -= hc[e];
    *(uint4*)(p.QK + (size_t)row * D + c0) = pack8(hs);
    float m_[8];
    const size_t RS_ = (size_t)R * D;
#pragma unroll
    for (int e = 0; e < 8; ++e) m_[e] = hc[e] + hs[e] * p.rw_mu[0 * D + c0 + e];
    *(uint4*)(p.BIG + 3 * RS_ + (size_t)row * D + c0) = pack8(m_);
#pragma unroll
    for (int e = 0; e < 8; ++e) m_[e] = hc[e] + hs[e] * p.rw_mu[2 * D + c0 + e];
    *(uint4*)(p.BIG + 4 * RS_ + (size_t)row * D + c0) = pack8(m_);
#pragma unroll
    for (int e = 0; e < 8; ++e) m_[e] = hc[e] + hs[e] * p.rw_mu[3 * D + c0 + e];
    *(uint4*)(p.BIG + 5 * RS_ + (size_t)row * D + c0) = pack8(m_);
  }
}

__device__ __forceinline__ void ph_rwprep(const Ctx cx, CParams& p) {
  const int lane = cx.tid & 63;
  const int gw = cx.bid * NWV + (cx.tid >> 6), nw = gridDim.x * NWV;
  const size_t RS = (size_t)R * D;
  float* CS = (float*)p.LR;
  for (int row = gw; row < R; row += nw) {
    const int c0 = lane * 16;
    const size_t o = (size_t)row * D + c0;
    float rr[16], kk[16], aa[16], km[16], ka[16];
    unpack8(*(const uint4*)(p.BIG + o), rr); unpack8(*(const uint4*)(p.BIG + o + 8), rr + 8);
    unpack8(*(const uint4*)(p.BIG + RS + o), kk); unpack8(*(const uint4*)(p.BIG + RS + o + 8), kk + 8);
    unpack8(*(const uint4*)(p.BIG + 3 * RS + o), aa); unpack8(*(const uint4*)(p.BIG + 3 * RS + o + 8), aa + 8);
    float ss = 0.f;
#pragma unroll
    for (int e = 0; e < 16; ++e) {
      km[e] = bf2f(f2bf(kk[e] * (1.f + (aa[e] - 1.f) * p.rw_kvec[D + c0 + e])));
      kk[e] *= p.rw_kvec[c0 + e]; ss += kk[e] * kk[e];
    }
    ss += __shfl_xor(ss, 1); ss += __shfl_xor(ss, 2);
    const float inv = 1.f / fmaxf(sqrtf(ss), 1e-12f);
    float c1 = 0.f, c2 = 0.f;
#pragma unroll
    for (int e = 0; e < 16; ++e) {
      kk[e] *= inv; ka[e] = bf2f(f2bf(kk[e] * aa[e]));
      c1 += ka[e] * rr[e]; c2 += km[e] * rr[e];
    }
    c1 += __shfl_xor(c1, 1); c1 += __shfl_xor(c1, 2);
    c2 += __shfl_xor(c2, 1); c2 += __shfl_xor(c2, 2);
    *(uint4*)(p.BIG + RS + o) = pack8(kk); *(uint4*)(p.BIG + RS + o + 8) = pack8(kk + 8);
    *(uint4*)(p.BIG + 3 * RS + o) = pack8(ka); *(uint4*)(p.BIG + 3 * RS + o + 8) = pack8(ka + 8);
    *(uint4*)(p.H + o) = pack8(km); *(uint4*)(p.H + o + 8) = pack8(km + 8);
    if ((lane & 3) == 0) { float2 c; c.x = c1; c.y = c2; *(float2*)(CS + (size_t)row * 32 + (lane >> 2) * 2) = c; }
  }
}

__device__ __forceinline__ void ph_rwscan(const Ctx cx, CParams& p) {
  const int lane = cx.tid & 63, w = cx.tid >> 6;
  if (w >= 4) return;
  const int vq = lane >> 3, kq = lane & 7, hf = w & 1;
  const size_t RS = (size_t)R * D;
  const u16* Rb = p.BIG; const u16* KKb = p.BIG + RS; const u16* Vb = p.BIG + 2 * RS; const u16* KAb = p.BIG + 3 * RS; const u16* KMb = p.H;
  const float* CS = (const float*)p.LR;
  const int nblk = (SPG * 16 * 2) / 2;
  for (int bi = cx.bid; bi < nblk; bi += gridDim.x) {
    const int item = bi * 2 + (w >> 1);
    const int bl = item >> 5, head = (item >> 1) & 15, dir = item & 1;
    const u16* Wb = p.BIG + (size_t)(4 + dir) * RS;
    u16* Yb = (u16*)p.YO + (size_t)dir * RS;
    const int base = bl * TPS;
    const int colk = head * 64 + kq * 8, colv = head * 64 + hf * 32 + vq * 4;
    float S[4][8];
#pragma unroll
    for (int i = 0; i < 4; ++i)
#pragma unroll
      for (int e = 0; e < 8; ++e) S[i][e] = 0.f;
    char* dummy = (char*)p.LR + (size_t)R * 128 + (cx.tid & 511) * 8;
    constexpr int PF = 4;
    uint4 qr[PF], qkk[PF], qka[PF], qkm[PF], qw[PF]; uint2 qv[PF]; float2 qcs[PF]; int qrow[PF];
#define RW_LOAD(j, ps_) do { const int row_ = scan_row(base, dir, (ps_)); qrow[j] = row_; \
      const unsigned ok_ = (unsigned)(row_ * D + colk) * 2u, ov_ = (unsigned)(row_ * D + colv) * 2u, oc_ = (unsigned)(row_ * 32 + head * 2) * 4u; \
      qr[j] = *(const uint4*)((const char*)Rb + ok_); qkk[j] = *(const uint4*)((const char*)KKb + ok_); \
      qka[j] = *(const uint4*)((const char*)KAb + ok_); qkm[j] = *(const uint4*)((const char*)KMb + ok_); \
      qw[j] = *(const uint4*)((const char*)Wb + ok_); qv[j] = *(const uint2*)((const char*)Vb + ov_); \
      qcs[j] = *(const float2*)((const char*)CS + oc_); } while (0)
#pragma unroll
    for (int j = 0; j < PF; ++j) RW_LOAD(j, j);
    for (int ps0 = 0; ps0 < TPS; ps0 += PF) {
#pragma unroll
    for (int j = 0; j < PF; ++j) {
      const uint4 cr_ = qr[j], ckk = qkk[j], cka = qka[j], ckm = qkm[j], cw = qw[j]; const uint2 cv = qv[j]; const float2 cs = qcs[j];
      const int crow_ = qrow[j];
      { const int pn_ = ps0 + PF + j; RW_LOAD(j, pn_ < TPS ? pn_ : TPS - 1); }
      float wr[8], kk[8], wm1[8], vv[4], kka[8], km[8];
      unpack8(cr_, wr); unpack8(ckk, kk); unpack8(cka, kka); unpack8(ckm, km); unpack8(cw, wm1);
      vv[0] = lo16(cv.x); vv[1] = hi16(cv.x); vv[2] = lo16(cv.y); vv[3] = hi16(cv.y);
#pragma unroll
      for (int e = 0; e < 8; ++e) wr[e] += wr[e] * wm1[e];
      float sa[4], yo[4];
#pragma unroll
      for (int i = 0; i < 4; ++i) {
        float s = 0.f, t = 0.f;
#pragma unroll
        for (int e = 0; e < 8; ++e) { s += S[i][e] * kk[e]; t += S[i][e] * wr[e]; }
        sa[i] = s; yo[i] = t;
      }
#pragma unroll
      for (int i = 0; i < 4; ++i) { sa[i] = -red8(sa[i]); yo[i] = red8(yo[i]); }
#pragma unroll
      for (int i = 0; i < 4; ++i) {
#pragma unroll
        for (int e = 0; e < 8; ++e) {
          float t = S[i][e] + S[i][e] * wm1[e];
          t += sa[i] * kka[e];
          t += vv[i] * km[e];
          S[i][e] = t;
        }
        yo[i] += sa[i] * cs.x + vv[i] * cs.y;
      }
      { uint2 o; o.x = pack2(yo[0], yo[1]); o.y = pack2(yo[2], yo[3]);
        char* dst_ = (kq == 0) ? (char*)Yb + (unsigned)(crow_ * D + colv) * 2u : dummy;
        *(uint2*)dst_ = o; }
    }
    }
#undef RW_LOAD
  }
}

__device__ __forceinline__ void ph_rwout(const Ctx cx, CParams& p, int g) {
  const int lane = cx.tid & 63;
  const int gw = cx.bid * NWV + (cx.tid >> 6), nw = gridDim.x * NWV;
  const size_t RS = (size_t)R * D;
  for (int row = gw; row < R; row += nw) {
    int b, pos; rowinfo(g, row, b, pos);
    if (pos < CTX) continue;
    const int c0 = lane * 16;
    const size_t o = (size_t)row * D + c0;
    float yf[16], yb[16], rr[16], kk[16], vv[16], gg[16];
    const u16* Yy = (const u16*)p.YO;
    unpack8(*(const uint4*)(Yy + o), yf); unpack8(*(const uint4*)(Yy + o + 8), yf + 8);
    unpack8(*(const uint4*)(Yy + RS + o), yb); unpack8(*(const uint4*)(Yy + RS + o + 8), yb + 8);
    unpack8(*(const uint4*)(p.BIG + o), rr); unpack8(*(const uint4*)(p.BIG + o + 8), rr + 8);
    unpack8(*(const uint4*)(p.H + o), kk); unpack8(*(const uint4*)(p.H + o + 8), kk + 8);
    unpack8(*(const uint4*)(p.BIG + 2 * RS + o), vv); unpack8(*(const uint4*)(p.BIG + 2 * RS + o + 8), vv + 8);
    unpack8(*(const uint4*)(p.QK + o), gg); unpack8(*(const uint4*)(p.QK + o + 8), gg + 8);
    float s1 = 0.f, bon = 0.f;
#pragma unroll
    for (int e = 0; e < 16; ++e) {
      yf[e] += yb[e]; s1 += yf[e];
      bon += rr[e] * kk[e] * p.rw_kvec[2 * D + c0 + e];
    }
    s1 += __shfl_xor(s1, 1); s1 += __shfl_xor(s1, 2);
    bon += __shfl_xor(bon, 1); bon += __shfl_xor(bon, 2);
    const float mu = s1 * (1.f / 64.f);
    float s2 = 0.f;
#pragma unroll
    for (int e = 0; e < 16; ++e) { const float d = yf[e] - mu; s2 += d * d; }
    s2 += __shfl_xor(s2, 1); s2 += __shfl_xor(s2, 2);
    const float rstd = rsqrtf(s2 * (1.f / 64.f) + 64e-5f);
#pragma unroll
    for (int e = 0; e < 16; ++e) {
      const float yn = (yf[e] - mu) * rstd * p.rw_lnx[c0 + e] + p.rw_lnx[D + c0 + e];
      yf[e] = (yn + bon * vv[e]) * gg[e];
    }
    *(uint4*)(p.H + o) = pack8(yf);
    *(uint4*)(p.H + o + 8) = pack8(yf + 8);
  }
}

#define XB_TMO      128
#define XB_XCNT(j)  (256  + 64 * (j))
#define XB_XSUB(j)  (1280 + 64 * (j))
#define XB_XGEN(j)  (2304 + 64 * (j))
#define XB_TOP      3328
#define XB_TOPGEN   3392
#define XCD_BAR_WORDS 3456
#define XB_SPIN_CAP (1u << 20)
#define LAS __attribute__((address_space(3)))
DI unsigned xb_ld(unsigned* p)              { return __hip_atomic_load(p, __ATOMIC_RELAXED, __HIP_MEMORY_SCOPE_AGENT); }
DI unsigned xb_add(unsigned* p, unsigned v) { return __hip_atomic_fetch_add(p, v, __ATOMIC_RELAXED, __HIP_MEMORY_SCOPE_AGENT); }
DI unsigned xb_xcc_id() { return (unsigned)__builtin_amdgcn_s_getreg((3 << 11) | 20) & 0xFu; }
#define XB_SPIN(cond, bar) do { unsigned _sp = 0; while (cond) { __builtin_amdgcn_s_sleep(1); \
    if ((++_sp & 255u) == 0u) { if (xb_ld(&(bar)[XB_TMO])) break; if (_sp > XB_SPIN_CAP) { atomicAdd(&(bar)[XB_TMO], 1u); break; } } } } while (0)
struct XcdBarrier { unsigned* bar; unsigned x; volatile LAS unsigned* st; };
DI XcdBarrier xcd_barrier_post(unsigned* bar, volatile LAS unsigned* st) {
  XcdBarrier b; b.bar = bar; b.x = xb_xcc_id(); b.st = st;
  if (threadIdx.x == 0) (void)xb_add(&bar[XB_XCNT(b.x)], 1u);
  return b;
}
DI void xcd_barrier_complete(unsigned* bar, unsigned x, unsigned& nloc, unsigned& nx) {
  const unsigned G = gridDim.x * gridDim.y * gridDim.z;
  unsigned sum, cnt, mine, sp = 0u;
  for (;;) {
    sum = 0u; cnt = 0u; mine = 0u;
#pragma unroll
    for (unsigned j = 0; j < 16; ++j) { const unsigned c = xb_ld(&bar[XB_XCNT(j)]); sum += c; cnt += (c > 0u) ? 1u : 0u; mine = (j == x) ? c : mine; }
    if (sum == G) break;
    __builtin_amdgcn_s_sleep(1);
    if ((++sp & 255u) == 0u) { if (xb_ld(&bar[XB_TMO])) break; if (sp > XB_SPIN_CAP) { atomicAdd(&bar[XB_TMO], 1u); break; } }
  }
  nloc = mine > 0u ? mine : 1u; nx = cnt > 0u ? cnt : 1u;
}
DI void xcd_barrier(const XcdBarrier& b) {
  asm volatile("s_waitcnt vmcnt(0)" ::: "memory");
  __syncthreads();
  if (threadIdx.x == 0) {
    unsigned* bar = b.bar;
    __builtin_amdgcn_s_waitcnt(0);
    unsigned nloc = b.st[0], nx = b.st[1];
    if (nloc == 0u) { xcd_barrier_complete(bar, b.x, nloc, nx); b.st[0] = nloc; b.st[1] = nx; }
    const unsigned old = xb_add(&bar[XB_XSUB(b.x)], 1u);
    const unsigned gen = old / nloc;
    if (old + 1u == (gen + 1u) * nloc) {
      __builtin_amdgcn_fence(__ATOMIC_RELEASE, "agent");
      asm volatile("s_waitcnt vmcnt(0)" ::: "memory");
      const unsigned og = xb_add(&bar[XB_TOP], 1u);
      const unsigned tg = og / nx;
      if (og + 1u == (tg + 1u) * nx) xb_add(&bar[XB_TOPGEN], 1u);
      else XB_SPIN(xb_ld(&bar[XB_TOPGEN]) == tg, bar);
      __builtin_amdgcn_fence(__ATOMIC_ACQUIRE, "agent");
      xb_add(&bar[XB_XGEN(b.x)], 1u);
      asm volatile("s_waitcnt vmcnt(0)" ::: "memory");
    } else {
      XB_SPIN(xb_ld(&bar[XB_XGEN(b.x)]) == gen, bar);
      __builtin_amdgcn_fence(__ATOMIC_ACQUIRE, "agent");
      asm volatile("s_waitcnt vmcnt(0)" ::: "memory");
    }
  }
  __syncthreads();
}

__global__ void __launch_bounds__(NTHR) fwd_megakernel(Params p_arg) {
  cg::grid_group grid = cg::this_grid();
  __shared__ __attribute__((aligned(1024))) char smem[2 * STAGE_B + 16384];
  const size_t RS = (size_t)R * D;
  (void)RS;
  __shared__ uint4 xb_words;
  if (threadIdx.x == 0) xb_words = make_uint4(0u, 0u, 0u, 0u);
  __syncthreads();
  const XcdBarrier xb = xcd_barrier_post(((CParams*)__builtin_amdgcn_kernarg_segment_ptr())->bar, (volatile LAS unsigned*)&xb_words);
  {
    Ctx cx; cx.tid = threadIdx.x; cx.bid = blockIdx.x;
    CParams* pp = (CParams*)__builtin_amdgcn_kernarg_segment_ptr();
    ph_prologue(cx, *pp, (float*)smem);
  }
  const int wave_s = __builtin_amdgcn_readfirstlane((int)threadIdx.x >> 6);
  grid.sync();
#pragma nounroll
  for (int it2 = 0; it2 < NG * NPH * 2; ++it2) {
    const int it = it2 >> 1;
    const int g = it / NPH, ph = it - g * NPH;
    if (it2 & 1) continue;
    const unsigned long long tp0 = PROBE_MASK ? wall_clock64() : 0ull;
    Ctx cx;
    {
      int t_ = (wave_s << 6) | (int)__builtin_amdgcn_mbcnt_hi(~0u, __builtin_amdgcn_mbcnt_lo(~0u, 0u));
      int b_ = blockIdx.x; asm volatile("" : "+v"(t_), "+s"(b_)); cx.tid = t_; cx.bid = b_; }
    CParams* pp = (CParams*)__builtin_amdgcn_kernarg_segment_ptr();
    asm volatile("" : "+s"(pp));
    CParams& p = *pp;
    switch (ph) {
      case 0: ph_norm0(cx, p, g); break;
      case 1: gemm256(cx, p.H, p.H, 1 << 30, D, p.wt_in, D, ZW / 256, false, EpBf16{p.BIG, ZW}, smem); break;
      case 2: ph_qkconv(cx, p, g); break;
      case 3: ph_scan0(cx, p, smem); break;
      case 4: ph_evout(cx, p, g); break;
      case 5: gemm256(cx, p.H, p.H, 1 << 30, D, p.wt_out, D, 4, false, EpBf16{(u16*)p.YO, D}, smem); break;
      case 6: ph_resid(cx, p, g, 0, 0, false); break;
      case 7: gemm256(cx, p.H, p.H, 1 << 30, D, p.wt_up, D, GUW / 256, false, EpBf16{p.BIG, GUW}, smem); break;
      case 8: ph_ffnact(cx, p, g, 0, false); break;
      case 9: gemm256(cx, p.BIG + DFF, p.BIG + DFF, 1 << 30, GUW, p.wt_down, DFF, 4, false, EpBf16{(u16*)p.YO, D}, smem); break;
      case 10: ph_resid(cx, p, g, 0, 1, false); break;
      case 11: ph_xx(cx, p, g); break;
      case 12: gemm256<true>(cx, p.H, p.QK, D, D, p.wt_1, K1, N1 / 256, false, EpRw1{p.BIG, p.LR}, smem, p.BIG + 3 * RS); break;
      case 13: gemm256(cx, p.LR, p.LR, 1 << 30, K2, p.wt_2, K2, N2 / 256, false, EpRw2{p.BIG, p.QK, p.rw_w0, p.rw_a0}, smem); break;
      case 14: ph_rwprep(cx, p); break;
      case 15: ph_rwscan(cx, p); break;
      case 16: ph_rwout(cx, p, g); break;
      case 17: gemm256(cx, p.H, p.H, 1 << 30, D, p.wt_o, D, 4, true, EpBf16{(u16*)p.YO, D}, smem); break;
      case 18: ph_resid(cx, p, g, 1, 0, true); break;
      case 19: gemm256(cx, p.H, p.H, 1 << 30, D, p.wt_up + (size_t)GUW * D, D, GUW / 256, true, EpBf16{p.BIG, GUW}, smem); break;
      case 20: ph_ffnact(cx, p, g, 1, true); break;
      case 21: gemm256(cx, p.BIG + DFF, p.BIG + DFF, 1 << 30, GUW, p.wt_down + (size_t)D * DFF, DFF, 4, true, EpBf16{(u16*)p.YO, D}, smem); break;
      default: ph_resid(cx, p, g, 1, 1, true); break;
    }
    xcd_barrier(xb);
    if (PROBE_MASK && ((PROBE_MASK >> ph) & 1u)) {
      const unsigned long long tp1 = wall_clock64();
      while (wall_clock64() - tp1 < tp1 - tp0) __builtin_amdgcn_s_sleep(8);
    }
  }
}

extern "C" void kernel_launch(void* const* d_in, const int* in_sizes, int n_in, void* d_out, int out_size, void* d_ws,
                              size_t ws_size, hipStream_t stream) {
  static int grid_blocks = 0;
  if (!grid_blocks) {
    int dev = 0, cus = 0, per_cu = 0;
    hipGetDevice(&dev);
    hipDeviceGetAttribute(&cus, hipDeviceAttributeMultiprocessorCount, dev);
    hipOccupancyMaxActiveBlocksPerMultiprocessor(&per_cu, fwd_megakernel, NTHR, 0);
    if (per_cu > 1) per_cu = 1;
    if (per_cu < 1) per_cu = 1;
    grid_blocks = cus * per_cu;
  }
  Params p{};
  const float** f = (const float**)&p;
  for (int i = 0; i < 32; ++i) f[i] = (const float*)d_in[i];
  p.out = (float*)d_out;
  char* ws = (char*)d_ws;
  size_t off = 0;
  auto take = [&](size_t bytes) { char* q = ws + off; off += (bytes + 255) & ~(size_t)255; return q; };
  p.wt_in = (u16*)take((size_t)ZW * D * 2);
  p.wt_out = (u16*)take((size_t)D * D * 2);
  p.wt_up = (u16*)take((size_t)2 * GUW * D * 2);
  p.wt_down = (u16*)take((size_t)2 * D * DFF * 2);
  p.wt_o = (u16*)take((size_t)D * D * 2);
  p.wt_1 = (u16*)take((size_t)N1 * K1 * 2);
  p.wt_2 = (u16*)take((size_t)N2 * K2 * 2);
  p.mod = (float*)take((size_t)2 * 33 * 6144 * 4);
  p.xc = (float*)take((size_t)NB * CTX * D * 4);
  p.H = (u16*)take((size_t)R * D * 2);
  p.BIG = (u16*)take((size_t)6 * R * D * 2);
  p.QK = (u16*)take((size_t)R * D * 2);
  p.YO = (float*)take((size_t)R * D * 4);
  p.LR = (u16*)take((size_t)R * K2 * 2);
  p.bar = (unsigned*)take((size_t)XCD_BAR_WORDS * 4);
  if (off > ws_size) { fprintf(stderr, "workspace too small: need %zu have %zu\n", off, ws_size); return; }
  hipMemsetAsync(p.bar, 0, (size_t)XCD_BAR_WORDS * 4, stream);
  void* args[] = {&p};
  hipError_t e = hipLaunchCooperativeKernel((void*)fwd_megakernel, dim3(grid_blocks), dim3(NTHR), args, 0, stream);
  if (e != hipSuccess) fprintf(stderr, "cooperative launch failed: %s (grid %d)\n", hipGetErrorString(e), grid_blocks);
}
```

```cpp
#include <hip/hip_runtime.h>
#include <hip/hip_cooperative_groups.h>
#include <cstdio>
namespace cg = cooperative_groups;

typedef unsigned short u16;
using bf16x8 = __attribute__((ext_vector_type(8))) short;
using s16x4  = __attribute__((ext_vector_type(4))) short;
using f32x16 = __attribute__((ext_vector_type(16))) float;
#define DI __device__ __forceinline__
#define MFMA(a, b, c) __builtin_amdgcn_mfma_f32_32x32x16_bf16((a), (b), (c), 0, 0, 0)

constexpr int D = 1024, NB = 32, SEQ = 2048, CTX = 256, TPS = 2304;
constexpr int NG = 2, SPG = 16, R = SPG * TPS;
constexpr int ZW = 3840;
constexpr int DFF = 2816, GUW = 5632;
constexpr int NTHR = 512, NWV = NTHR / 64, NPH = 23;
constexpr int N1 = 3584, K1 = 2048, N2 = 4096, K2 = 320;
#ifndef PROBE_MASK_V
#define PROBE_MASK_V 0u
#endif
constexpr unsigned PROBE_MASK = PROBE_MASK_V;

struct Ctx { int tid, bid; };
struct Params {
  const float *x, *c, *ctx, *c_ctx, *w_mod, *b_mod, *norm_g, *ffn_w_up, *ffn_conv_w, *ffn_conv_b, *ffn_w_down,
      *ev_w_in, *ev_b_gates, *ev_conv_w, *ev_conv_b, *ev_gla_w2, *ev_gla_b, *ev_head_g, *ev_w_out,
      *rw_mu, *rw_w_rkv, *rw_w_o, *rw_w0, *rw_w1, *rw_w2, *rw_a0, *rw_a1, *rw_a2, *rw_g1, *rw_g2, *rw_kvec, *rw_lnx;
  float* out;
  u16 *wt_in, *wt_out, *wt_up, *wt_down, *wt_o, *wt_1, *wt_2;
  float* mod; float* xc;
  u16* H; u16* BIG; u16* QK; float* YO; u16* LR; unsigned* bar;
};

typedef const __attribute__((address_space(4))) Params CParams;

DI float bf2f(u16 v) { return __uint_as_float(((unsigned)v) << 16); }
typedef __bf16 bf16x2_t __attribute__((ext_vector_type(2)));
typedef float f32x2_t __attribute__((ext_vector_type(2)));
DI unsigned pack2(float a, float b) { f32x2_t v; v.x = a; v.y = b; return __builtin_bit_cast(unsigned, __builtin_convertvector(v, bf16x2_t)); }
DI u16 f2bf(float f) { return (u16)(pack2(f, 0.f) & 0xffffu); }
DI float lo16(unsigned u) { return __uint_as_float(u << 16); }
DI float hi16(unsigned u) { return __uint_as_float(u & 0xffff0000u); }
DI void unpack8(const uint4& v, float* o) {
  o[0] = lo16(v.x); o[1] = hi16(v.x); o[2] = lo16(v.y); o[3] = hi16(v.y);
  o[4] = lo16(v.z); o[5] = hi16(v.z); o[6] = lo16(v.w); o[7] = hi16(v.w);
}
DI uint4 pack8(const float* o) { uint4 v; v.x = pack2(o[0], o[1]); v.y = pack2(o[2], o[3]); v.z = pack2(o[4], o[5]); v.w = pack2(o[6], o[7]); return v; }
DI int crow(int reg, int h) { return (reg & 3) + 8 * (reg >> 2) + 4 * h; }
DI float wsum(float v) { for (int o = 32; o; o >>= 1) v += __shfl_xor(v, o); return v; }
DI float sigmoidf_(float x) { return 1.f / (1.f + __expf(-x)); }
DI float logsigf_(float x) { return fminf(x, 0.f) - log1pf(__expf(-fabsf(x))); }
DI float siluf_(float x) { return x / (1.f + __expf(-x)); }
DI bf16x8 cat4(s16x4 lo, s16x4 hi) { return __builtin_shufflevector(lo, hi, 0, 1, 2, 3, 4, 5, 6, 7); }
DI bf16x8 pack_step(const f32x16& x, int s) {
  uint4 v;
  v.x = pack2(x[8 * s + 0], x[8 * s + 1]); v.y = pack2(x[8 * s + 2], x[8 * s + 3]);
  v.z = pack2(x[8 * s + 4], x[8 * s + 5]); v.w = pack2(x[8 * s + 6], x[8 * s + 7]);
  return __builtin_bit_cast(bf16x8, v);
}
DI float dppf(float x, int) { return x; }
#define DPP_F(x, ctrl) __int_as_float(__builtin_amdgcn_update_dpp(0, __float_as_int(x), (ctrl), 0xF, 0xF, true))
DI float red8(float x) {
  x += DPP_F(x, 0x141);
  x += DPP_F(x, 0xB1);
  x += DPP_F(x, 0x4E);
  return x;
}

DI int scan_row(int base, int dir, int p) {
  if (dir == 0) return base + p;
  return (p < CTX) ? base + (CTX - 1 - p) : base + (TPS + CTX - 1 - p);
}

__device__ __forceinline__ void convert_job(const Ctx cx, const float* __restrict__ src, int K, int N, int Npad, u16* __restrict__ dst, int ldd, const float* __restrict__ mu, float* tile) {
  const int tx = cx.tid & 31, ty = cx.tid >> 5;
  const int tk = K >> 5, tn = Npad >> 5;
  for (int t = cx.bid; t < tk * tn; t += gridDim.x) {
    const int k0 = (t / tn) * 32, n0 = (t % tn) * 32;
#pragma unroll
    for (int i = 0; i < 2; ++i) {
      const int kk = k0 + ty + 16 * i, nn = n0 + tx;
      float v = (nn < N) ? src[(size_t)kk * N + nn] : 0.f;
      if (mu) v *= mu[kk];
      tile[(ty + 16 * i) * 33 + tx] = v;
    }
    __syncthreads();
#pragma unroll
    for (int i = 0; i < 2; ++i) {
      const int nn = n0 + ty + 16 * i, kk = k0 + tx;
      dst[(size_t)nn * ldd + kk] = f2bf(tile[tx * 33 + ty + 16 * i]);
    }
    __syncthreads();
  }
}

__device__ __forceinline__ void ph_mod(const Ctx cx, CParams& p, float* smem) {
  const int tid = cx.tid, lane = tid & 63, w = tid >> 6;
  float* sc = smem + w * (33 * 64);
  for (int u = cx.bid; u < 2 * 96; u += gridDim.x) {
    const int layer = u / 96, n = (u % 96) * 64 + lane;
    const float* W = p.w_mod + (size_t)layer * D * 6144;
    float acc[33];
#pragma unroll
    for (int i = 0; i < 33; ++i) acc[i] = 0.f;
    for (int kc = 0; kc < 2; ++kc) {
      const int k0 = w * 128 + kc * 64;
#pragma nounroll
      for (int cr = 0; cr < 33; ++cr) {
        const float v = (cr < 32) ? p.c[cr * D + k0 + lane] : p.c_ctx[k0 + lane];
        sc[cr * 64 + lane] = siluf_(v);
      }
      __syncthreads();
#pragma unroll 2
      for (int j = 0; j < 64; ++j) {
        const float wv = W[(size_t)(k0 + j) * 6144 + n];
#pragma unroll
        for (int cr = 0; cr < 33; ++cr) acc[cr] += sc[cr * 64 + j] * wv;
      }
      __syncthreads();
    }
#pragma unroll
    for (int cr = 0; cr < 33; ++cr) sc[cr * 64 + lane] = acc[cr];
    __syncthreads();
    if (w == 0) {
      const float bm = p.b_mod[layer * 6144 + n];
      for (int cr = 0; cr < 33; ++cr) {
        float s = 0.f;
#pragma unroll
        for (int q = 0; q < NWV; ++q) s += smem[q * 33 * 64 + cr * 64 + lane];
        p.mod[((size_t)layer * 33 + cr) * 6144 + n] = s + bm;
      }
    }
    __syncthreads();
  }
}

__device__ __forceinline__ void ph_prologue(const Ctx cx, CParams& p, float* smem) {
  ph_mod(cx, p, smem);
  convert_job(cx, p.ev_w_in, D, 3632, ZW, p.wt_in, D, nullptr, smem);
  convert_job(cx, p.ev_w_out, D, D, D, p.wt_out, D, nullptr, smem);
  for (int l = 0; l < 2; ++l) {
    convert_job(cx, p.ffn_w_up + (size_t)l * D * GUW, D, GUW, GUW, p.wt_up + (size_t)l * GUW * D, D, nullptr, smem);
    convert_job(cx, p.ffn_w_down + (size_t)l * DFF * D, DFF, D, D, p.wt_down + (size_t)l * D * DFF, DFF, nullptr, smem);
  }
  convert_job(cx, p.rw_w_o, D, D, D, p.wt_o, D, nullptr, smem);
  for (int half = 0; half < 2; ++half) {
    u16* dcol = p.wt_1 + half * D;
    const float* m0 = half ? p.rw_mu : nullptr;
    convert_job(cx, p.rw_w_rkv, D, D, D, dcol, K1, half ? m0 + 0 * D : nullptr, smem);
    convert_job(cx, p.rw_w_rkv + (size_t)D * D, D, D, D, dcol + (size_t)1024 * K1, K1, half ? m0 + 2 * D : nullptr, smem);
    convert_job(cx, p.rw_w_rkv + (size_t)2 * D * D, D, D, D, dcol + (size_t)2048 * K1, K1, half ? m0 + 3 * D : nullptr, smem);
    convert_job(cx, p.rw_w1, D, 64, 64, dcol + (size_t)3072 * K1, K1, half ? m0 + 1 * D : nullptr, smem);
    convert_job(cx, p.rw_w1 + D * 64, D, 64, 64, dcol + (size_t)3136 * K1, K1, half ? m0 + 1 * D : nullptr, smem);
    convert_job(cx, p.rw_a1, D, 64, 64, dcol + (size_t)3200 * K1, K1, half ? m0 + 4 * D : nullptr, smem);
    convert_job(cx, p.rw_g1, D, 128, 320, dcol + (size_t)3264 * K1, K1, half ? m0 + 5 * D : nullptr, smem);
  }
  for (size_t i = (size_t)cx.bid * NTHR + cx.tid; i < (size_t)N2 * K2; i += (size_t)gridDim.x * NTHR) {
    const int n = (int)(i / K2), c = (int)(i % K2), blk = n >> 10, nn = n & 1023;
    float v = 0.f;
    if (blk == 0) { if (c < 64) v = p.rw_w2[(size_t)c * D + nn]; }
    else if (blk == 1) { if (c >= 64 && c < 128) v = p.rw_w2[(size_t)(64 + c - 64) * D + nn]; }
    else if (blk == 2) { if (c >= 128 && c < 192) v = p.rw_a2[(size_t)(c - 128) * D + nn]; }
    else { if (c >= 192) v = p.rw_g2[(size_t)(c - 192) * D + nn]; }
    p.wt_2[i] = f2bf(v);
  }
}

DI void rowinfo(int g, int row, int& b, int& pos) { const int bl = row / TPS; pos = row - bl * TPS; b = g * SPG + bl; }

__device__ __forceinline__ void ph_norm0(const Ctx cx, CParams& p, int g) {
  const int lane = cx.tid & 63;
  const int gw = cx.bid * NWV + (cx.tid >> 6), nw = gridDim.x * NWV;
  for (int row = gw; row < R; row += nw) {
    int b, pos; rowinfo(g, row, b, pos);
    const float* src = (pos < CTX) ? p.ctx + ((size_t)(b * CTX + pos)) * D : p.x + ((size_t)(b * SEQ + pos - CTX)) * D;
    const float* md = p.mod + ((size_t)(pos < CTX ? 32 : b)) * 6144;
    float4 v[4]; float ss = 0.f;
#pragma unroll
    for (int j = 0; j < 4; ++j) { v[j] = ((const float4*)src)[j * 64 + lane]; ss += v[j].x * v[j].x + v[j].y * v[j].y + v[j].z * v[j].z + v[j].w * v[j].w; }
    ss = wsum(ss);
    const float rstd = rsqrtf(ss * (1.f / D) + 1e-6f);
#pragma unroll
    for (int j = 0; j < 4; ++j) {
      const int col = j * 256 + lane * 4;
      const float4 gg = *(const float4*)(p.norm_g + col);
      const float4 sh = *(const float4*)(md + col), sc = *(const float4*)(md + D + col);
      uint2 o;
      o.x = pack2(v[j].x * rstd * gg.x * (1.f + sc.x) + sh.x, v[j].y * rstd * gg.y * (1.f + sc.y) + sh.y);
      o.y = pack2(v[j].z * rstd * gg.z * (1.f + sc.z) + sh.z, v[j].w * rstd * gg.w * (1.f + sc.w) + sh.w);
      *(uint2*)(p.H + (size_t)row * D + col) = o;
    }
  }
}

__device__ __forceinline__ void ph_resid(const Ctx cx, CParams& p, int g, int layer, int which, bool lat_only) {
  const int lane = cx.tid & 63;
  const int gw = cx.bid * NWV + (cx.tid >> 6), nw = gridDim.x * NWV;
  const bool from_inputs = (layer == 0 && which == 0);
  const bool has_next = (which == 0) || (layer + 1 < 2);
  const float* ga = p.norm_g + (layer * 4 + (which ? 3 : 1)) * D;
  const float* gb = (which == 0) ? p.norm_g + (layer * 4 + 2) * D : p.norm_g + ((layer + 1) * 4 + 0) * D;
  for (int row = gw; row < R; row += nw) {
    int b, pos; rowinfo(g, row, b, pos);
    if (lat_only && pos < CTX) continue;
    const size_t ridx = (pos < CTX) ? ((size_t)(b * CTX + pos)) * D : ((size_t)(b * SEQ + pos - CTX)) * D;
    const float* src = from_inputs ? ((pos < CTX) ? p.ctx + ridx : p.x + ridx) : ((pos < CTX) ? p.xc + ridx : p.out + ridx);
    float* dst = (pos < CTX) ? p.xc + ridx : p.out + ridx;
    const int cr = (pos < CTX) ? 32 : b;
    const float* md = p.mod + ((size_t)layer * 33 + cr) * 6144;
    const float* mdn = (which == 0) ? md + 3 * D : p.mod + ((size_t)(layer + 1) * 33 + cr) * 6144;
    const float* gate = md + (which ? 5 : 2) * D;
    const u16* yo = (const u16*)p.YO + (size_t)row * D;
    float4 y[4], xv[4]; float ss = 0.f;
#pragma unroll
    for (int j = 0; j < 4; ++j) {
      const uint2 yb = ((const uint2*)yo)[j * 64 + lane];
      y[j].x = lo16(yb.x); y[j].y = hi16(yb.x); y[j].z = lo16(yb.y); y[j].w = hi16(yb.y);
      xv[j] = ((const float4*)src)[j * 64 + lane]; ss += y[j].x * y[j].x + y[j].y * y[j].y + y[j].z * y[j].z + y[j].w * y[j].w; }
    ss = wsum(ss);
    const float rstd = rsqrtf(ss * (1.f / D) + 1e-6f);
    float s2 = 0.f;
#pragma unroll
    for (int j = 0; j < 4; ++j) {
      const int col = j * 256 + lane * 4;
      const float4 g4 = *(const float4*)(ga + col), gt = *(const float4*)(gate + col);
      xv[j].x += gt.x * (y[j].x * rstd * g4.x); xv[j].y += gt.y * (y[j].y * rstd * g4.y);
      xv[j].z += gt.z * (y[j].z * rstd * g4.z); xv[j].w += gt.w * (y[j].w * rstd * g4.w);
      ((float4*)dst)[j * 64 + lane] = xv[j];
      s2 += xv[j].x * xv[j].x + xv[j].y * xv[j].y + xv[j].z * xv[j].z + xv[j].w * xv[j].w;
    }
    if (has_next) {
      s2 = wsum(s2);
      const float r2 = rsqrtf(s2 * (1.f / D) + 1e-6f);
#pragma unroll
      for (int j = 0; j < 4; ++j) {
        const int col = j * 256 + lane * 4;
        const float4 gg = *(const float4*)(gb + col);
        const float4 sh = *(const float4*)(mdn + col), sc = *(const float4*)(mdn + D + col);
        uint2 o;
        o.x = pack2(xv[j].x * r2 * gg.x * (1.f + sc.x) + sh.x, xv[j].y * r2 * gg.y * (1.f + sc.y) + sh.y);
        o.y = pack2(xv[j].z * r2 * gg.z * (1.f + sc.z) + sh.z, xv[j].w * r2 * gg.w * (1.f + sc.w) + sh.w);
        *(uint2*)(p.H + (size_t)row * D + col) = o;
      }
    }
  }
}

using f32x4 = __attribute__((ext_vector_type(4))) float;
using i32x4 = __attribute__((ext_vector_type(4))) int;
DI int lds_byte(int r, int c) {
  const int st = (r >> 4) * 2 + (c >> 5), ob = (r & 15) * 64 + (c & 31) * 2;
  return st * 1024 + (ob ^ (((ob >> 9) & 1) << 5));
}
DI void stage_rc(int b, int& Rr, int& Cc) {
  const int st = b >> 10, sb = b & 1023, swz = sb ^ (((sb >> 9) & 1) << 5);
  Rr = (st >> 1) * 16 + swz / 64;
  Cc = (st & 1) * 32 + (swz % 64) / 2;
}
constexpr int TILE_B = 256 * 64 * 2, STAGE_B = 2 * TILE_B;

DI const char* uni_ptr(const char* q) {
  const unsigned long long a = (unsigned long long)q;
  const unsigned lo = (unsigned)__builtin_amdgcn_readfirstlane((int)(unsigned)a), hi = (unsigned)__builtin_amdgcn_readfirstlane((int)(unsigned)(a >> 32));
  return (const char*)(((unsigned long long)hi << 32) | lo);
}
struct GUnit { const u16* A0; const u16* Bb; int ksplit, nt, brow, bcol; };
template <bool RW1>
DI GUnit gemm_unit(int u, int nN, int nMx, int xcd, bool lat_only, const u16* A0in, const u16* A2, int ksplit_in, int Kin, const u16* Bt, int ldb) {
  constexpr int GM = 4;
  const int grp = u / (GM * nN), fm = grp * GM, gsz = (nMx - fm) < GM ? (nMx - fm) : GM;
  const int rr_ = u - grp * (GM * nN);
  const int pn = rr_ / gsz, ml = fm + (rr_ - pn * gsz), pm = ml * 8 + xcd;
  GUnit g;
  g.brow = lat_only ? ((pm >> 3) * 9 + 1 + (pm & 7)) * 256 : pm * 256;
  g.bcol = pn * 256;
  g.A0 = A0in; g.ksplit = ksplit_in; int K = Kin;
  if constexpr (RW1) { if (pn < 12) { g.A0 = A2 + (size_t)(pn >> 2) * ((size_t)R * D); g.ksplit = 1 << 30; K = D; } }
  g.nt = K >> 6;
  g.Bb = Bt + (size_t)g.bcol * ldb;
  return g;
}
template <bool RW1 = false, class EP>
__device__ __forceinline__ void gemm256(const Ctx cx, const u16* __restrict__ A0in, const u16* __restrict__ A1, int ksplit_in, int lda,
                        const u16* __restrict__ Bt, int Kin, int nN, bool lat_only, const EP& ep, char* shm, const u16* __restrict__ A2 = nullptr) {
  const int wsg = __builtin_amdgcn_readfirstlane(cx.tid >> 6);
  const int wid = wsg, lane = cx.tid & 63;
  const int nM = lat_only ? SPG * 8 : R / 256;
  const int ldb = Kin;
  const int fragA = lds_byte((wsg >> 2) * 128 + (lane & 15), (lane >> 4) * 8), fragB = lds_byte((wsg & 3) * 64 + (lane & 15), (lane >> 4) * 8);
  const int xcd = cx.bid & 7, slot = cx.bid >> 3, nslot = gridDim.x >> 3, per_xcd = (nM >> 3) * nN;
  const int nMx = nM >> 3;
  if (slot < per_xcd) {
#define G_STAGE(buf, kt, UU, AO, BO) do { const int kb_ = (kt) * 64; const size_t ro_ = (size_t)(UU).brow * lda; \
    const char* Ab0_ = (const char*)((kb_ < (UU).ksplit) ? (UU).A0 + ro_ + kb_ : A1 + ro_ + (kb_ - (UU).ksplit)); \
    const char* Bb0_ = (const char*)((UU).Bb + kb_); \
    _Pragma("unroll") for (int i = 0; i < 4; ++i) { \
      const char* Ab_ = uni_ptr(Ab0_ + (size_t)i * 128 * lda); const char* Bb_ = uni_ptr(Bb0_ + (size_t)i * 128 * ldb);     \
      __builtin_amdgcn_global_load_lds((const unsigned*)(Ab_ + AO), (__attribute__((address_space(3))) unsigned*)(shm + (buf) * STAGE_B + wid * 1024 + i * 8192), 16, 0, 0); \
      __builtin_amdgcn_global_load_lds((const unsigned*)(Bb_ + BO), (__attribute__((address_space(3))) unsigned*)(shm + (buf) * STAGE_B + TILE_B + wid * 1024 + i * 8192), 16, 0, 0); } } while (0)
#define G_STAGE1(buf, kt, UU, AO, BO, i) do { const int kb_ = (kt) * 64; const size_t ro_ = (size_t)(UU).brow * lda; \
    const char* Ab0_ = (const char*)((kb_ < (UU).ksplit) ? (UU).A0 + ro_ + kb_ : A1 + ro_ + (kb_ - (UU).ksplit)); \
    const char* Bb0_ = (const char*)((UU).Bb + kb_); \
    const char* Ab_ = uni_ptr(Ab0_ + (size_t)(i) * 128 * lda); const char* Bb_ = uni_ptr(Bb0_ + (size_t)(i) * 128 * ldb); \
    __builtin_amdgcn_global_load_lds((const unsigned*)(Ab_ + AO), (__attribute__((address_space(3))) unsigned*)(shm + (buf) * STAGE_B + wid * 1024 + (i) * 8192), 16, 0, 0); \
    __builtin_amdgcn_global_load_lds((const unsigned*)(Bb_ + BO), (__attribute__((address_space(3))) unsigned*)(shm + (buf) * STAGE_B + TILE_B + wid * 1024 + (i) * 8192), 16, 0, 0); } while (0)
#define G_OFFS(UU, AO, BO) do { int sR, sC; stage_rc(wid * 1024 + lane * 16, sR, sC); \
      AO = (unsigned)((sR * lda + sC) * 2); BO = (unsigned)((sR * ldb + sC) * 2); } while (0)
  int u = slot;
  GUnit cu = gemm_unit<RW1>(u, nN, nMx, xcd, lat_only, A0in, A2, ksplit_in, Kin, Bt, ldb);
  unsigned aoff, boff;
  G_OFFS(cu, aoff, boff);
  G_STAGE(0, 0, cu, aoff, boff);
  asm volatile("s_waitcnt vmcnt(0)" ::: "memory");
  __syncthreads();
  int gt = 0;
  for (;;) {
    const int un = u + nslot;
    const bool has_next = un < per_xcd;
    f32x4 acc[8][4];
#pragma unroll
    for (int m = 0; m < 8; ++m)
#pragma unroll
      for (int n = 0; n < 4; ++n) acc[m][n] = (f32x4){0.f, 0.f, 0.f, 0.f};
    const int nt = cu.nt;
#pragma nounroll
    for (int t = 0; t < nt; ++t) {
      const int cur = gt & 1;
      const char* SAp = shm + cur * STAGE_B; const char* SBp = SAp + TILE_B;
      {
        bf16x8 At[8], Bf[4];
        const char* abase = SAp + fragA;
        const char* bbase = SBp + fragB;
#pragma unroll
        for (int n = 0; n < 4; ++n) Bf[n] = *(const bf16x8*)(bbase + n * 2048);
#pragma unroll
        for (int m = 0; m < 2; ++m) At[m] = *(const bf16x8*)(abase + m * 2048);
        __builtin_amdgcn_sched_barrier(0);
        const bool in_unit = t + 1 < nt;
        const bool do_stage = in_unit || has_next;
        GUnit su = cu;
        if (!in_unit && has_next) su = gemm_unit<RW1>(un, nN, nMx, xcd, lat_only, A0in, A2, ksplit_in, Kin, Bt, ldb);
        const int skt = in_unit ? t + 1 : 0;
#pragma unroll
        for (int m = 0; m < 4; ++m) {
#pragma unroll
          for (int n = 0; n < 4; ++n) acc[m][n] = __builtin_amdgcn_mfma_f32_16x16x32_bf16(Bf[n], At[m], acc[m][n], 0, 0, 0);
          if (m < 3) { At[2 * m + 2] = *(const bf16x8*)(abase + (2 * m + 2) * 2048); At[2 * m + 3] = *(const bf16x8*)(abase + (2 * m + 3) * 2048); }
          At[m] = *(const bf16x8*)(abase + m * 2048 + 1024);
          if (do_stage) G_STAGE1(cur ^ 1, skt, su, aoff, boff, m);
          __builtin_amdgcn_sched_barrier(0);
        }
#pragma unroll
        for (int n = 0; n < 4; ++n) {
#pragma unroll
          for (int m = 4; m < 8; ++m) {
            acc[m][n] = __builtin_amdgcn_mfma_f32_16x16x32_bf16(Bf[n], At[m], acc[m][n], 0, 0, 0);
            if (n == 3) At[m] = *(const bf16x8*)(abase + m * 2048 + 1024);
          }
          Bf[n] = *(const bf16x8*)(bbase + n * 2048 + 1024);
          __builtin_amdgcn_sched_barrier(0);
        }
#pragma unroll
        for (int n = 0; n < 4; ++n) {
#pragma unroll
          for (int m = 0; m < 8; ++m) acc[m][n] = __builtin_amdgcn_mfma_f32_16x16x32_bf16(Bf[n], At[m], acc[m][n], 0, 0, 0);
          __builtin_amdgcn_sched_barrier(0);
        }
      }
      asm volatile("s_waitcnt vmcnt(0)" ::: "memory");
      __syncthreads();
      ++gt;
    }
    {
      int lane_ = (int)__builtin_amdgcn_mbcnt_hi(~0u, __builtin_amdgcn_mbcnt_lo(~0u, 0u));
      asm volatile("" : "+v"(lane_));
      const int wr = wsg >> 2, wc = wsg & 3, fr = lane_ & 15, fq = lane_ >> 4;
      char* ob = shm + 2 * STAGE_B + wsg * 2048;
      const int wofs = fr * 128 + (fq & 1) * 8, wch = fq >> 1, wsw = fr & 7;
      const int r8 = lane_ >> 3, c8 = lane_ & 7;
      const int rofs = r8 * 128 + ((c8 ^ (r8 & 7)) << 4);
#pragma unroll
      for (int m = 0; m < 8; ++m) {
#pragma unroll
        for (int n = 0; n < 4; ++n) {
          const f32x4 v = ep.conv(cu.brow + wr * 128 + m * 16 + fr, cu.bcol + wc * 64 + n * 16 + fq * 4, acc[m][n]);
          uint2 o; o.x = pack2(v[0], v[1]); o.y = pack2(v[2], v[3]);
          *(uint2*)(ob + wofs + ((((n << 1) | wch) ^ wsw) << 4)) = o;
        }
#pragma unroll
        for (int hh = 0; hh < 2; ++hh) {
          const uint4 val = *(const uint4*)(ob + hh * 1024 + rofs);
          u16* dp = ep.dst(cu.brow + wr * 128 + m * 16 + hh * 8 + r8, cu.bcol + wc * 64 + c8 * 8);
          if (dp) *(uint4*)dp = val;
        }
        __builtin_amdgcn_sched_barrier(0);
      }
    }
    if (!has_next) break;
    u = un;
    cu = gemm_unit<RW1>(u, nN, nMx, xcd, lat_only, A0in, A2, ksplit_in, Kin, Bt, ldb);
  }
  }
#undef G_STAGE
#undef G_STAGE1
#undef G_OFFS
}

DI float tanh_fast(float x) { x = fminf(fmaxf(x, -15.f), 15.f); const float t = __expf(2.f * x); return (t - 1.f) / (t + 1.f); }
DI float decay_m1(float lw) {
  const float el = __expf(-fabsf(lw));
  const float ls = fminf(lw, 0.f) - __logf(1.f + el);
  const float e = __expf(ls - 0.5f);
  return __expf(-e) - 1.f;
}
struct EpBf16 {
  u16* base; int ld;
  DI f32x4 conv(int, int, f32x4 v) const { return v; }
  DI u16* dst(int row, int col) const { return base + (size_t)row * ld + col; }
};
struct EpRw1 {
  u16* big; u16* lr;
  DI f32x4 conv(int, int col, f32x4 v) const {
    const int cu = __builtin_amdgcn_readfirstlane(col >> 6);
    if (cu >= 48 && cu < 50) { v[0] = tanh_fast(v[0]); v[1] = tanh_fast(v[1]); v[2] = tanh_fast(v[2]); v[3] = tanh_fast(v[3]); }
    else if (cu >= 51 && cu < 53) { v[0] = sigmoidf_(v[0]); v[1] = sigmoidf_(v[1]); v[2] = sigmoidf_(v[2]); v[3] = sigmoidf_(v[3]); }
    return v;
  }
  DI u16* dst(int row, int col) const {
    if (col < 3072) return big + (size_t)(col >> 10) * ((size_t)R * D) + (size_t)row * D + (col & 1023);
    if (col < 3392) return lr + (size_t)row * K2 + (col - 3072);
    return nullptr;
  }
};
struct EpRw2 {
  u16* big; u16* gq; const float* w0; const float* a0;
  DI f32x4 conv(int, int col, f32x4 v) const {
    const int blk = __builtin_amdgcn_readfirstlane(col >> 10), cc = col & 1023;
    if (blk < 2) {
      const float4 ww = *(const float4*)(w0 + blk * D + cc);
      v[0] = decay_m1(v[0] + ww.x); v[1] = decay_m1(v[1] + ww.y); v[2] = decay_m1(v[2] + ww.z); v[3] = decay_m1(v[3] + ww.w);
    } else if (blk == 2) {
      const float4 ww = *(const float4*)(a0 + cc);
      v[0] = sigmoidf_(v[0] + ww.x); v[1] = sigmoidf_(v[1] + ww.y); v[2] = sigmoidf_(v[2] + ww.z); v[3] = sigmoidf_(v[3] + ww.w);
    }
    return v;
  }
  DI u16* dst(int row, int col) const {
    const int blk = col >> 10, cc = col & 1023;
    if (blk < 2) return big + (size_t)(4 + blk) * ((size_t)R * D) + (size_t)row * D + cc;
    if (blk == 2) return big + (size_t)3 * ((size_t)R * D) + (size_t)row * D + cc;
    return gq + (size_t)row * D + cc;
  }
};

__device__ __forceinline__ void ph_qkconv(const Ctx cx, CParams& p, int g) {
  const size_t total = (size_t)R * 128;
  for (size_t i = (size_t)cx.bid * NTHR + cx.tid; i < total; i += (size_t)gridDim.x * NTHR) {
    const int row = (int)(i >> 7), c0 = ((int)(i & 127)) * 8;
    int b, pos; rowinfo(g, row, b, pos);
    const bool hasp = (pos != 0 && pos != CTX), hasn = (pos != CTX - 1 && pos != TPS - 1);
    const u16* Z = p.BIG + (size_t)row * ZW + c0;
    float cur[8], pv[8], nx[8];
    unpack8(*(const uint4*)Z, cur);
    if (hasp) unpack8(*(const uint4*)(Z - ZW), pv); else { for (int e = 0; e < 8; ++e) pv[e] = 0.f; }
    if (hasn) unpack8(*(const uint4*)(Z + ZW), nx); else { for (int e = 0; e < 8; ++e) nx[e] = 0.f; }
    const float scale = (c0 < 512) ? 0.08838834764831845f : 1.f;
    float o[8];
#pragma unroll
    for (int e = 0; e < 8; ++e) {
      const int c = c0 + e;
      const float v = pv[e] * p.ev_conv_w[c] + cur[e] * p.ev_conv_w[D + c] + nx[e] * p.ev_conv_w[2 * D + c] + p.ev_conv_b[c];
      o[e] = siluf_(v) * scale;
    }
    *(uint4*)(p.QK + (size_t)row * D + c0) = pack8(o);
  }
}

__device__ __forceinline__ void mlstm_item(const Ctx cx, CParams& p, int item, char* smem) {
  const int tid = cx.tid, lane = tid & 63, w = tid >> 6, r = lane & 31, h = lane >> 5;
  const int bl = item >> 3, head = (item >> 1) & 3, dir = item & 1;
  const int base = bl * TPS;
  u16* sQ = (u16*)smem;
  u16* sK = sQ + 32 * 136;
  u16* sVT = sK + 32 * 136;
  u16* sKT = sVT + 128 * 40;
  float* sU = (float*)(sKT + 128 * 40);
  float* sM = sU + 32; float* sBc = sM + 32; float* sLast = sBc + 32;
  float* sN = sLast + 32;
  float* sRD = sN + 128;
  float* sWI = sRD + 128;
  const u16* Z = p.BIG;
  u16* Y = p.BIG + (size_t)R * ZW + (size_t)dir * R * 512;
  const float bgi = p.ev_b_gates[(2 * dir) * 4 + head], bgf = p.ev_b_gates[(2 * dir + 1) * 4 + head];
  f32x16 cacc[4];
#pragma unroll
  for (int a = 0; a < 4; ++a)
#pragma unroll
    for (int i = 0; i < 16; ++i) cacc[a][i] = 0.f;
  if (tid < 128) sN[tid] = 0.f;
  float m = 0.f;
  const bool act = tid < 256;
  const int lr = (tid >> 3) & 31, lc = tid & 7;
  uint4 q0, q1, k0, k1, v0, v1;
  u16 gzi = 0, gzf = 0;
#define ML_LOAD(p0_) do { if (act) { const int grow = scan_row(base, dir, (p0_) + lr); \
      q0 = *(const uint4*)(p.QK + (size_t)grow * D + head * 128 + lc * 8); \
      q1 = *(const uint4*)(p.QK + (size_t)grow * D + head * 128 + lc * 8 + 64); \
      k0 = *(const uint4*)(p.QK + (size_t)grow * D + 512 + head * 128 + lc * 8); \
      k1 = *(const uint4*)(p.QK + (size_t)grow * D + 512 + head * 128 + lc * 8 + 64); \
      v0 = *(const uint4*)(Z + (size_t)grow * ZW + 1024 + head * 128 + lc * 8); \
      v1 = *(const uint4*)(Z + (size_t)grow * ZW + 1024 + head * 128 + lc * 8 + 64); } \
    if (w == 0) { const int row_ = scan_row(base, dir, (p0_) + (lane & 31)); \
      gzi = Z[(size_t)row_ * ZW + 2048 + (2 * dir) * 4 + head]; gzf = Z[(size_t)row_ * ZW + 2048 + (2 * dir + 1) * 4 + head]; } } while (0)
  ML_LOAD(0);
  for (int ch = 0; ch < TPS / 32; ++ch) {
    const int p0 = ch * 32;
    __syncthreads();
    if (w == 0) {
      const int t = lane & 31;
      const float zi = bf2f(gzi) + bgi;
      const float zf = bf2f(gzf) + bgf;
      float bsum = logsigf_(zf);
      for (int o = 1; o < 32; o <<= 1) { const float v = __shfl_up(bsum, o); if (t >= o) bsum += v; }
      const float u = zi - bsum;
      float pm = u;
      for (int o = 1; o < 32; o <<= 1) { const float v = __shfl_up(pm, o); if (t >= o) pm = fmaxf(pm, v); }
      const float M = fmaxf(m, pm);
      if (lane < 32) { sU[t] = u; sM[t] = M; sBc[t] = bsum; if (t == 31) { sLast[0] = M; sLast[1] = bsum; } }
    }
    __syncthreads();
    const float Mlast = sLast[0], blast = sLast[1];
    if (act) {
      const float ws = __expf(sU[lr] - Mlast);
      *(uint4*)(sQ + lr * 136 + lc * 8) = q0; *(uint4*)(sQ + lr * 136 + lc * 8 + 64) = q1;
      *(uint4*)(sK + lr * 136 + lc * 8) = k0; *(uint4*)(sK + lr * 136 + lc * 8 + 64) = k1;
      float f[8];
      unpack8(k0, f);
#pragma unroll
      for (int e = 0; e < 8; ++e) sKT[(lc * 8 + e) * 40 + lr] = f2bf(f[e] * ws);
      unpack8(k1, f);
#pragma unroll
      for (int e = 0; e < 8; ++e) sKT[(lc * 8 + 64 + e) * 40 + lr] = f2bf(f[e] * ws);
      const u16* pv0 = (const u16*)&v0; const u16* pv1 = (const u16*)&v1;
#pragma unroll
      for (int e = 0; e < 8; ++e) { sVT[(lc * 8 + e) * 40 + lr] = pv0[e]; sVT[(lc * 8 + 64 + e) * 40 + lr] = pv1[e]; }
    }
    if (ch + 1 < TPS / 32) ML_LOAD(p0 + 32);
    __syncthreads();
    f32x16 st;
#pragma unroll
    for (int i = 0; i < 16; ++i) st[i] = 0.f;
    if (act) {
#pragma unroll
    for (int ks = 0; ks < 8; ++ks) {
      const bf16x8 a = *(const bf16x8*)(sK + r * 136 + 16 * ks + 8 * h);
      const bf16x8 b = *(const bf16x8*)(sQ + r * 136 + 16 * ks + 8 * h);
      st = MFMA(a, b, st);
    }
    const float Mt = sM[r];
    float dsum = 0.f;
#pragma unroll
    for (int i = 0; i < 16; ++i) {
      const int s = crow(i, h);
      const float pv = (s <= r) ? st[i] * __expf(sU[s] - Mt) : 0.f;
      st[i] = pv; dsum += pv;
    }
    dsum += __shfl_xor(dsum, 32);
    float qn = 0.f;
#pragma unroll
    for (int d8 = 0; d8 < 8; ++d8) {
      float qf[8]; unpack8(*(const uint4*)(sQ + r * 136 + 64 * h + 8 * d8), qf);
#pragma unroll
      for (int e = 0; e < 8; ++e) qn += qf[e] * sN[64 * h + 8 * d8 + e];
    }
    qn += __shfl_xor(qn, 32);
    const float wi = __expf(m - Mt);
    const float den = dsum + wi * qn;
    const float dn = fmaxf(fabsf(den), __expf(-(sBc[r] + Mt)));
    if (h == 0) { sRD[w * 32 + r] = 1.f / dn; sWI[w * 32 + r] = wi; }
    }
    __syncthreads();
    const float wp = __expf(m - Mlast);
    if (act) {
    f32x16 o;
#pragma unroll
    for (int i = 0; i < 16; ++i) o[i] = 0.f;
#pragma unroll
    for (int mb = 0; mb < 4; ++mb)
#pragma unroll
      for (int s2 = 0; s2 < 2; ++s2) {
        const bf16x8 cb = pack_step(cacc[mb], s2);
        const u16* qp = sQ + r * 136 + 32 * mb + 16 * s2 + 4 * h;
        const bf16x8 a = cat4(*(const s16x4*)qp, *(const s16x4*)(qp + 8));
        o = MFMA(a, cb, o);
      }
#pragma unroll
    for (int i = 0; i < 16; ++i) o[i] *= sWI[w * 32 + crow(i, h)];
#pragma unroll
    for (int s2 = 0; s2 < 2; ++s2) {
      const bf16x8 a = pack_step(st, s2);
      const u16* vp = sVT + (32 * w + r) * 40 + 16 * s2 + 4 * h;
      const bf16x8 b = cat4(*(const s16x4*)vp, *(const s16x4*)(vp + 8));
      o = MFMA(a, b, o);
    }
#pragma unroll
    for (int i = 0; i < 16; ++i) {
      const int t = crow(i, h);
      const int row = scan_row(base, dir, p0 + t);
      Y[(size_t)row * 512 + head * 128 + 32 * w + r] = f2bf(o[i] * sRD[w * 32 + t]);
    }
#pragma unroll
    for (int mb = 0; mb < 4; ++mb) {
#pragma unroll
      for (int i = 0; i < 16; ++i) cacc[mb][i] *= wp;
#pragma unroll
      for (int s2 = 0; s2 < 2; ++s2) {
        const bf16x8 a = *(const bf16x8*)(sKT + (32 * mb + r) * 40 + 16 * s2 + 8 * h);
        const bf16x8 b = *(const bf16x8*)(sVT + (32 * w + r) * 40 + 16 * s2 + 8 * h);
        cacc[mb] = MFMA(a, b, cacc[mb]);
      }
    }
    }
    __syncthreads();
    if (tid < 128) {
      float s = 0.f;
#pragma unroll
      for (int e = 0; e < 32; ++e) s += bf2f(sKT[tid * 40 + e]);
      sN[tid] = wp * sN[tid] + s;
    }
    m = blast + Mlast;
  }
#undef ML_LOAD
}

__device__ __forceinline__ void gla_item(const Ctx cx, CParams& p, int item, char* smem) {
  const int tid = cx.tid, lane = tid & 63, w = tid >> 6, r = lane & 31, h = lane >> 5;
  const int bl = item >> 3, head = (item >> 1) & 3, dir = item & 1;
  const int base = bl * TPS;
  u16* sQ = (u16*)smem;
  u16* sK = sQ + 32 * 72;
  u16* sKT = sK + 32 * 72;
  u16* sVT = sKT + 64 * 40;
  float* sLa = (float*)(sVT + 128 * 40);
  float* sW2 = sLa + 32 * 64;
  float* sBi = sW2 + 16 * 64;
  const u16* Z = p.BIG;
  u16* Y = p.BIG + (size_t)R * ZW + (size_t)(2 + dir) * R * 512;
  for (int i = tid; i < 16 * 64; i += NTHR) sW2[i] = p.ev_gla_w2[((size_t)dir * 16 + (i >> 6)) * 256 + head * 64 + (i & 63)];
  if (tid < 64) sBi[tid] = p.ev_gla_b[dir * 256 + head * 64 + tid];
  f32x16 sacc[2];
#pragma unroll
  for (int a = 0; a < 2; ++a)
#pragma unroll
    for (int i = 0; i < 16; ++i) sacc[a][i] = 0.f;
  const bool act = tid < 256;
  const int lr = (tid >> 3) & 31, lc = tid & 7;
  uint4 gq, gk, v0, v1, gl0, gl1;
#define GLA_LOAD(p0_) do { if (act) { const int grow = scan_row(base, dir, (p0_) + lr); const u16* zr = Z + (size_t)grow * ZW; \
      gq = *(const uint4*)(zr + 2064 + head * 64 + lc * 8); gk = *(const uint4*)(zr + 2320 + head * 64 + lc * 8); \
      v0 = *(const uint4*)(zr + 2576 + head * 128 + lc * 8); v1 = *(const uint4*)(zr + 2576 + head * 128 + lc * 8 + 64); \
      gl0 = *(const uint4*)(zr + 3600 + dir * 16); gl1 = *(const uint4*)(zr + 3600 + dir * 16 + 8); } } while (0)
  GLA_LOAD(0);
  for (int ch = 0; ch < TPS / 32; ++ch) {
    const int p0 = ch * 32;
    __syncthreads();
    if (act) {
      float gl[16];
      unpack8(gl0, gl); unpack8(gl1, gl + 8);
#pragma unroll
      for (int e = 0; e < 8; ++e) {
        const int c = lc * 8 + e;
        float xv = sBi[c];
#pragma unroll
        for (int q = 0; q < 16; ++q) xv += gl[q] * sW2[q * 64 + c];
        sLa[lr * 64 + c] = logsigf_(xv) * (1.f / 16.f);
      }
    }
    __syncthreads();
    if (tid < 64) {
      float lv[32];
#pragma unroll
      for (int t = 0; t < 32; ++t) lv[t] = sLa[t * 64 + tid];
      float b = 0.f;
#pragma unroll
      for (int t = 0; t < 32; ++t) { b += lv[t]; sLa[t * 64 + tid] = b; }
    }
    __syncthreads();
    if (act) {
      float qf[8], kf[8], o[8];
      unpack8(gq, qf); unpack8(gk, kf);
#pragma unroll
      for (int e = 0; e < 8; ++e) { const float bb = sLa[lr * 64 + lc * 8 + e]; qf[e] *= 0.125f * __expf(bb); kf[e] *= __expf(-bb); }
      *(uint4*)(sQ + lr * 72 + lc * 8) = pack8(qf);
      *(uint4*)(sK + lr * 72 + lc * 8) = pack8(kf);
#pragma unroll
      for (int e = 0; e < 8; ++e) sKT[(lc * 8 + e) * 40 + lr] = f2bf(kf[e]);
      (void)o;
      const u16* pv0 = (const u16*)&v0; const u16* pv1 = (const u16*)&v1;
#pragma unroll
      for (int e = 0; e < 8; ++e) { sVT[(lc * 8 + e) * 40 + lr] = pv0[e]; sVT[(lc * 8 + 64 + e) * 40 + lr] = pv1[e]; }
    }
    if (ch + 1 < TPS / 32) GLA_LOAD(p0 + 32);
    __syncthreads();
    if (act) {
    f32x16 st;
#pragma unroll
    for (int i = 0; i < 16; ++i) st[i] = 0.f;
#pragma unroll
    for (int ks = 0; ks < 4; ++ks) {
      const bf16x8 a = *(const bf16x8*)(sK + r * 72 + 16 * ks + 8 * h);
      const bf16x8 b = *(const bf16x8*)(sQ + r * 72 + 16 * ks + 8 * h);
      st = MFMA(a, b, st);
    }
#pragma unroll
    for (int i = 0; i < 16; ++i) { if (crow(i, h) > r) st[i] = 0.f; }
    f32x16 o;
#pragma unroll
    for (int i = 0; i < 16; ++i) o[i] = 0.f;
#pragma unroll
    for (int mb = 0; mb < 2; ++mb)
#pragma unroll
      for (int s2 = 0; s2 < 2; ++s2) {
        const bf16x8 cb = pack_step(sacc[mb], s2);
        const u16* qp = sQ + r * 72 + 32 * mb + 16 * s2 + 4 * h;
        const bf16x8 a = cat4(*(const s16x4*)qp, *(const s16x4*)(qp + 8));
        o = MFMA(a, cb, o);
      }
#pragma unroll
    for (int s2 = 0; s2 < 2; ++s2) {
      const bf16x8 a = pack_step(st, s2);
      const u16* vp = sVT + (32 * w + r) * 40 + 16 * s2 + 4 * h;
      const bf16x8 b = cat4(*(const s16x4*)vp, *(const s16x4*)(vp + 8));
      o = MFMA(a, b, o);
    }
#pragma unroll
    for (int i = 0; i < 16; ++i) {
      const int row = scan_row(base, dir, p0 + crow(i, h));
      Y[(size_t)row * 512 + head * 128 + 32 * w + r] = f2bf(o[i]);
    }
#pragma unroll
    for (int mb = 0; mb < 2; ++mb) {
#pragma unroll
      for (int s2 = 0; s2 < 2; ++s2) {
        const bf16x8 a = *(const bf16x8*)(sKT + (32 * mb + r) * 40 + 16 * s2 + 8 * h);
        const bf16x8 b = *(const bf16x8*)(sVT + (32 * w + r) * 40 + 16 * s2 + 8 * h);
        sacc[mb] = MFMA(a, b, sacc[mb]);
      }
#pragma unroll
      for (int i = 0; i < 16; ++i) sacc[mb][i] *= __expf(sLa[31 * 64 + 32 * mb + crow(i, h)]);
    }
    }
  }
#undef GLA_LOAD
}

__device__ __forceinline__ void ph_scan0(const Ctx cx, CParams& p, char* smem) {
  for (int it = cx.bid; it < 2 * SPG * 8; it += gridDim.x) {
    __syncthreads();
    if (it < SPG * 8) mlstm_item(cx, p, it, smem); else gla_item(cx, p, it - SPG * 8, smem);
  }
}

__device__ __forceinline__ void ph_evout(const Ctx cx, CParams& p, int g) {
  const int lane = cx.tid & 63;
  const int gw = cx.bid * NWV + (cx.tid >> 6), nw = gridDim.x * NWV;
  const u16* Yb = p.BIG + (size_t)R * ZW;
  for (int row = gw; row < R; row += nw) {
    const int c0 = lane * 16;
    const int part = c0 >> 9, cc = c0 & 511;
    const u16* yf = Yb + ((size_t)(2 * part) * R + row) * 512 + cc;
    const u16* yb = Yb + ((size_t)(2 * part + 1) * R + row) * 512 + cc;
    float a[16], b[16];
    unpack8(*(const uint4*)yf, a); unpack8(*(const uint4*)(yf + 8), a + 8);
    unpack8(*(const uint4*)yb, b); unpack8(*(const uint4*)(yb + 8), b + 8);
    float ss = 0.f;
#pragma unroll
    for (int e = 0; e < 16; ++e) { a[e] += b[e]; ss += a[e] * a[e]; }
    ss += __shfl_xor(ss, 1); ss += __shfl_xor(ss, 2); ss += __shfl_xor(ss, 4);
    const float rstd = rsqrtf(ss * (1.f / 128.f) + 1e-6f);
    const u16* zg = p.BIG + (size_t)row * ZW + (part ? 3088 : 1536) + cc;
    float gt[16];
    unpack8(*(const uint4*)zg, gt); unpack8(*(const uint4*)(zg + 8), gt + 8);
#pragma unroll
    for (int e = 0; e < 16; ++e) {
      const float gv = part ? siluf_(gt[e]) : sigmoidf_(gt[e]);
      a[e] = a[e] * rstd * p.ev_head_g[c0 + e] * gv;
    }
    *(uint4*)(p.H + (size_t)row * D + c0) = pack8(a);
    *(uint4*)(p.H + (size_t)row * D + c0 + 8) = pack8(a + 8);
  }
}

__device__ __forceinline__ void ph_ffnact(const Ctx cx, CParams& p, int g, int layer, bool lat_only) {
  const float* cw = p.ffn_conv_w + (size_t)layer * 9 * DFF;
  const float* cb = p.ffn_conv_b + (size_t)layer * DFF;
  constexpr int SEG = 16, NSEG = TPS / SEG;
  const int total = SPG * NSEG * 352;
  for (int it = cx.bid * NTHR + cx.tid; it < total; it += gridDim.x * NTHR) {
    const int cg = it % 352, sg = (it / 352) % NSEG, s = it / (352 * NSEG);
    const int f0 = cg * 8;
    const int pos0 = sg * SEG;
    const bool isctx = pos0 < CTX;
    if (lat_only && isctx) continue;
    bool has_up = false, has_dn = false, has_l, has_r;
    if (isctx) { has_l = pos0 > 0; has_r = pos0 + SEG < CTX; }
    else { const int lp = pos0 - CTX, gr = lp >> 6, gc0 = lp & 63; has_up = gr > 0; has_dn = gr < 31; has_l = gc0 > 0; has_r = gc0 + SEG < 64; }
    float w[3][3][8], bias[8];
#pragma unroll
    for (int dh = 0; dh < 3; ++dh)
#pragma unroll
      for (int dw = 0; dw < 3; ++dw) {
        const float4 w0 = *(const float4*)(cw + (dh * 3 + dw) * DFF + f0), w1 = *(const float4*)(cw + (dh * 3 + dw) * DFF + f0 + 4);
        w[dh][dw][0] = w0.x; w[dh][dw][1] = w0.y; w[dh][dw][2] = w0.z; w[dh][dw][3] = w0.w;
        w[dh][dw][4] = w1.x; w[dh][dw][5] = w1.y; w[dh][dw][6] = w1.z; w[dh][dw][7] = w1.w;
      }
    { const float4 b0 = *(const float4*)(cb + f0), b1 = *(const float4*)(cb + f0 + 4);
      bias[0] = b0.x; bias[1] = b0.y; bias[2] = b0.z; bias[3] = b0.w; bias[4] = b1.x; bias[5] = b1.y; bias[6] = b1.z; bias[7] = b1.w; }
    u16* gu = p.BIG + (size_t)(s * TPS + pos0) * GUW + f0;
    float c0[3][8], c1[3][8], c2[3][8];
    uint4 nx[3];
#define FA_LD1(d, tok_, ok_) do { const bool o_ = (ok_); const uint4 r_ = *(const uint4*)(gu + (ptrdiff_t)(o_ ? (tok_) : 0) * GUW); \
      d.x = o_ ? r_.x : 0u; d.y = o_ ? r_.y : 0u; d.z = o_ ? r_.z : 0u; d.w = o_ ? r_.w : 0u; } while (0)
#define FA_LOAD(dst, tok, ok) do { FA_LD1(dst[1], (tok), (ok)); FA_LD1(dst[0], (tok) - 64, (ok) && has_up); FA_LD1(dst[2], (tok) + 64, (ok) && has_dn); } while (0)
    FA_LOAD(nx, -1, has_l);
    unpack8(nx[0], c0[0]); unpack8(nx[1], c0[1]); unpack8(nx[2], c0[2]);
    FA_LOAD(nx, 0, true);
    unpack8(nx[0], c1[0]); unpack8(nx[1], c1[1]); unpack8(nx[2], c1[2]);
    FA_LOAD(nx, 1, true);
#pragma unroll 2
    for (int t = 0; t < SEG; ++t) {
      unpack8(nx[0], c2[0]); unpack8(nx[1], c2[1]); unpack8(nx[2], c2[2]);
      const uint4 upraw = *(const uint4*)(gu + (ptrdiff_t)t * GUW + DFF);
      { const int tn = t + 2; const bool ok = (tn < SEG) || (tn == SEG && has_r); FA_LOAD(nx, tn, ok); }
      float acc[8];
#pragma unroll
      for (int e = 0; e < 8; ++e) {
        float a = bias[e];
#pragma unroll
        for (int dh = 0; dh < 3; ++dh) a += c0[dh][e] * w[dh][0][e] + c1[dh][e] * w[dh][1][e] + c2[dh][e] * w[dh][2][e];
        acc[e] = a;
      }
      float up[8]; unpack8(upraw, up);
#pragma unroll
      for (int e = 0; e < 8; ++e) {
        const float xg = acc[e];
        const float th = tanh_fast(0.7978845608028654f * (xg + 0.044715f * xg * xg * xg));
        up[e] *= 0.5f * xg * (1.f + th);
      }
      *(uint4*)(gu + (ptrdiff_t)t * GUW + DFF) = pack8(up);
#pragma unroll
      for (int dh = 0; dh < 3; ++dh)
#pragma unroll
        for (int e = 0; e < 8; ++e) { c0[dh][e] = c1[dh][e]; c1[dh][e] = c2[dh][e]; }
    }
#undef FA_LOAD
#undef FA_LD1
  }
}

__device__ __forceinline__ void ph_xx(const Ctx cx, CParams& p, int g) {
  const size_t total = (size_t)R * 128;
  for (size_t i = (size_t)cx.bid * NTHR + cx.tid; i < total; i += (size_t)gridDim.x * NTHR) {
    const int row = (int)(i >> 7), c0 = ((int)(i & 127)) * 8;
    int b, pos; rowinfo(g, row, b, pos);
    const int q = c0 >> 8;
    int off = 0; bool ok;
    if (pos < CTX) {
      if ((q & 1) == 0) { off = -1; ok = pos > 0; } else { off = 1; ok = pos < CTX - 1; }
    } else {
      const int lp = pos - CTX, gr = lp >> 6, gc = lp & 63;
      if (q == 0) { off = -1; ok = gc > 0; }
      else if (q == 1) { off = 1; ok = gc < 63; }
      else if (q == 2) { off = -64; ok = gr > 0; }
      else { off = 64; ok = gr < 31; }
    }
    float hc[8], hs[8];
    unpack8(*(const uint4*)(p.H + (size_t)row * D + c0), hc);
    if (ok) unpack8(*(const uint4*)(p.H + (size_t)(row + off) * D + c0), hs); else { for (int e = 0; e < 8; ++e) hs[e] = 0.f; }
#pragma unroll
    for (int e = 0; e < 8; ++e) hs[e] -= hc[e];
    *(uint4*)(p.QK + (size_t)row * D + c0) = pack8(hs);
    float m_[8];
    const size_t RS_ = (size_t)R * D;
#pragma unroll
    for (int e = 0; e < 8; ++e) m_[e] = hc[e] + hs[e] * p.rw_mu[0 * D + c0 + e];
    *(uint4*)(p.BIG + 3 * RS_ + (size_t)row * D + c0) = pack8(m_);
#pragma unroll
    for (int e = 0; e < 8; ++e) m_[e] = hc[e] + hs[e] * p.rw_mu[2 * D + c0 + e];
    *(uint4*)(p.BIG + 4 * RS_ + (size_t)row * D + c0) = pack8(m_);
#pragma unroll
    for (int e = 0; e < 8; ++e) m_[e] = hc[e] + hs[e] * p.rw_mu[3 * D + c0 + e];
    *(uint4*)(p.BIG + 5 * RS_ + (size_t)row * D + c0) = pack8(m_);
  }
}

__device__ __forceinline__ void ph_rwprep(const Ctx cx, CParams& p) {
  const int lane = cx.tid & 63;
  const int gw = cx.bid * NWV + (cx.tid >> 6), nw = gridDim.x * NWV;
  const size_t RS = (size_t)R * D;
  float* CS = (float*)p.LR;
  for (int row = gw; row < R; row += nw) {
    const int c0 = lane * 16;
    const size_t o = (size_t)row * D + c0;
    float rr[16], kk[16], aa[16], km[16], ka[16];
    unpack8(*(const uint4*)(p.BIG + o), rr); unpack8(*(const uint4*)(p.BIG + o + 8), rr + 8);
    unpack8(*(const uint4*)(p.BIG + RS + o), kk); unpack8(*(const uint4*)(p.BIG + RS + o + 8), kk + 8);
    unpack8(*(const uint4*)(p.BIG + 3 * RS + o), aa); unpack8(*(const uint4*)(p.BIG + 3 * RS + o + 8), aa + 8);
    float ss = 0.f;
#pragma unroll
    for (int e = 0; e < 16; ++e) {
      km[e] = bf2f(f2bf(kk[e] * (1.f + (aa[e] - 1.f) * p.rw_kvec[D + c0 + e])));
      kk[e] *= p.rw_kvec[c0 + e]; ss += kk[e] * kk[e];
    }
    ss += __shfl_xor(ss, 1); ss += __shfl_xor(ss, 2);
    const float inv = 1.f / fmaxf(sqrtf(ss), 1e-12f);
    float c1 = 0.f, c2 = 0.f;
#pragma unroll
    for (int e = 0; e < 16; ++e) {
      kk[e] *= inv; ka[e] = bf2f(f2bf(kk[e] * aa[e]));
      c1 += ka[e] * rr[e]; c2 += km[e] * rr[e];
    }
    c1 += __shfl_xor(c1, 1); c1 += __shfl_xor(c1, 2);
    c2 += __shfl_xor(c2, 1); c2 += __shfl_xor(c2, 2);
    *(uint4*)(p.BIG + RS + o) = pack8(kk); *(uint4*)(p.BIG + RS + o + 8) = pack8(kk + 8);
    *(uint4*)(p.BIG + 3 * RS + o) = pack8(ka); *(uint4*)(p.BIG + 3 * RS + o + 8) = pack8(ka + 8);
    *(uint4*)(p.H + o) = pack8(km); *(uint4*)(p.H + o + 8) = pack8(km + 8);
    if ((lane & 3) == 0) { float2 c; c.x = c1; c.y = c2; *(float2*)(CS + (size_t)row * 32 + (lane >> 2) * 2) = c; }
  }
}

__device__ __forceinline__ void ph_rwscan(const Ctx cx, CParams& p) {
  const int lane = cx.tid & 63, w = cx.tid >> 6;
  if (w >= 4) return;
  const int vq = lane >> 3, kq = lane & 7, hf = w & 1;
  const size_t RS = (size_t)R * D;
  const u16* Rb = p.BIG; const u16* KKb = p.BIG + RS; const u16* Vb = p.BIG + 2 * RS; const u16* KAb = p.BIG + 3 * RS; const u16* KMb = p.H;
  const float* CS = (const float*)p.LR;
  const int nblk = (SPG * 16 * 2) / 2;
  for (int bi = cx.bid; bi < nblk; bi += gridDim.x) {
    const int item = bi * 2 + (w >> 1);
    const int bl = item >> 5, head = (item >> 1) & 15, dir = item & 1;
    const u16* Wb = p.BIG + (size_t)(4 + dir) * RS;
    u16* Yb = (u16*)p.YO + (size_t)dir * RS;
    const int base = bl * TPS;
    const int colk = head * 64 + kq * 8, colv = head * 64 + hf * 32 + vq * 4;
    float S[4][8];
#pragma unroll
    for (int i = 0; i < 4; ++i)
#pragma unroll
      for (int e = 0; e < 8; ++e) S[i][e] = 0.f;
    char* dummy = (char*)p.LR + (size_t)R * 128 + (cx.tid & 511) * 8;
    constexpr int PF = 4;
    uint4 qr[PF], qkk[PF], qka[PF], qkm[PF], qw[PF]; uint2 qv[PF]; float2 qcs[PF]; int qrow[PF];
#define RW_LOAD(j, ps_) do { const int row_ = scan_row(base, dir, (ps_)); qrow[j] = row_; \
      const unsigned ok_ = (unsigned)(row_ * D + colk) * 2u, ov_ = (unsigned)(row_ * D + colv) * 2u, oc_ = (unsigned)(row_ * 32 + head * 2) * 4u; \
      qr[j] = *(const uint4*)((const char*)Rb + ok_); qkk[j] = *(const uint4*)((const char*)KKb + ok_); \
      qka[j] = *(const uint4*)((const char*)KAb + ok_); qkm[j] = *(const uint4*)((const char*)KMb + ok_); \
      qw[j] = *(const uint4*)((const char*)Wb + ok_); qv[j] = *(const uint2*)((const char*)Vb + ov_); \
      qcs[j] = *(const float2*)((const char*)CS + oc_); } while (0)
#pragma unroll
    for (int j = 0; j < PF; ++j) RW_LOAD(j, j);
    for (int ps0 = 0; ps0 < TPS; ps0 += PF) {
#pragma unroll
    for (int j = 0; j < PF; ++j) {
      const uint4 cr_ = qr[j], ckk = qkk[j], cka = qka[j], ckm = qkm[j], cw = qw[j]; const uint2 cv = qv[j]; const float2 cs = qcs[j];
      const int crow_ = qrow[j];
      { const int pn_ = ps0 + PF + j; RW_LOAD(j, pn_ < TPS ? pn_ : TPS - 1); }
      float wr[8], kk[8], wm1[8], vv[4], kka[8], km[8];
      unpack8(cr_, wr); unpack8(ckk, kk); unpack8(cka, kka); unpack8(ckm, km); unpack8(cw, wm1);
      vv[0] = lo16(cv.x); vv[1] = hi16(cv.x); vv[2] = lo16(cv.y); vv[3] = hi16(cv.y);
#pragma unroll
      for (int e = 0; e < 8; ++e) wr[e] += wr[e] * wm1[e];
      float sa[4], yo[4];
#pragma unroll
      for (int i = 0; i < 4; ++i) {
        float s = 0.f, t = 0.f;
#pragma unroll
        for (int e = 0; e < 8; ++e) { s += S[i][e] * kk[e]; t += S[i][e] * wr[e]; }
        sa[i] = s; yo[i] = t;
      }
#pragma unroll
      for (int i = 0; i < 4; ++i) { sa[i] = -red8(sa[i]); yo[i] = red8(yo[i]); }
#pragma unroll
      for (int i = 0; i < 4; ++i) {
#pragma unroll
        for (int e = 0; e < 8; ++e) {
          float t = S[i][e] + S[i][e] * wm1[e];
          t += sa[i] * kka[e];
          t += vv[i] * km[e];
          S[i][e] = t;
        }
        yo[i] += sa[i] * cs.x + vv[i] * cs.y;
      }
      { uint2 o; o.x = pack2(yo[0], yo[1]); o.y = pack2(yo[2], yo[3]);
        char* dst_ = (kq == 0) ? (char*)Yb + (unsigned)(crow_ * D + colv) * 2u : dummy;
        *(uint2*)dst_ = o; }
    }
    }
#undef RW_LOAD
  }
}

__device__ __forceinline__ void ph_rwout(const Ctx cx, CParams& p, int g) {
  const int lane = cx.tid & 63;
  const int gw = cx.bid * NWV + (cx.tid >> 6), nw = gridDim.x * NWV;
  const size_t RS = (size_t)R * D;
  for (int row = gw; row < R; row += nw) {
    int b, pos; rowinfo(g, row, b, pos);
    if (pos < CTX) continue;
    const int c0 = lane * 16;
    const size_t o = (size_t)row * D + c0;
    float yf[16], yb[16], rr[16], kk[16], vv[16], gg[16];
    const u16* Yy = (const u16*)p.YO;
    unpack8(*(const uint4*)(Yy + o), yf); unpack8(*(const uint4*)(Yy + o + 8), yf + 8);
    unpack8(*(const uint4*)(Yy + RS + o), yb); unpack8(*(const uint4*)(Yy + RS + o + 8), yb + 8);
    unpack8(*(const uint4*)(p.BIG + o), rr); unpack8(*(const uint4*)(p.BIG + o + 8), rr + 8);
    unpack8(*(const uint4*)(p.H + o), kk); unpack8(*(const uint4*)(p.H + o + 8), kk + 8);
    unpack8(*(const uint4*)(p.BIG + 2 * RS + o), vv); unpack8(*(const uint4*)(p.BIG + 2 * RS + o + 8), vv + 8);
    unpack8(*(const uint4*)(p.QK + o), gg); unpack8(*(const uint4*)(p.QK + o + 8), gg + 8);
    float s1 = 0.f, bon = 0.f;
#pragma unroll
    for (int e = 0; e < 16; ++e) {
      yf[e] += yb[e]; s1 += yf[e];
      bon += rr[e] * kk[e] * p.rw_kvec[2 * D + c0 + e];
    }
    s1 += __shfl_xor(s1, 1); s1 += __shfl_xor(s1, 2);
    bon += __shfl_xor(bon, 1); bon += __shfl_xor(bon, 2);
    const float mu = s1 * (1.f / 64.f);
    float s2 = 0.f;
#pragma unroll
    for (int e = 0; e < 16; ++e) { const float d = yf[e] - mu; s2 += d * d; }
    s2 += __shfl_xor(s2, 1); s2 += __shfl_xor(s2, 2);
    const float rstd = rsqrtf(s2 * (1.f / 64.f) + 64e-5f);
#pragma unroll
    for (int e = 0; e < 16; ++e) {
      const float yn = (yf[e] - mu) * rstd * p.rw_lnx[c0 + e] + p.rw_lnx[D + c0 + e];
      yf[e] = (yn + bon * vv[e]) * gg[e];
    }
    *(uint4*)(p.H + o) = pack8(yf);
    *(uint4*)(p.H + o + 8) = pack8(yf + 8);
  }
}

#define XB_TMO      128
#define XB_XCNT(j)  (256  + 64 * (j))
#define XB_XSUB(j)  (1280 + 64 * (j))
#define XB_XGEN(j)  (2304 + 64 * (j))
#define XB_TOP      3328
#define XB_TOPGEN   3392
#define XCD_BAR_WORDS 3456
#define XB_SPIN_CAP (1u << 20)
#define LAS __attribute__((address_space(3)))
DI unsigned xb_ld(unsigned* p)              { return __hip_atomic_load(p, __ATOMIC_RELAXED, __HIP_MEMORY_SCOPE_AGENT); }
DI unsigned xb_add(unsigned* p, unsigned v) { return __hip_atomic_fetch_add(p, v, __ATOMIC_RELAXED, __HIP_MEMORY_SCOPE_AGENT); }
DI unsigned xb_xcc_id() { return (unsigned)__builtin_amdgcn_s_getreg((3 << 11) | 20) & 0xFu; }
#define XB_SPIN(cond, bar) do { unsigned _sp = 0; while (cond) { __builtin_amdgcn_s_sleep(1); \
    if ((++_sp & 255u) == 0u) { if (xb_ld(&(bar)[XB_TMO])) break; if (_sp > XB_SPIN_CAP) { atomicAdd(&(bar)[XB_TMO], 1u); break; } } } } while (0)
struct XcdBarrier { unsigned* bar; unsigned x; volatile LAS unsigned* st; };
DI XcdBarrier xcd_barrier_post(unsigned* bar, volatile LAS unsigned* st) {
  XcdBarrier b; b.bar = bar; b.x = xb_xcc_id(); b.st = st;
  if (threadIdx.x == 0) (void)xb_add(&bar[XB_XCNT(b.x)], 1u);
  return b;
}
DI void xcd_barrier_complete(unsigned* bar, unsigned x, unsigned& nloc, unsigned& nx) {
  const unsigned G = gridDim.x * gridDim.y * gridDim.z;
  unsigned sum, cnt, mine, sp = 0u;
  for (;;) {
    sum = 0u; cnt = 0u; mine = 0u;
#pragma unroll
    for (unsigned j = 0; j < 16; ++j) { const unsigned c = xb_ld(&bar[XB_XCNT(j)]); sum += c; cnt += (c > 0u) ? 1u : 0u; mine = (j == x) ? c : mine; }
    if (sum == G) break;
    __builtin_amdgcn_s_sleep(1);
    if ((++sp & 255u) == 0u) { if (xb_ld(&bar[XB_TMO])) break; if (sp > XB_SPIN_CAP) { atomicAdd(&bar[XB_TMO], 1u); break; } }
  }
  nloc = mine > 0u ? mine : 1u; nx = cnt > 0u ? cnt : 1u;
}
DI void xcd_barrier(const XcdBarrier& b) {
  asm volatile("s_waitcnt vmcnt(0)" ::: "memory");
  __syncthreads();
  if (threadIdx.x == 0) {
    unsigned* bar = b.bar;
    __builtin_amdgcn_s_waitcnt(0);
    unsigned nloc = b.st[0], nx = b.st[1];
    if (nloc == 0u) { xcd_barrier_complete(bar, b.x, nloc, nx); b.st[0] = nloc; b.st[1] = nx; }
    const unsigned old = xb_add(&bar[XB_XSUB(b.x)], 1u);
    const unsigned gen = old / nloc;
    if (old + 1u == (gen + 1u) * nloc) {
      __builtin_amdgcn_fence(__ATOMIC_RELEASE, "agent");
      asm volatile("s_waitcnt vmcnt(0)" ::: "memory");
      const unsigned og = xb_add(&bar[XB_TOP], 1u);
      const unsigned tg = og / nx;
      if (og + 1u == (tg + 1u) * nx) xb_add(&bar[XB_TOPGEN], 1u);
      else XB_SPIN(xb_ld(&bar[XB_TOPGEN]) == tg, bar);
      __builtin_amdgcn_fence(__ATOMIC_ACQUIRE, "agent");
      xb_add(&bar[XB_XGEN(b.x)], 1u);
      asm volatile("s_waitcnt vmcnt(0)" ::: "memory");
    } else {
      XB_SPIN(xb_ld(&bar[XB_XGEN(b.x)]) == gen, bar);
      __builtin_amdgcn_fence(__ATOMIC_ACQUIRE, "agent");
      asm volatile("s_waitcnt vmcnt(0)" ::: "memory");
    }
  }
  __syncthreads();
}

__global__ void __launch_bounds__(NTHR) fwd_megakernel(Params p_arg) {
  cg::grid_group grid = cg::this_grid();
  __shared__ __attribute__((aligned(1024))) char smem[2 * STAGE_B + 16384];
  const size_t RS = (size_t)R * D;
  (void)RS;
  __shared__ uint4 xb_words;
  if (threadIdx.x == 0) xb_words = make_uint4(0u, 0u, 0u, 0u);
  __syncthreads();
  const XcdBarrier xb = xcd_barrier_post(((CParams*)__builtin_amdgcn_kernarg_segment_ptr())->bar, (volatile LAS unsigned*)&xb_words);
  {
    Ctx cx; cx.tid = threadIdx.x; cx.bid = blockIdx.x;
    CParams* pp = (CParams*)__builtin_amdgcn_kernarg_segment_ptr();
    ph_prologue(cx, *pp, (float*)smem);
  }
  const int wave_s = __builtin_amdgcn_readfirstlane((int)threadIdx.x >> 6);
  grid.sync();
#pragma nounroll
  for (int it2 = 0; it2 < NG * NPH * 2; ++it2) {
    const int it = it2 >> 1;
    const int g = it / NPH, ph = it - g * NPH;
    if (it2 & 1) continue;
    const unsigned long long tp0 = PROBE_MASK ? wall_clock64() : 0ull;
    Ctx cx;
    {
      int t_ = (wave_s << 6) | (int)__builtin_amdgcn_mbcnt_hi(~0u, __builtin_amdgcn_mbcnt_lo(~0u, 0u));
      int b_ = blockIdx.x; asm volatile("" : "+v"(t_), "+s"(b_)); cx.tid = t_; cx.bid = b_; }
    CParams* pp = (CParams*)__builtin_amdgcn_kernarg_segment_ptr();
    asm volatile("" : "+s"(pp));
    CParams& p = *pp;
    switch (ph) {
      case 0: ph_norm0(cx, p, g); break;
      case 1: gemm256(cx, p.H, p.H, 1 << 30, D, p.wt_in, D, ZW / 256, false, EpBf16{p.BIG, ZW}, smem); break;
      case 2: ph_qkconv(cx, p, g); break;
      case 3: ph_scan0(cx, p, smem); break;
      case 4: ph_evout(cx, p, g); break;
      case 5: gemm256(cx, p.H, p.H, 1 << 30, D, p.wt_out, D, 4, false, EpBf16{(u16*)p.YO, D}, smem); break;
      case 6: ph_resid(cx, p, g, 0, 0, false); break;
      case 7: gemm256(cx, p.H, p.H, 1 << 30, D, p.wt_up, D, GUW / 256, false, EpBf16{p.BIG, GUW}, smem); break;
      case 8: ph_ffnact(cx, p, g, 0, false); break;
      case 9: gemm256(cx, p.BIG + DFF, p.BIG + DFF, 1 << 30, GUW, p.wt_down, DFF, 4, false, EpBf16{(u16*)p.YO, D}, smem); break;
      case 10: ph_resid(cx, p, g, 0, 1, false); break;
      case 11: ph_xx(cx, p, g); break;
      case 12: gemm256<true>(cx, p.H, p.QK, D, D, p.wt_1, K1, N1 / 256, false, EpRw1{p.BIG, p.LR}, smem, p.BIG + 3 * RS); break;
      case 13: gemm256(cx, p.LR, p.LR, 1 << 30, K2, p.wt_2, K2, N2 / 256, false, EpRw2{p.BIG, p.QK, p.rw_w0, p.rw_a0}, smem); break;
      case 14: ph_rwprep(cx, p); break;
      case 15: ph_rwscan(cx, p); break;
      case 16: ph_rwout(cx, p, g); break;
      case 17: gemm256(cx, p.H, p.H, 1 << 30, D, p.wt_o, D, 4, true, EpBf16{(u16*)p.YO, D}, smem); break;
      case 18: ph_resid(cx, p, g, 1, 0, true); break;
      case 19: gemm256(cx, p.H, p.H, 1 << 30, D, p.wt_up + (size_t)GUW * D, D, GUW / 256, true, EpBf16{p.BIG, GUW}, smem); break;
      case 20: ph_ffnact(cx, p, g, 1, true); break;
      case 21: gemm256(cx, p.BIG + DFF, p.BIG + DFF, 1 << 30, GUW, p.wt_down + (size_t)D * DFF, DFF, 4, true, EpBf16{(u16*)p.YO, D}, smem); break;
      default: ph_resid(cx, p, g, 1, 1, true); break;
    }
    xcd_barrier(xb);
    if (PROBE_MASK && ((PROBE_MASK >> ph) & 1u)) {
      const unsigned long long tp1 = wall_clock64();
      while (wall_clock64() - tp1 < tp1 - tp0) __builtin_amdgcn_s_sleep(8);
    }
  }
}

extern "C" void kernel_launch(void* const* d_in, const int* in_sizes, int n_in, void* d_out, int out_size, void* d_ws,
                              size_t ws_size, hipStream_t stream) {
  static int grid_blocks = 0;
  if (!grid_blocks) {
    int dev = 0, cus = 0, per_cu = 0;
    hipGetDevice(&dev);
    hipDeviceGetAttribute(&cus, hipDeviceAttributeMultiprocessorCount, dev);
    hipOccupancyMaxActiveBlocksPerMultiprocessor(&per_cu, fwd_megakernel, NTHR, 0);
    if (per_cu > 1) per_cu = 1;
    if (per_cu < 1) per_cu = 1;
    grid_blocks = cus * per_cu;
  }
  Params p{};
  const float** f = (const float**)&p;
  for (int i = 0; i < 32; ++i) f[i] = (const float*)d_in[i];
  p.out = (float*)d_out;
  char* ws = (char*)d_ws;
  size_t off = 0;
  auto take = [&](size_t bytes) { char* q = ws + off; off += (bytes + 255) & ~(size_t)255; return q; };
  p.wt_in = (u16*)take((size_t)ZW * D * 2);
  p.wt_out = (u16*)take((size_t)D * D * 2);
  p.wt_up = (u16*)take((size_t)2 * GUW * D * 2);
  p.wt_down = (u16*)take((size_t)2 * D * DFF * 2);
  p.wt_o = (u16*)take((size_t)D * D * 2);
  p.wt_1 = (u16*)take((size_t)N1 * K1 * 2);
  p.wt_2 = (u16*)take((size_t)N2 * K2 * 2);
  p.mod = (float*)take((size_t)2 * 33 * 6144 * 4);
  p.xc = (float*)take((size_t)NB * CTX * D * 4);
  p.H = (u16*)take((size_t)R * D * 2);
  p.BIG = (u16*)take((size_t)6 * R * D * 2);
  p.QK = (u16*)take((size_t)R * D * 2);
  p.YO = (float*)take((size_t)R * D * 4);
  p.LR = (u16*)take((size_t)R * K2 * 2);
  p.bar = (unsigned*)take((size_t)XCD_BAR_WORDS * 4);
  if (off > ws_size) { fprintf(stderr, "workspace too small: need %zu have %zu\n", off, ws_size); return; }
  hipMemsetAsync(p.bar, 0, (size_t)XCD_BAR_WORDS * 4, stream);
  void* args[] = {&p};
  hipError_t e = hipLaunchCooperativeKernel((void*)fwd_megakernel, dim3(grid_blocks), dim3(NTHR), args, 0, stream);
  if (e != hipSuccess) fprintf(stderr, "cooperative launch failed: %s (grid %d)\n", hipGetErrorString(e), grid_blocks);
}
```

```cpp
#include <hip/hip_runtime.h>
#include <hip/hip_cooperative_groups.h>
#include <cstdio>
namespace cg = cooperative_groups;

typedef unsigned short u16;
using bf16x8 = __attribute__((ext_vector_type(8))) short;
using s16x4  = __attribute__((ext_vector_type(4))) short;
using f32x16 = __attribute__((ext_vector_type(16))) float;
#define DI __device__ __forceinline__
#define MFMA(a, b, c) __builtin_amdgcn_mfma_f32_32x32x16_bf16((a), (b), (c), 0, 0, 0)

constexpr int D = 1024, NB = 32, SEQ = 2048, CTX = 256, TPS = 2304;
constexpr int NG = 2, SPG = 16, R = SPG * TPS;
constexpr int ZW = 3840;
constexpr int DFF = 2816, GUW = 5632;
constexpr int NTHR = 512, NWV = NTHR / 64, NPH = 23;
constexpr int N1 = 3584, K1 = 2048, N2 = 4096, K2 = 320;
#ifndef PROBE_MASK_V
#define PROBE_MASK_V 0u
#endif
constexpr unsigned PROBE_MASK = PROBE_MASK_V;

struct Ctx { int tid, bid; };
struct Params {
  const float *x, *c, *ctx, *c_ctx, *w_mod, *b_mod, *norm_g, *ffn_w_up, *ffn_conv_w, *ffn_conv_b, *ffn_w_down,
      *ev_w_in, *ev_b_gates, *ev_conv_w, *ev_conv_b, *ev_gla_w2, *ev_gla_b, *ev_head_g, *ev_w_out,
      *rw_mu, *rw_w_rkv, *rw_w_o, *rw_w0, *rw_w1, *rw_w2, *rw_a0, *rw_a1, *rw_a2, *rw_g1, *rw_g2, *rw_kvec, *rw_lnx;
  float* out;
  u16 *wt_in, *wt_out, *wt_up, *wt_down, *wt_o, *wt_1, *wt_2;
  float* mod; float* xc;
  u16* H; u16* BIG; u16* QK; float* YO; u16* LR; unsigned* bar;
};

typedef const __attribute__((address_space(4))) Params CParams;

DI float bf2f(u16 v) { return __uint_as_float(((unsigned)v) << 16); }
typedef __bf16 bf16x2_t __attribute__((ext_vector_type(2)));
typedef float f32x2_t __attribute__((ext_vector_type(2)));
DI unsigned pack2(float a, float b) { f32x2_t v; v.x = a; v.y = b; return __builtin_bit_cast(unsigned, __builtin_convertvector(v, bf16x2_t)); }
DI u16 f2bf(float f) { return (u16)(pack2(f, 0.f) & 0xffffu); }
DI float lo16(unsigned u) { return __uint_as_float(u << 16); }
DI float hi16(unsigned u) { return __uint_as_float(u & 0xffff0000u); }
DI void unpack8(const uint4& v, float* o) {
  o[0] = lo16(v.x); o[1] = hi16(v.x); o[2] = lo16(v.y); o[3] = hi16(v.y);
  o[4] = lo16(v.z); o[5] = hi16(v.z); o[6] = lo16(v.w); o[7] = hi16(v.w);
}
DI uint4 pack8(const float* o) { uint4 v; v.x = pack2(o[0], o[1]); v.y = pack2(o[2], o[3]); v.z = pack2(o[4], o[5]); v.w = pack2(o[6], o[7]); return v; }
DI int crow(int reg, int h) { return (reg & 3) + 8 * (reg >> 2) + 4 * h; }
DI float wsum(float v) { for (int o = 32; o; o >>= 1) v += __shfl_xor(v, o); return v; }
DI float sigmoidf_(float x) { return 1.f / (1.f + __expf(-x)); }
DI float logsigf_(float x) { return fminf(x, 0.f) - log1pf(__expf(-fabsf(x))); }
DI float siluf_(float x) { return x / (1.f + __expf(-x)); }
DI bf16x8 cat4(s16x4 lo, s16x4 hi) { return __builtin_shufflevector(lo, hi, 0, 1, 2, 3, 4, 5, 6, 7); }
DI bf16x8 pack_step(const f32x16& x, int s) {
  uint4 v;
  v.x = pack2(x[8 * s + 0], x[8 * s + 1]); v.y = pack2(x[8 * s + 2], x[8 * s + 3]);
  v.z = pack2(x[8 * s + 4], x[8 * s + 5]); v.w = pack2(x[8 * s + 6], x[8 * s + 7]);
  return __builtin_bit_cast(bf16x8, v);
}
DI float dppf(float x, int) { return x; }
#define DPP_F(x, ctrl) __int_as_float(__builtin_amdgcn_update_dpp(0, __float_as_int(x), (ctrl), 0xF, 0xF, true))
DI float red8(float x) {
  x += DPP_F(x, 0x141);
  x += DPP_F(x, 0xB1);
  x += DPP_F(x, 0x4E);
  return x;
}

DI int scan_row(int base, int dir, int p) {
  if (dir == 0) return base + p;
  return (p < CTX) ? base + (CTX - 1 - p) : base + (TPS + CTX - 1 - p);
}

__device__ __forceinline__ void convert_job(const Ctx cx, const float* __restrict__ src, int K, int N, int Npad, u16* __restrict__ dst, int ldd, const float* __restrict__ mu, float* tile) {
  const int tx = cx.tid & 31, ty = cx.tid >> 5;
  const int tk = K >> 5, tn = Npad >> 5;
  for (int t = cx.bid; t < tk * tn; t += gridDim.x) {
    const int k0 = (t / tn) * 32, n0 = (t % tn) * 32;
#pragma unroll
    for (int i = 0; i < 2; ++i) {
      const int kk = k0 + ty + 16 * i, nn = n0 + tx;
      float v = (nn < N) ? src[(size_t)kk * N + nn] : 0.f;
      if (mu) v *= mu[kk];
      tile[(ty + 16 * i) * 33 + tx] = v;
    }
    __syncthreads();
#pragma unroll
    for (int i = 0; i < 2; ++i) {
      const int nn = n0 + ty + 16 * i, kk = k0 + tx;
      dst[(size_t)nn * ldd + kk] = f2bf(tile[tx * 33 + ty + 16 * i]);
    }
    __syncthreads();
  }
}

__device__ __forceinline__ void ph_mod(const Ctx cx, CParams& p, float* smem) {
  const int tid = cx.tid, lane = tid & 63, w = tid >> 6;
  float* sc = smem + w * (33 * 64);
  for (int u = cx.bid; u < 2 * 96; u += gridDim.x) {
    const int layer = u / 96, n = (u % 96) * 64 + lane;
    const float* W = p.w_mod + (size_t)layer * D * 6144;
    float acc[33];
#pragma unroll
    for (int i = 0; i < 33; ++i) acc[i] = 0.f;
    for (int kc = 0; kc < 2; ++kc) {
      const int k0 = w * 128 + kc * 64;
#pragma nounroll
      for (int cr = 0; cr < 33; ++cr) {
        const float v = (cr < 32) ? p.c[cr * D + k0 + lane] : p.c_ctx[k0 + lane];
        sc[cr * 64 + lane] = siluf_(v);
      }
      __syncthreads();
#pragma unroll 2
      for (int j = 0; j < 64; ++j) {
        const float wv = W[(size_t)(k0 + j) * 6144 + n];
#pragma unroll
        for (int cr = 0; cr < 33; ++cr) acc[cr] += sc[cr * 64 + j] * wv;
      }
      __syncthreads();
    }
#pragma unroll
    for (int cr = 0; cr < 33; ++cr) sc[cr * 64 + lane] = acc[cr];
    __syncthreads();
    if (w == 0) {
      const float bm = p.b_mod[layer * 6144 + n];
      for (int cr = 0; cr < 33; ++cr) {
        float s = 0.f;
#pragma unroll
        for (int q = 0; q < NWV; ++q) s += smem[q * 33 * 64 + cr * 64 + lane];
        p.mod[((size_t)layer * 33 + cr) * 6144 + n] = s + bm;
      }
    }
    __syncthreads();
  }
}

__device__ __forceinline__ void ph_prologue(const Ctx cx, CParams& p, float* smem) {
  ph_mod(cx, p, smem);
  convert_job(cx, p.ev_w_in, D, 3632, ZW, p.wt_in, D, nullptr, smem);
  convert_job(cx, p.ev_w_out, D, D, D, p.wt_out, D, nullptr, smem);
  for (int l = 0; l < 2; ++l) {
    convert_job(cx, p.ffn_w_up + (size_t)l * D * GUW, D, GUW, GUW, p.wt_up + (size_t)l * GUW * D, D, nullptr, smem);
    convert_job(cx, p.ffn_w_down + (size_t)l * DFF * D, DFF, D, D, p.wt_down + (size_t)l * D * DFF, DFF, nullptr, smem);
  }
  convert_job(cx, p.rw_w_o, D, D, D, p.wt_o, D, nullptr, smem);
  for (int half = 0; half < 2; ++half) {
    u16* dcol = p.wt_1 + half * D;
    const float* m0 = half ? p.rw_mu : nullptr;
    convert_job(cx, p.rw_w_rkv, D, D, D, dcol, K1, half ? m0 + 0 * D : nullptr, smem);
    convert_job(cx, p.rw_w_rkv + (size_t)D * D, D, D, D, dcol + (size_t)1024 * K1, K1, half ? m0 + 2 * D : nullptr, smem);
    convert_job(cx, p.rw_w_rkv + (size_t)2 * D * D, D, D, D, dcol + (size_t)2048 * K1, K1, half ? m0 + 3 * D : nullptr, smem);
    convert_job(cx, p.rw_w1, D, 64, 64, dcol + (size_t)3072 * K1, K1, half ? m0 + 1 * D : nullptr, smem);
    convert_job(cx, p.rw_w1 + D * 64, D, 64, 64, dcol + (size_t)3136 * K1, K1, half ? m0 + 1 * D : nullptr, smem);
    convert_job(cx, p.rw_a1, D, 64, 64, dcol + (size_t)3200 * K1, K1, half ? m0 + 4 * D : nullptr, smem);
    convert_job(cx, p.rw_g1, D, 128, 320, dcol + (size_t)3264 * K1, K1, half ? m0 + 5 * D : nullptr, smem);
  }
  for (size_t i = (size_t)cx.bid * NTHR + cx.tid; i < (size_t)N2 * K2; i += (size_t)gridDim.x * NTHR) {
    const int n = (int)(i / K2), c = (int)(i % K2), blk = n >> 10, nn = n & 1023;
    float v = 0.f;
    if (blk == 0) { if (c < 64) v = p.rw_w2[(size_t)c * D + nn]; }
    else if (blk == 1) { if (c >= 64 && c < 128) v = p.rw_w2[(size_t)(64 + c - 64) * D + nn]; }
    else if (blk == 2) { if (c >= 128 && c < 192) v = p.rw_a2[(size_t)(c - 128) * D + nn]; }
    else { if (c >= 192) v = p.rw_g2[(size_t)(c - 192) * D + nn]; }
    p.wt_2[i] = f2bf(v);
  }
}

DI void rowinfo(int g, int row, int& b, int& pos) { const int bl = row / TPS; pos = row - bl * TPS; b = g * SPG + bl; }

__device__ __forceinline__ void ph_norm0(const Ctx cx, CParams& p, int g) {
  const int lane = cx.tid & 63;
  const int gw = cx.bid * NWV + (cx.tid >> 6), nw = gridDim.x * NWV;
  for (int row = gw; row < R; row += nw) {
    int b, pos; rowinfo(g, row, b, pos);
    const float* src = (pos < CTX) ? p.ctx + ((size_t)(b * CTX + pos)) * D : p.x + ((size_t)(b * SEQ + pos - CTX)) * D;
    const float* md = p.mod + ((size_t)(pos < CTX ? 32 : b)) * 6144;
    float4 v[4]; float ss = 0.f;
#pragma unroll
    for (int j = 0; j < 4; ++j) { v[j] = ((const float4*)src)[j * 64 + lane]; ss += v[j].x * v[j].x + v[j].y * v[j].y + v[j].z * v[j].z + v[j].w * v[j].w; }
    ss = wsum(ss);
    const float rstd = rsqrtf(ss * (1.f / D) + 1e-6f);
#pragma unroll
    for (int j = 0; j < 4; ++j) {
      const int col = j * 256 + lane * 4;
      const float4 gg = *(const float4*)(p.norm_g + col);
      const float4 sh = *(const float4*)(md + col), sc = *(const float4*)(md + D + col);
      uint2 o;
      o.x = pack2(v[j].x * rstd * gg.x * (1.f + sc.x) + sh.x, v[j].y * rstd * gg.y * (1.f + sc.y) + sh.y);
      o.y = pack2(v[j].z * rstd * gg.z * (1.f + sc.z) + sh.z, v[j].w * rstd * gg.w * (1.f + sc.w) + sh.w);
      *(uint2*)(p.H + (size_t)row * D + col) = o;
    }
  }
}

__device__ __forceinline__ void ph_resid(const Ctx cx, CParams& p, int g, int layer, int which, bool lat_only) {
  const int lane = cx.tid & 63;
  const int gw = cx.bid * NWV + (cx.tid >> 6), nw = gridDim.x * NWV;
  const bool from_inputs = (layer == 0 && which == 0);
  const bool has_next = (which == 0) || (layer + 1 < 2);
  const bool final_out = !has_next;
  const float* ga = p.norm_g + (layer * 4 + (which ? 3 : 1)) * D;
  const float* gb = (which == 0) ? p.norm_g + (layer * 4 + 2) * D : p.norm_g + ((layer + 1) * 4 + 0) * D;
  for (int row = gw; row < R; row += nw) {
    int b, pos; rowinfo(g, row, b, pos);
    if (lat_only && pos < CTX) continue;
    const size_t ridx = (pos < CTX) ? ((size_t)(b * CTX + pos)) * D : ((size_t)(b * SEQ + pos - CTX)) * D;
    const float* src = from_inputs ? ((pos < CTX) ? p.ctx + ridx : p.x + ridx) : ((pos < CTX) ? p.xc + ridx : p.out + ridx);
    float* dst = (pos < CTX) ? p.xc + ridx : p.out + ridx;
    const int cr = (pos < CTX) ? 32 : b;
    const float* md = p.mod + ((size_t)layer * 33 + cr) * 6144;
    const float* mdn = (which == 0) ? md + 3 * D : p.mod + ((size_t)(layer + 1) * 33 + cr) * 6144;
    const float* gate = md + (which ? 5 : 2) * D;
    const u16* yo = (const u16*)p.YO + (size_t)row * D;
    float4 y[4], xv[4]; float ss = 0.f;
#pragma unroll
    for (int j = 0; j < 4; ++j) {
      const uint2 yb = ((const uint2*)yo)[j * 64 + lane];
      y[j].x = lo16(yb.x); y[j].y = hi16(yb.x); y[j].z = lo16(yb.y); y[j].w = hi16(yb.y);
      if (from_inputs) xv[j] = ((const float4*)src)[j * 64 + lane];
      else { const uint2 xb = ((const uint2*)src)[j * 64 + lane]; xv[j].x = lo16(xb.x); xv[j].y = hi16(xb.x); xv[j].z = lo16(xb.y); xv[j].w = hi16(xb.y); }
      ss += y[j].x * y[j].x + y[j].y * y[j].y + y[j].z * y[j].z + y[j].w * y[j].w; }
    ss = wsum(ss);
    const float rstd = rsqrtf(ss * (1.f / D) + 1e-6f);
    float s2 = 0.f;
#pragma unroll
    for (int j = 0; j < 4; ++j) {
      const int col = j * 256 + lane * 4;
      const float4 g4 = *(const float4*)(ga + col), gt = *(const float4*)(gate + col);
      xv[j].x += gt.x * (y[j].x * rstd * g4.x); xv[j].y += gt.y * (y[j].y * rstd * g4.y);
      xv[j].z += gt.z * (y[j].z * rstd * g4.z); xv[j].w += gt.w * (y[j].w * rstd * g4.w);
      if (final_out) ((float4*)dst)[j * 64 + lane] = xv[j];
      else {
        uint2 xo; xo.x = pack2(xv[j].x, xv[j].y); xo.y = pack2(xv[j].z, xv[j].w);
        ((uint2*)dst)[j * 64 + lane] = xo;
        xv[j].x = lo16(xo.x); xv[j].y = hi16(xo.x); xv[j].z = lo16(xo.y); xv[j].w = hi16(xo.y);
      }
      s2 += xv[j].x * xv[j].x + xv[j].y * xv[j].y + xv[j].z * xv[j].z + xv[j].w * xv[j].w;
    }
    if (has_next) {
      s2 = wsum(s2);
      const float r2 = rsqrtf(s2 * (1.f / D) + 1e-6f);
#pragma unroll
      for (int j = 0; j < 4; ++j) {
        const int col = j * 256 + lane * 4;
        const float4 gg = *(const float4*)(gb + col);
        const float4 sh = *(const float4*)(mdn + col), sc = *(const float4*)(mdn + D + col);
        uint2 o;
        o.x = pack2(xv[j].x * r2 * gg.x * (1.f + sc.x) + sh.x, xv[j].y * r2 * gg.y * (1.f + sc.y) + sh.y);
        o.y = pack2(xv[j].z * r2 * gg.z * (1.f + sc.z) + sh.z, xv[j].w * r2 * gg.w * (1.f + sc.w) + sh.w);
        *(uint2*)(p.H + (size_t)row * D + col) = o;
      }
    }
  }
}

using f32x4 = __attribute__((ext_vector_type(4))) float;
using i32x4 = __attribute__((ext_vector_type(4))) int;
DI int lds_byte(int r, int c) {
  const int st = (r >> 4) * 2 + (c >> 5), ob = (r & 15) * 64 + (c & 31) * 2;
  return st * 1024 + (ob ^ (((ob >> 9) & 1) << 5));
}
DI void stage_rc(int b, int& Rr, int& Cc) {
  const int st = b >> 10, sb = b & 1023, swz = sb ^ (((sb >> 9) & 1) << 5);
  Rr = (st >> 1) * 16 + swz / 64;
  Cc = (st & 1) * 32 + (swz % 64) / 2;
}
constexpr int TILE_B = 256 * 64 * 2, STAGE_B = 2 * TILE_B;

DI const char* uni_ptr(const char* q) {
  const unsigned long long a = (unsigned long long)q;
  const unsigned lo = (unsigned)__builtin_amdgcn_readfirstlane((int)(unsigned)a), hi = (unsigned)__builtin_amdgcn_readfirstlane((int)(unsigned)(a >> 32));
  return (const char*)(((unsigned long long)hi << 32) | lo);
}
struct GUnit { const u16* A0; const u16* Bb; int ksplit, nt, brow, bcol; };
template <bool RW1>
DI GUnit gemm_unit(int u, int nN, int nMx, int xcd, bool lat_only, const u16* A0in, const u16* A2, int ksplit_in, int Kin, const u16* Bt, int ldb) {
  constexpr int GM = 4;
  const int grp = u / (GM * nN), fm = grp * GM, gsz = (nMx - fm) < GM ? (nMx - fm) : GM;
  const int rr_ = u - grp * (GM * nN);
  const int pn = rr_ / gsz, ml = fm + (rr_ - pn * gsz), pm = ml * 8 + xcd;
  GUnit g;
  g.brow = lat_only ? ((pm >> 3) * 9 + 1 + (pm & 7)) * 256 : pm * 256;
  g.bcol = pn * 256;
  g.A0 = A0in; g.ksplit = ksplit_in; int K = Kin;
  if constexpr (RW1) { if (pn < 12) { g.A0 = A2 + (size_t)(pn >> 2) * ((size_t)R * D); g.ksplit = 1 << 30; K = D; } }
  g.nt = K >> 6;
  g.Bb = Bt + (size_t)g.bcol * ldb;
  return g;
}
template <bool RW1 = false, class EP>
__device__ __forceinline__ void gemm256(const Ctx cx, const u16* __restrict__ A0in, const u16* __restrict__ A1, int ksplit_in, int lda,
                        const u16* __restrict__ Bt, int Kin, int nN, bool lat_only, const EP& ep, char* shm, const u16* __restrict__ A2 = nullptr) {
  const int wsg = __builtin_amdgcn_readfirstlane(cx.tid >> 6);
  const int wid = wsg, lane = cx.tid & 63;
  const int nM = lat_only ? SPG * 8 : R / 256;
  const int ldb = Kin;
  const int fragA = lds_byte((wsg >> 2) * 128 + (lane & 15), (lane >> 4) * 8), fragB = lds_byte((wsg & 3) * 64 + (lane & 15), (lane >> 4) * 8);
  const int xcd = cx.bid & 7, slot = cx.bid >> 3, nslot = gridDim.x >> 3, per_xcd = (nM >> 3) * nN;
  const int nMx = nM >> 3;
  if (slot < per_xcd) {
#define G_STAGE(buf, kt, UU, AO, BO) do { const int kb_ = (kt) * 64; const size_t ro_ = (size_t)(UU).brow * lda; \
    const char* Ab0_ = (const char*)((kb_ < (UU).ksplit) ? (UU).A0 + ro_ + kb_ : A1 + ro_ + (kb_ - (UU).ksplit)); \
    const char* Bb0_ = (const char*)((UU).Bb + kb_); \
    _Pragma("unroll") for (int i = 0; i < 4; ++i) { \
      const char* Ab_ = uni_ptr(Ab0_ + (size_t)i * 128 * lda); const char* Bb_ = uni_ptr(Bb0_ + (size_t)i * 128 * ldb);     \
      __builtin_amdgcn_global_load_lds((const unsigned*)(Ab_ + AO), (__attribute__((address_space(3))) unsigned*)(shm + (buf) * STAGE_B + wid * 1024 + i * 8192), 16, 0, 0); \
      __builtin_amdgcn_global_load_lds((const unsigned*)(Bb_ + BO), (__attribute__((address_space(3))) unsigned*)(shm + (buf) * STAGE_B + TILE_B + wid * 1024 + i * 8192), 16, 0, 0); } } while (0)
#define G_STAGE1(buf, kt, UU, AO, BO, i) do { const int kb_ = (kt) * 64; const size_t ro_ = (size_t)(UU).brow * lda; \
    const char* Ab0_ = (const char*)((kb_ < (UU).ksplit) ? (UU).A0 + ro_ + kb_ : A1 + ro_ + (kb_ - (UU).ksplit)); \
    const char* Bb0_ = (const char*)((UU).Bb + kb_); \
    const char* Ab_ = uni_ptr(Ab0_ + (size_t)(i) * 128 * lda); const char* Bb_ = uni_ptr(Bb0_ + (size_t)(i) * 128 * ldb); \
    __builtin_amdgcn_global_load_lds((const unsigned*)(Ab_ + AO), (__attribute__((address_space(3))) unsigned*)(shm + (buf) * STAGE_B + wid * 1024 + (i) * 8192), 16, 0, 0); \
    __builtin_amdgcn_global_load_lds((const unsigned*)(Bb_ + BO), (__attribute__((address_space(3))) unsigned*)(shm + (buf) * STAGE_B + TILE_B + wid * 1024 + (i) * 8192), 16, 0, 0); } while (0)
#define G_OFFS(UU, AO, BO) do { int sR, sC; stage_rc(wid * 1024 + lane * 16, sR, sC); \
      AO = (unsigned)((sR * lda + sC) * 2); BO = (unsigned)((sR * ldb + sC) * 2); } while (0)
  int u = slot;
  GUnit cu = gemm_unit<RW1>(u, nN, nMx, xcd, lat_only, A0in, A2, ksplit_in, Kin, Bt, ldb);
  unsigned aoff, boff;
  G_OFFS(cu, aoff, boff);
  G_STAGE(0, 0, cu, aoff, boff);
  asm volatile("s_waitcnt vmcnt(0)" ::: "memory");
  __syncthreads();
  int gt = 0;
  for (;;) {
    const int un = u + nslot;
    const bool has_next = un < per_xcd;
    f32x4 acc[8][4];
#pragma unroll
    for (int m = 0; m < 8; ++m)
#pragma unroll
      for (int n = 0; n < 4; ++n) acc[m][n] = (f32x4){0.f, 0.f, 0.f, 0.f};
    const int nt = cu.nt;
#pragma nounroll
    for (int t = 0; t < nt; ++t) {
      const int cur = gt & 1;
      const char* SAp = shm + cur * STAGE_B; const char* SBp = SAp + TILE_B;
      {
        bf16x8 At[8], Bf[4];
        const char* abase = SAp + fragA;
        const char* bbase = SBp + fragB;
#pragma unroll
        for (int n = 0; n < 4; ++n) Bf[n] = *(const bf16x8*)(bbase + n * 2048);
#pragma unroll
        for (int m = 0; m < 2; ++m) At[m] = *(const bf16x8*)(abase + m * 2048);
        __builtin_amdgcn_sched_barrier(0);
        const bool in_unit = t + 1 < nt;
        const bool do_stage = in_unit || has_next;
        GUnit su = cu;
        if (!in_unit && has_next) su = gemm_unit<RW1>(un, nN, nMx, xcd, lat_only, A0in, A2, ksplit_in, Kin, Bt, ldb);
        const int skt = in_unit ? t + 1 : 0;
#pragma unroll
        for (int m = 0; m < 4; ++m) {
#pragma unroll
          for (int n = 0; n < 4; ++n) acc[m][n] = __builtin_amdgcn_mfma_f32_16x16x32_bf16(Bf[n], At[m], acc[m][n], 0, 0, 0);
          if (m < 3) { At[2 * m + 2] = *(const bf16x8*)(abase + (2 * m + 2) * 2048); At[2 * m + 3] = *(const bf16x8*)(abase + (2 * m + 3) * 2048); }
          At[m] = *(const bf16x8*)(abase + m * 2048 + 1024);
          if (do_stage) G_STAGE1(cur ^ 1, skt, su, aoff, boff, m);
          __builtin_amdgcn_sched_barrier(0);
        }
#pragma unroll
        for (int n = 0; n < 4; ++n) {
#pragma unroll
          for (int m = 4; m < 8; ++m) {
            acc[m][n] = __builtin_amdgcn_mfma_f32_16x16x32_bf16(Bf[n], At[m], acc[m][n], 0, 0, 0);
            if (n == 3) At[m] = *(const bf16x8*)(abase + m * 2048 + 1024);
          }
          Bf[n] = *(const bf16x8*)(bbase + n * 2048 + 1024);
          __builtin_amdgcn_sched_barrier(0);
        }
#pragma unroll
        for (int n = 0; n < 4; ++n) {
#pragma unroll
          for (int m = 0; m < 8; ++m) acc[m][n] = __builtin_amdgcn_mfma_f32_16x16x32_bf16(Bf[n], At[m], acc[m][n], 0, 0, 0);
          __builtin_amdgcn_sched_barrier(0);
        }
      }
      asm volatile("s_waitcnt vmcnt(0)" ::: "memory");
      __syncthreads();
      ++gt;
    }
    {
      int lane_ = (int)__builtin_amdgcn_mbcnt_hi(~0u, __builtin_amdgcn_mbcnt_lo(~0u, 0u));
      asm volatile("" : "+v"(lane_));
      const int wr = wsg >> 2, wc = wsg & 3, fr = lane_ & 15, fq = lane_ >> 4;
      char* ob = shm + 2 * STAGE_B + wsg * 2048;
      const int wofs = fr * 128 + (fq & 1) * 8, wch = fq >> 1, wsw = fr & 7;
      const int r8 = lane_ >> 3, c8 = lane_ & 7;
      const int rofs = r8 * 128 + ((c8 ^ (r8 & 7)) << 4);
#pragma unroll
      for (int m = 0; m < 8; ++m) {
#pragma unroll
        for (int n = 0; n < 4; ++n) {
          const f32x4 v = ep.conv(cu.brow + wr * 128 + m * 16 + fr, cu.bcol + wc * 64 + n * 16 + fq * 4, acc[m][n]);
          uint2 o; o.x = pack2(v[0], v[1]); o.y = pack2(v[2], v[3]);
          *(uint2*)(ob + wofs + ((((n << 1) | wch) ^ wsw) << 4)) = o;
        }
#pragma unroll
        for (int hh = 0; hh < 2; ++hh) {
          const uint4 val = *(const uint4*)(ob + hh * 1024 + rofs);
          u16* dp = ep.dst(cu.brow + wr * 128 + m * 16 + hh * 8 + r8, cu.bcol + wc * 64 + c8 * 8);
          if (dp) *(uint4*)dp = val;
        }
        __builtin_amdgcn_sched_barrier(0);
      }
    }
    if (!has_next) break;
    u = un;
    cu = gemm_unit<RW1>(u, nN, nMx, xcd, lat_only, A0in, A2, ksplit_in, Kin, Bt, ldb);
  }
  }
#undef G_STAGE
#undef G_STAGE1
#undef G_OFFS
}

DI float tanh_fast(float x) { x = fminf(fmaxf(x, -15.f), 15.f); const float t = __expf(2.f * x); return (t - 1.f) / (t + 1.f); }
DI float decay_m1(float lw) {
  const float el = __expf(-fabsf(lw));
  const float ls = fminf(lw, 0.f) - __logf(1.f + el);
  const float e = __expf(ls - 0.5f);
  return __expf(-e) - 1.f;
}
struct EpBf16 {
  u16* base; int ld;
  DI f32x4 conv(int, int, f32x4 v) const { return v; }
  DI u16* dst(int row, int col) const { return base + (size_t)row * ld + col; }
};
struct EpRw1 {
  u16* big; u16* lr;
  DI f32x4 conv(int, int col, f32x4 v) const {
    const int cu = __builtin_amdgcn_readfirstlane(col >> 6);
    if (cu >= 48 && cu < 50) { v[0] = tanh_fast(v[0]); v[1] = tanh_fast(v[1]); v[2] = tanh_fast(v[2]); v[3] = tanh_fast(v[3]); }
    else if (cu >= 51 && cu < 53) { v[0] = sigmoidf_(v[0]); v[1] = sigmoidf_(v[1]); v[2] = sigmoidf_(v[2]); v[3] = sigmoidf_(v[3]); }
    return v;
  }
  DI u16* dst(int row, int col) const {
    if (col < 3072) return big + (size_t)(col >> 10) * ((size_t)R * D) + (size_t)row * D + (col & 1023);
    if (col < 3392) return lr + (size_t)row * K2 + (col - 3072);
    return nullptr;
  }
};
struct EpRw2 {
  u16* big; u16* gq; const float* w0; const float* a0;
  DI f32x4 conv(int, int col, f32x4 v) const {
    const int blk = __builtin_amdgcn_readfirstlane(col >> 10), cc = col & 1023;
    if (blk < 2) {
      const float4 ww = *(const float4*)(w0 + blk * D + cc);
      v[0] = decay_m1(v[0] + ww.x); v[1] = decay_m1(v[1] + ww.y); v[2] = decay_m1(v[2] + ww.z); v[3] = decay_m1(v[3] + ww.w);
    } else if (blk == 2) {
      const float4 ww = *(const float4*)(a0 + cc);
      v[0] = sigmoidf_(v[0] + ww.x); v[1] = sigmoidf_(v[1] + ww.y); v[2] = sigmoidf_(v[2] + ww.z); v[3] = sigmoidf_(v[3] + ww.w);
    }
    return v;
  }
  DI u16* dst(int row, int col) const {
    const int blk = col >> 10, cc = col & 1023;
    if (blk < 2) return big + (size_t)(4 + blk) * ((size_t)R * D) + (size_t)row * D + cc;
    if (blk == 2) return big + (size_t)3 * ((size_t)R * D) + (size_t)row * D + cc;
    return gq + (size_t)row * D + cc;
  }
};

__device__ __forceinline__ void ph_qkconv(const Ctx cx, CParams& p, int g) {
  const size_t total = (size_t)R * 128;
  for (size_t i = (size_t)cx.bid * NTHR + cx.tid; i < total; i += (size_t)gridDim.x * NTHR) {
    const int row = (int)(i >> 7), c0 = ((int)(i & 127)) * 8;
    int b, pos; rowinfo(g, row, b, pos);
    const bool hasp = (pos != 0 && pos != CTX), hasn = (pos != CTX - 1 && pos != TPS - 1);
    const u16* Z = p.BIG + (size_t)row * ZW + c0;
    float cur[8], pv[8], nx[8];
    unpack8(*(const uint4*)Z, cur);
    if (hasp) unpack8(*(const uint4*)(Z - ZW), pv); else { for (int e = 0; e < 8; ++e) pv[e] = 0.f; }
    if (hasn) unpack8(*(const uint4*)(Z + ZW), nx); else { for (int e = 0; e < 8; ++e) nx[e] = 0.f; }
    const float scale = (c0 < 512) ? 0.08838834764831845f : 1.f;
    float o[8];
#pragma unroll
    for (int e = 0; e < 8; ++e) {
      const int c = c0 + e;
      const float v = pv[e] * p.ev_conv_w[c] + cur[e] * p.ev_conv_w[D + c] + nx[e] * p.ev_conv_w[2 * D + c] + p.ev_conv_b[c];
      o[e] = siluf_(v) * scale;
    }
    *(uint4*)(p.QK + (size_t)row * D + c0) = pack8(o);
  }
}

__device__ __forceinline__ void mlstm_item(const Ctx cx, CParams& p, int item, char* smem) {
  const int tid = cx.tid, lane = tid & 63, w = tid >> 6, r = lane & 31, h = lane >> 5;
  const int bl = item >> 3, head = (item >> 1) & 3, dir = item & 1;
  const int base = bl * TPS;
  u16* sQ = (u16*)smem;
  u16* sK = sQ + 32 * 136;
  u16* sVT = sK + 32 * 136;
  u16* sKT = sVT + 128 * 40;
  float* sU = (float*)(sKT + 128 * 40);
  float* sM = sU + 32; float* sBc = sM + 32; float* sLast = sBc + 32;
  float* sN = sLast + 32;
  float* sRD = sN + 128;
  float* sWI = sRD + 128;
  const u16* Z = p.BIG;
  u16* Y = p.BIG + (size_t)R * ZW + (size_t)dir * R * 512;
  const float bgi = p.ev_b_gates[(2 * dir) * 4 + head], bgf = p.ev_b_gates[(2 * dir + 1) * 4 + head];
  f32x16 cacc[4];
#pragma unroll
  for (int a = 0; a < 4; ++a)
#pragma unroll
    for (int i = 0; i < 16; ++i) cacc[a][i] = 0.f;
  if (tid < 128) sN[tid] = 0.f;
  float m = 0.f;
  const bool act = tid < 256;
  const int lr = (tid >> 3) & 31, lc = tid & 7;
  uint4 q0, q1, k0, k1, v0, v1;
  u16 gzi = 0, gzf = 0;
#define ML_LOAD(p0_) do { if (act) { const int grow = scan_row(base, dir, (p0_) + lr); \
      q0 = *(const uint4*)(p.QK + (size_t)grow * D + head * 128 + lc * 8); \
      q1 = *(const uint4*)(p.QK + (size_t)grow * D + head * 128 + lc * 8 + 64); \
      k0 = *(const uint4*)(p.QK + (size_t)grow * D + 512 + head * 128 + lc * 8); \
      k1 = *(const uint4*)(p.QK + (size_t)grow * D + 512 + head * 128 + lc * 8 + 64); \
      v0 = *(const uint4*)(Z + (size_t)grow * ZW + 1024 + head * 128 + lc * 8); \
      v1 = *(const uint4*)(Z + (size_t)grow * ZW + 1024 + head * 128 + lc * 8 + 64); } \
    if (w == 0) { const int row_ = scan_row(base, dir, (p0_) + (lane & 31)); \
      gzi = Z[(size_t)row_ * ZW + 2048 + (2 * dir) * 4 + head]; gzf = Z[(size_t)row_ * ZW + 2048 + (2 * dir + 1) * 4 + head]; } } while (0)
  ML_LOAD(0);
  for (int ch = 0; ch < TPS / 32; ++ch) {
    const int p0 = ch * 32;
    __syncthreads();
    if (w == 0) {
      const int t = lane & 31;
      const float zi = bf2f(gzi) + bgi;
      const float zf = bf2f(gzf) + bgf;
      float bsum = logsigf_(zf);
      for (int o = 1; o < 32; o <<= 1) { const float v = __shfl_up(bsum, o); if (t >= o) bsum += v; }
      const float u = zi - bsum;
      float pm = u;
      for (int o = 1; o < 32; o <<= 1) { const float v = __shfl_up(pm, o); if (t >= o) pm = fmaxf(pm, v); }
      const float M = fmaxf(m, pm);
      if (lane < 32) { sU[t] = u; sM[t] = M; sBc[t] = bsum; if (t == 31) { sLast[0] = M; sLast[1] = bsum; } }
    }
    __syncthreads();
    const float Mlast = sLast[0], blast = sLast[1];
    if (act) {
      const float ws = __expf(sU[lr] - Mlast);
      *(uint4*)(sQ + lr * 136 + lc * 8) = q0; *(uint4*)(sQ + lr * 136 + lc * 8 + 64) = q1;
      *(uint4*)(sK + lr * 136 + lc * 8) = k0; *(uint4*)(sK + lr * 136 + lc * 8 + 64) = k1;
      float f[8];
      unpack8(k0, f);
#pragma unroll
      for (int e = 0; e < 8; ++e) sKT[(lc * 8 + e) * 40 + lr] = f2bf(f[e] * ws);
      unpack8(k1, f);
#pragma unroll
      for (int e = 0; e < 8; ++e) sKT[(lc * 8 + 64 + e) * 40 + lr] = f2bf(f[e] * ws);
      const u16* pv0 = (const u16*)&v0; const u16* pv1 = (const u16*)&v1;
#pragma unroll
      for (int e = 0; e < 8; ++e) { sVT[(lc * 8 + e) * 40 + lr] = pv0[e]; sVT[(lc * 8 + 64 + e) * 40 + lr] = pv1[e]; }
    }
    if (ch + 1 < TPS / 32) ML_LOAD(p0 + 32);
    __syncthreads();
    f32x16 st;
#pragma unroll
    for (int i = 0; i < 16; ++i) st[i] = 0.f;
    if (act) {
#pragma unroll
    for (int ks = 0; ks < 8; ++ks) {
      const bf16x8 a = *(const bf16x8*)(sK + r * 136 + 16 * ks + 8 * h);
      const bf16x8 b = *(const bf16x8*)(sQ + r * 136 + 16 * ks + 8 * h);
      st = MFMA(a, b, st);
    }
    const float Mt = sM[r];
    float dsum = 0.f;
#pragma unroll
    for (int i = 0; i < 16; ++i) {
      const int s = crow(i, h);
      const float pv = (s <= r) ? st[i] * __expf(sU[s] - Mt) : 0.f;
      st[i] = pv; dsum += pv;
    }
    dsum += __shfl_xor(dsum, 32);
    float qn = 0.f;
#pragma unroll
    for (int d8 = 0; d8 < 8; ++d8) {
      float qf[8]; unpack8(*(const uint4*)(sQ + r * 136 + 64 * h + 8 * d8), qf);
#pragma unroll
      for (int e = 0; e < 8; ++e) qn += qf[e] * sN[64 * h + 8 * d8 + e];
    }
    qn += __shfl_xor(qn, 32);
    const float wi = __expf(m - Mt);
    const float den = dsum + wi * qn;
    const float dn = fmaxf(fabsf(den), __expf(-(sBc[r] + Mt)));
    if (h == 0) { sRD[w * 32 + r] = 1.f / dn; sWI[w * 32 + r] = wi; }
    }
    __syncthreads();
    const float wp = __expf(m - Mlast);
    if (act) {
    f32x16 o;
#pragma unroll
    for (int i = 0; i < 16; ++i) o[i] = 0.f;
#pragma unroll
    for (int mb = 0; mb < 4; ++mb)
#pragma unroll
      for (int s2 = 0; s2 < 2; ++s2) {
        const bf16x8 cb = pack_step(cacc[mb], s2);
        const u16* qp = sQ + r * 136 + 32 * mb + 16 * s2 + 4 * h;
        const bf16x8 a = cat4(*(const s16x4*)qp, *(const s16x4*)(qp + 8));
        o = MFMA(a, cb, o);
      }
#pragma unroll
    for (int i = 0; i < 16; ++i) o[i] *= sWI[w * 32 + crow(i, h)];
#pragma unroll
    for (int s2 = 0; s2 < 2; ++s2) {
      const bf16x8 a = pack_step(st, s2);
      const u16* vp = sVT + (32 * w + r) * 40 + 16 * s2 + 4 * h;
      const bf16x8 b = cat4(*(const s16x4*)vp, *(const s16x4*)(vp + 8));
      o = MFMA(a, b, o);
    }
#pragma unroll
    for (int i = 0; i < 16; ++i) {
      const int t = crow(i, h);
      const int row = scan_row(base, dir, p0 + t);
      Y[(size_t)row * 512 + head * 128 + 32 * w + r] = f2bf(o[i] * sRD[w * 32 + t]);
    }
#pragma unroll
    for (int mb = 0; mb < 4; ++mb) {
#pragma unroll
      for (int i = 0; i < 16; ++i) cacc[mb][i] *= wp;
#pragma unroll
      for (int s2 = 0; s2 < 2; ++s2) {
        const bf16x8 a = *(const bf16x8*)(sKT + (32 * mb + r) * 40 + 16 * s2 + 8 * h);
        const bf16x8 b = *(const bf16x8*)(sVT + (32 * w + r) * 40 + 16 * s2 + 8 * h);
        cacc[mb] = MFMA(a, b, cacc[mb]);
      }
    }
    }
    __syncthreads();
    if (tid < 128) {
      float s = 0.f;
#pragma unroll
      for (int e = 0; e < 32; ++e) s += bf2f(sKT[tid * 40 + e]);
      sN[tid] = wp * sN[tid] + s;
    }
    m = blast + Mlast;
  }
#undef ML_LOAD
}

__device__ __forceinline__ void gla_item(const Ctx cx, CParams& p, int item, char* smem) {
  const int tid = cx.tid, lane = tid & 63, w = tid >> 6, r = lane & 31, h = lane >> 5;
  const int bl = item >> 3, head = (item >> 1) & 3, dir = item & 1;
  const int base = bl * TPS;
  u16* sQ = (u16*)smem;
  u16* sK = sQ + 32 * 72;
  u16* sKT = sK + 32 * 72;
  u16* sVT = sKT + 64 * 40;
  float* sLa = (float*)(sVT + 128 * 40);
  float* sW2 = sLa + 32 * 64;
  float* sBi = sW2 + 16 * 64;
  const u16* Z = p.BIG;
  u16* Y = p.BIG + (size_t)R * ZW + (size_t)(2 + dir) * R * 512;
  for (int i = tid; i < 16 * 64; i += NTHR) sW2[i] = p.ev_gla_w2[((size_t)dir * 16 + (i >> 6)) * 256 + head * 64 + (i & 63)];
  if (tid < 64) sBi[tid] = p.ev_gla_b[dir * 256 + head * 64 + tid];
  f32x16 sacc[2];
#pragma unroll
  for (int a = 0; a < 2; ++a)
#pragma unroll
    for (int i = 0; i < 16; ++i) sacc[a][i] = 0.f;
  const bool act = tid < 256;
  const int lr = (tid >> 3) & 31, lc = tid & 7;
  uint4 gq, gk, v0, v1, gl0, gl1;
#define GLA_LOAD(p0_) do { if (act) { const int grow = scan_row(base, dir, (p0_) + lr); const u16* zr = Z + (size_t)grow * ZW; \
      gq = *(const uint4*)(zr + 2064 + head * 64 + lc * 8); gk = *(const uint4*)(zr + 2320 + head * 64 + lc * 8); \
      v0 = *(const uint4*)(zr + 2576 + head * 128 + lc * 8); v1 = *(const uint4*)(zr + 2576 + head * 128 + lc * 8 + 64); \
      gl0 = *(const uint4*)(zr + 3600 + dir * 16); gl1 = *(const uint4*)(zr + 3600 + dir * 16 + 8); } } while (0)
  GLA_LOAD(0);
  for (int ch = 0; ch < TPS / 32; ++ch) {
    const int p0 = ch * 32;
    __syncthreads();
    if (act) {
      float gl[16];
      unpack8(gl0, gl); unpack8(gl1, gl + 8);
#pragma unroll
      for (int e = 0; e < 8; ++e) {
        const int c = lc * 8 + e;
        float xv = sBi[c];
#pragma unroll
        for (int q = 0; q < 16; ++q) xv += gl[q] * sW2[q * 64 + c];
        sLa[lr * 64 + c] = logsigf_(xv) * (1.f / 16.f);
      }
    }
    __syncthreads();
    if (tid < 64) {
      float lv[32];
#pragma unroll
      for (int t = 0; t < 32; ++t) lv[t] = sLa[t * 64 + tid];
      float b = 0.f;
#pragma unroll
      for (int t = 0; t < 32; ++t) { b += lv[t]; sLa[t * 64 + tid] = b; }
    }
    __syncthreads();
    if (act) {
      float qf[8], kf[8], o[8];
      unpack8(gq, qf); unpack8(gk, kf);
#pragma unroll
      for (int e = 0; e < 8; ++e) { const float bb = sLa[lr * 64 + lc * 8 + e]; qf[e] *= 0.125f * __expf(bb); kf[e] *= __expf(-bb); }
      *(uint4*)(sQ + lr * 72 + lc * 8) = pack8(qf);
      *(uint4*)(sK + lr * 72 + lc * 8) = pack8(kf);
#pragma unroll
      for (int e = 0; e < 8; ++e) sKT[(lc * 8 + e) * 40 + lr] = f2bf(kf[e]);
      (void)o;
      const u16* pv0 = (const u16*)&v0; const u16* pv1 = (const u16*)&v1;
#pragma unroll
      for (int e = 0; e < 8; ++e) { sVT[(lc * 8 + e) * 40 + lr] = pv0[e]; sVT[(lc * 8 + 64 + e) * 40 + lr] = pv1[e]; }
    }
    if (ch + 1 < TPS / 32) GLA_LOAD(p0 + 32);
    __syncthreads();
    if (act) {
    f32x16 st;
#pragma unroll
    for (int i = 0; i < 16; ++i) st[i] = 0.f;
#pragma unroll
    for (int ks = 0; ks < 4; ++ks) {
      const bf16x8 a = *(const bf16x8*)(sK + r * 72 + 16 * ks + 8 * h);
      const bf16x8 b = *(const bf16x8*)(sQ + r * 72 + 16 * ks + 8 * h);
      st = MFMA(a, b, st);
    }
#pragma unroll
    for (int i = 0; i < 16; ++i) { if (crow(i, h) > r) st[i] = 0.f; }
    f32x16 o;
#pragma unroll
    for (int i = 0; i < 16; ++i) o[i] = 0.f;
#pragma unroll
    for (int mb = 0; mb < 2; ++mb)
#pragma unroll
      for (int s2 = 0; s2 < 2; ++s2) {
        const bf16x8 cb = pack_step(sacc[mb], s2);
        const u16* qp = sQ + r * 72 + 32 * mb + 16 * s2 + 4 * h;
        const bf16x8 a = cat4(*(const s16x4*)qp, *(const s16x4*)(qp + 8));
        o = MFMA(a, cb, o);
      }
#pragma unroll
    for (int s2 = 0; s2 < 2; ++s2) {
      const bf16x8 a = pack_step(st, s2);
      const u16* vp = sVT + (32 * w + r) * 40 + 16 * s2 + 4 * h;
      const bf16x8 b = cat4(*(const s16x4*)vp, *(const s16x4*)(vp + 8));
      o = MFMA(a, b, o);
    }
#pragma unroll
    for (int i = 0; i < 16; ++i) {
      const int row = scan_row(base, dir, p0 + crow(i, h));
      Y[(size_t)row * 512 + head * 128 + 32 * w + r] = f2bf(o[i]);
    }
#pragma unroll
    for (int mb = 0; mb < 2; ++mb) {
#pragma unroll
      for (int s2 = 0; s2 < 2; ++s2) {
        const bf16x8 a = *(const bf16x8*)(sKT + (32 * mb + r) * 40 + 16 * s2 + 8 * h);
        const bf16x8 b = *(const bf16x8*)(sVT + (32 * w + r) * 40 + 16 * s2 + 8 * h);
        sacc[mb] = MFMA(a, b, sacc[mb]);
      }
#pragma unroll
      for (int i = 0; i < 16; ++i) sacc[mb][i] *= __expf(sLa[31 * 64 + 32 * mb + crow(i, h)]);
    }
    }
  }
#undef GLA_LOAD
}

__device__ __forceinline__ void ph_scan0(const Ctx cx, CParams& p, char* smem) {
  for (int it = cx.bid; it < 2 * SPG * 8; it += gridDim.x) {
    __syncthreads();
    if (it < SPG * 8) mlstm_item(cx, p, it, smem); else gla_item(cx, p, it - SPG * 8, smem);
  }
}

__device__ __forceinline__ void ph_evout(const Ctx cx, CParams& p, int g) {
  const int lane = cx.tid & 63;
  const int gw = cx.bid * NWV + (cx.tid >> 6), nw = gridDim.x * NWV;
  const u16* Yb = p.BIG + (size_t)R * ZW;
  for (int row = gw; row < R; row += nw) {
    const int c0 = lane * 16;
    const int part = c0 >> 9, cc = c0 & 511;
    const u16* yf = Yb + ((size_t)(2 * part) * R + row) * 512 + cc;
    const u16* yb = Yb + ((size_t)(2 * part + 1) * R + row) * 512 + cc;
    float a[16], b[16];
    unpack8(*(const uint4*)yf, a); unpack8(*(const uint4*)(yf + 8), a + 8);
    unpack8(*(const uint4*)yb, b); unpack8(*(const uint4*)(yb + 8), b + 8);
    float ss = 0.f;
#pragma unroll
    for (int e = 0; e < 16; ++e) { a[e] += b[e]; ss += a[e] * a[e]; }
    ss += __shfl_xor(ss, 1); ss += __shfl_xor(ss, 2); ss += __shfl_xor(ss, 4);
    const float rstd = rsqrtf(ss * (1.f / 128.f) + 1e-6f);
    const u16* zg = p.BIG + (size_t)row * ZW + (part ? 3088 : 1536) + cc;
    float gt[16];
    unpack8(*(const uint4*)zg, gt); unpack8(*(const uint4*)(zg + 8), gt + 8);
#pragma unroll
    for (int e = 0; e < 16; ++e) {
      const float gv = part ? siluf_(gt[e]) : sigmoidf_(gt[e]);
      a[e] = a[e] * rstd * p.ev_head_g[c0 + e] * gv;
    }
    *(uint4*)(p.H + (size_t)row * D + c0) = pack8(a);
    *(uint4*)(p.H + (size_t)row * D + c0 + 8) = pack8(a + 8);
  }
}

__device__ __forceinline__ void ph_ffnact(const Ctx cx, CParams& p, int g, int layer, bool lat_only) {
  const float* cw = p.ffn_conv_w + (size_t)layer * 9 * DFF;
  const float* cb = p.ffn_conv_b + (size_t)layer * DFF;
  constexpr int SEG = 16, NSEG = TPS / SEG;
  const int total = SPG * NSEG * 352;
  for (int it = cx.bid * NTHR + cx.tid; it < total; it += gridDim.x * NTHR) {
    const int cg = it % 352, sg = (it / 352) % NSEG, s = it / (352 * NSEG);
    const int f0 = cg * 8;
    const int pos0 = sg * SEG;
    const bool isctx = pos0 < CTX;
    if (lat_only && isctx) continue;
    bool has_up = false, has_dn = false, has_l, has_r;
    if (isctx) { has_l = pos0 > 0; has_r = pos0 + SEG < CTX; }
    else { const int lp = pos0 - CTX, gr = lp >> 6, gc0 = lp & 63; has_up = gr > 0; has_dn = gr < 31; has_l = gc0 > 0; has_r = gc0 + SEG < 64; }
    float w[3][3][8], bias[8];
#pragma unroll
    for (int dh = 0; dh < 3; ++dh)
#pragma unroll
      for (int dw = 0; dw < 3; ++dw) {
        const float4 w0 = *(const float4*)(cw + (dh * 3 + dw) * DFF + f0), w1 = *(const float4*)(cw + (dh * 3 + dw) * DFF + f0 + 4);
        w[dh][dw][0] = w0.x; w[dh][dw][1] = w0.y; w[dh][dw][2] = w0.z; w[dh][dw][3] = w0.w;
        w[dh][dw][4] = w1.x; w[dh][dw][5] = w1.y; w[dh][dw][6] = w1.z; w[dh][dw][7] = w1.w;
      }
    { const float4 b0 = *(const float4*)(cb + f0), b1 = *(const float4*)(cb + f0 + 4);
      bias[0] = b0.x; bias[1] = b0.y; bias[2] = b0.z; bias[3] = b0.w; bias[4] = b1.x; bias[5] = b1.y; bias[6] = b1.z; bias[7] = b1.w; }
    u16* gu = p.BIG + (size_t)(s * TPS + pos0) * GUW + f0;
    float c0[3][8], c1[3][8], c2[3][8];
    uint4 nx[3];
#define FA_LD1(d, tok_, ok_) do { const bool o_ = (ok_); const uint4 r_ = *(const uint4*)(gu + (ptrdiff_t)(o_ ? (tok_) : 0) * GUW); \
      d.x = o_ ? r_.x : 0u; d.y = o_ ? r_.y : 0u; d.z = o_ ? r_.z : 0u; d.w = o_ ? r_.w : 0u; } while (0)
#define FA_LOAD(dst, tok, ok) do { FA_LD1(dst[1], (tok), (ok)); FA_LD1(dst[0], (tok) - 64, (ok) && has_up); FA_LD1(dst[2], (tok) + 64, (ok) && has_dn); } while (0)
    FA_LOAD(nx, -1, has_l);
    unpack8(nx[0], c0[0]); unpack8(nx[1], c0[1]); unpack8(nx[2], c0[2]);
    FA_LOAD(nx, 0, true);
    unpack8(nx[0], c1[0]); unpack8(nx[1], c1[1]); unpack8(nx[2], c1[2]);
    FA_LOAD(nx, 1, true);
#pragma unroll 2
    for (int t = 0; t < SEG; ++t) {
      unpack8(nx[0], c2[0]); unpack8(nx[1], c2[1]); unpack8(nx[2], c2[2]);
      const uint4 upraw = *(const uint4*)(gu + (ptrdiff_t)t * GUW + DFF);
      { const int tn = t + 2; const bool ok = (tn < SEG) || (tn == SEG && has_r); FA_LOAD(nx, tn, ok); }
      float acc[8];
#pragma unroll
      for (int e = 0; e < 8; ++e) {
        float a = bias[e];
#pragma unroll
        for (int dh = 0; dh < 3; ++dh) a += c0[dh][e] * w[dh][0][e] + c1[dh][e] * w[dh][1][e] + c2[dh][e] * w[dh][2][e];
        acc[e] = a;
      }
      float up[8]; unpack8(upraw, up);
#pragma unroll
      for (int e = 0; e < 8; ++e) {
        const float xg = acc[e];
        const float th = tanh_fast(0.7978845608028654f * (xg + 0.044715f * xg * xg * xg));
        up[e] *= 0.5f * xg * (1.f + th);
      }
      *(uint4*)(gu + (ptrdiff_t)t * GUW + DFF) = pack8(up);
#pragma unroll
      for (int dh = 0; dh < 3; ++dh)
#pragma unroll
        for (int e = 0; e < 8; ++e) { c0[dh][e] = c1[dh][e]; c1[dh][e] = c2[dh][e]; }
    }
#undef FA_LOAD
#undef FA_LD1
  }
}

__device__ __forceinline__ void ph_xx(const Ctx cx, CParams& p, int g) {
  const size_t total = (size_t)R * 128;
  for (size_t i = (size_t)cx.bid * NTHR + cx.tid; i < total; i += (size_t)gridDim.x * NTHR) {
    const int row = (int)(i >> 7), c0 = ((int)(i & 127)) * 8;
    int b, pos; rowinfo(g, row, b, pos);
    const int q = c0 >> 8;
    int off = 0; bool ok;
    if (pos < CTX) {
      if ((q & 1) == 0) { off = -1; ok = pos > 0; } else { off = 1; ok = pos < CTX - 1; }
    } else {
      const int lp = pos - CTX, gr = lp >> 6, gc = lp & 63;
      if (q == 0) { off = -1; ok = gc > 0; }
      else if (q == 1) { off = 1; ok = gc < 63; }
      else if (q == 2) { off = -64; ok = gr > 0; }
      else { off = 64; ok = gr < 31; }
    }
    float hc[8], hs[8];
    unpack8(*(const uint4*)(p.H + (size_t)row * D + c0), hc);
    if (ok) unpack8(*(const uint4*)(p.H + (size_t)(row + off) * D + c0), hs); else { for (int e = 0; e < 8; ++e) hs[e] = 0.f; }
#pragma unroll
    for (int e = 0; e < 8; ++e) hs[e] -= hc[e];
    *(uint4*)(p.QK + (size_t)row * D + c0) = pack8(hs);
    float m_[8];
    const size_t RS_ = (size_t)R * D;
#pragma unroll
    for (int e = 0; e < 8; ++e) m_[e] = hc[e] + hs[e] * p.rw_mu[0 * D + c0 + e];
    *(uint4*)(p.BIG + 3 * RS_ + (size_t)row * D + c0) = pack8(m_);
#pragma unroll
    for (int e = 0; e < 8; ++e) m_[e] = hc[e] + hs[e] * p.rw_mu[2 * D + c0 + e];
    *(uint4*)(p.BIG + 4 * RS_ + (size_t)row * D + c0) = pack8(m_);
#pragma unroll
    for (int e = 0; e < 8; ++e) m_[e] = hc[e] + hs[e] * p.rw_mu[3 * D + c0 + e];
    *(uint4*)(p.BIG + 5 * RS_ + (size_t)row * D + c0) = pack8(m_);
  }
}

__device__ __forceinline__ void ph_rwprep(const Ctx cx, CParams& p) {
  const int lane = cx.tid & 63;
  const int gw = cx.bid * NWV + (cx.tid >> 6), nw = gridDim.x * NWV;
  const size_t RS = (size_t)R * D;
  float* CS = (float*)p.LR;
  for (int row = gw; row < R; row += nw) {
    const int c0 = lane * 16;
    const size_t o = (size_t)row * D + c0;
    float rr[16], kk[16], aa[16], km[16], ka[16];
    unpack8(*(const uint4*)(p.BIG + o), rr); unpack8(*(const uint4*)(p.BIG + o + 8), rr + 8);
    unpack8(*(const uint4*)(p.BIG + RS + o), kk); unpack8(*(const uint4*)(p.BIG + RS + o + 8), kk + 8);
    unpack8(*(const uint4*)(p.BIG + 3 * RS + o), aa); unpack8(*(const uint4*)(p.BIG + 3 * RS + o + 8), aa + 8);
    float ss = 0.f;
#pragma unroll
    for (int e = 0; e < 16; ++e) {
      km[e] = bf2f(f2bf(kk[e] * (1.f + (aa[e] - 1.f) * p.rw_kvec[D + c0 + e])));
      kk[e] *= p.rw_kvec[c0 + e]; ss += kk[e] * kk[e];
    }
    ss += __shfl_xor(ss, 1); ss += __shfl_xor(ss, 2);
    const float inv = 1.f / fmaxf(sqrtf(ss), 1e-12f);
    float c1 = 0.f, c2 = 0.f;
#pragma unroll
    for (int e = 0; e < 16; ++e) {
      kk[e] *= inv; ka[e] = bf2f(f2bf(kk[e] * aa[e]));
      c1 += ka[e] * rr[e]; c2 += km[e] * rr[e];
    }
    c1 += __shfl_xor(c1, 1); c1 += __shfl_xor(c1, 2);
    c2 += __shfl_xor(c2, 1); c2 += __shfl_xor(c2, 2);
    *(uint4*)(p.BIG + RS + o) = pack8(kk); *(uint4*)(p.BIG + RS + o + 8) = pack8(kk + 8);
    *(uint4*)(p.BIG + 3 * RS + o) = pack8(ka); *(uint4*)(p.BIG + 3 * RS + o + 8) = pack8(ka + 8);
    *(uint4*)(p.H + o) = pack8(km); *(uint4*)(p.H + o + 8) = pack8(km + 8);
    if ((lane & 3) == 0) { float2 c; c.x = c1; c.y = c2; *(float2*)(CS + (size_t)row * 32 + (lane >> 2) * 2) = c; }
  }
}

__device__ __forceinline__ void ph_rwscan(const Ctx cx, CParams& p) {
  const int lane = cx.tid & 63, w = cx.tid >> 6;
  if (w >= 4) return;
  const int vq = lane >> 3, kq = lane & 7, hf = w & 1;
  const size_t RS = (size_t)R * D;
  const u16* Rb = p.BIG; const u16* KKb = p.BIG + RS; const u16* Vb = p.BIG + 2 * RS; const u16* KAb = p.BIG + 3 * RS; const u16* KMb = p.H;
  const float* CS = (const float*)p.LR;
  const int nblk = (SPG * 16 * 2) / 2;
  for (int bi = cx.bid; bi < nblk; bi += gridDim.x) {
    const int item = bi * 2 + (w >> 1);
    const int bl = item >> 5, head = (item >> 1) & 15, dir = item & 1;
    const u16* Wb = p.BIG + (size_t)(4 + dir) * RS;
    u16* Yb = (u16*)p.YO + (size_t)dir * RS;
    const int base = bl * TPS;
    const int colk = head * 64 + kq * 8, colv = head * 64 + hf * 32 + vq * 4;
    float S[4][8];
#pragma unroll
    for (int i = 0; i < 4; ++i)
#pragma unroll
      for (int e = 0; e < 8; ++e) S[i][e] = 0.f;
    char* dummy = (char*)p.LR + (size_t)R * 128 + (cx.tid & 511) * 8;
    constexpr int PF = 4;
    uint4 qr[PF], qkk[PF], qka[PF], qkm[PF], qw[PF]; uint2 qv[PF]; float2 qcs[PF]; int qrow[PF];
#define RW_LOAD(j, ps_) do { const int row_ = scan_row(base, dir, (ps_)); qrow[j] = row_; \
      const unsigned ok_ = (unsigned)(row_ * D + colk) * 2u, ov_ = (unsigned)(row_ * D + colv) * 2u, oc_ = (unsigned)(row_ * 32 + head * 2) * 4u; \
      qr[j] = *(const uint4*)((const char*)Rb + ok_); qkk[j] = *(const uint4*)((const char*)KKb + ok_); \
      qka[j] = *(const uint4*)((const char*)KAb + ok_); qkm[j] = *(const uint4*)((const char*)KMb + ok_); \
      qw[j] = *(const uint4*)((const char*)Wb + ok_); qv[j] = *(const uint2*)((const char*)Vb + ov_); \
      qcs[j] = *(const float2*)((const char*)CS + oc_); } while (0)
#pragma unroll
    for (int j = 0; j < PF; ++j) RW_LOAD(j, j);
    for (int ps0 = 0; ps0 < TPS; ps0 += PF) {
#pragma unroll
    for (int j = 0; j < PF; ++j) {
      const uint4 cr_ = qr[j], ckk = qkk[j], cka = qka[j], ckm = qkm[j], cw = qw[j]; const uint2 cv = qv[j]; const float2 cs = qcs[j];
      const int crow_ = qrow[j];
      { const int pn_ = ps0 + PF + j; RW_LOAD(j, pn_ < TPS ? pn_ : TPS - 1); }
      float wr[8], kk[8], wm1[8], vv[4], kka[8], km[8];
      unpack8(cr_, wr); unpack8(ckk, kk); unpack8(cka, kka); unpack8(ckm, km); unpack8(cw, wm1);
      vv[0] = lo16(cv.x); vv[1] = hi16(cv.x); vv[2] = lo16(cv.y); vv[3] = hi16(cv.y);
#pragma unroll
      for (int e = 0; e < 8; ++e) wr[e] += wr[e] * wm1[e];
      float sa[4], yo[4];
#pragma unroll
      for (int i = 0; i < 4; ++i) {
        float s = 0.f, t = 0.f;
#pragma unroll
        for (int e = 0; e < 8; ++e) { s += S[i][e] * kk[e]; t += S[i][e] * wr[e]; }
        sa[i] = s; yo[i] = t;
      }
#pragma unroll
      for (int i = 0; i < 4; ++i) { sa[i] = -red8(sa[i]); yo[i] = red8(yo[i]); }
#pragma unroll
      for (int i = 0; i < 4; ++i) {
#pragma unroll
        for (int e = 0; e < 8; ++e) {
          float t = S[i][e] + S[i][e] * wm1[e];
          t += sa[i] * kka[e];
          t += vv[i] * km[e];
          S[i][e] = t;
        }
        yo[i] += sa[i] * cs.x + vv[i] * cs.y;
      }
      { uint2 o; o.x = pack2(yo[0], yo[1]); o.y = pack2(yo[2], yo[3]);
        char* dst_ = (kq == 0) ? (char*)Yb + (unsigned)(crow_ * D + colv) * 2u : dummy;
        *(uint2*)dst_ = o; }
    }
    }
#undef RW_LOAD
  }
}

__device__ __forceinline__ void ph_rwout(const Ctx cx, CParams& p, int g) {
  const int lane = cx.tid & 63;
  const int gw = cx.bid * NWV + (cx.tid >> 6), nw = gridDim.x * NWV;
  const size_t RS = (size_t)R * D;
  for (int row = gw; row < R; row += nw) {
    int b, pos; rowinfo(g, row, b, pos);
    if (pos < CTX) continue;
    const int c0 = lane * 16;
    const size_t o = (size_t)row * D + c0;
    float yf[16], yb[16], rr[16], kk[16], vv[16], gg[16];
    const u16* Yy = (const u16*)p.YO;
    unpack8(*(const uint4*)(Yy + o), yf); unpack8(*(const uint4*)(Yy + o + 8), yf + 8);
    unpack8(*(const uint4*)(Yy + RS + o), yb); unpack8(*(const uint4*)(Yy + RS + o + 8), yb + 8);
    unpack8(*(const uint4*)(p.BIG + o), rr); unpack8(*(const uint4*)(p.BIG + o + 8), rr + 8);
    unpack8(*(const uint4*)(p.H + o), kk); unpack8(*(const uint4*)(p.H + o + 8), kk + 8);
    unpack8(*(const uint4*)(p.BIG + 2 * RS + o), vv); unpack8(*(const uint4*)(p.BIG + 2 * RS + o + 8), vv + 8);
    unpack8(*(const uint4*)(p.QK + o), gg); unpack8(*(const uint4*)(p.QK + o + 8), gg + 8);
    float s1 = 0.f, bon = 0.f;
#pragma unroll
    for (int e = 0; e < 16; ++e) {
      yf[e] += yb[e]; s1 += yf[e];
      bon += rr[e] * kk[e] * p.rw_kvec[2 * D + c0 + e];
    }
    s1 += __shfl_xor(s1, 1); s1 += __shfl_xor(s1, 2);
    bon += __shfl_xor(bon, 1); bon += __shfl_xor(bon, 2);
    const float mu = s1 * (1.f / 64.f);
    float s2 = 0.f;
#pragma unroll
    for (int e = 0; e < 16; ++e) { const float d = yf[e] - mu; s2 += d * d; }
    s2 += __shfl_xor(s2, 1); s2 += __shfl_xor(s2, 2);
    const float rstd = rsqrtf(s2 * (1.f / 64.f) + 64e-5f);
#pragma unroll
    for (int e = 0; e < 16; ++e) {
      const float yn = (yf[e] - mu) * rstd * p.rw_lnx[c0 + e] + p.rw_lnx[D + c0 + e];
      yf[e] = (yn + bon * vv[e]) * gg[e];
    }
    *(uint4*)(p.H + o) = pack8(yf);
    *(uint4*)(p.H + o + 8) = pack8(yf + 8);
  }
}

#define XB_TMO      128
#define XB_XCNT(j)  (256  + 64 * (j))
#define XB_XSUB(j)  (1280 + 64 * (j))
#define XB_XGEN(j)  (2304 + 64 * (j))
#define XB_TOP      3328
#define XB_TOPGEN   3392
#define XCD_BAR_WORDS 3456
#define XB_SPIN_CAP (1u << 20)
#define LAS __attribute__((address_space(3)))
DI unsigned xb_ld(unsigned* p)              { return __hip_atomic_load(p, __ATOMIC_RELAXED, __HIP_MEMORY_SCOPE_AGENT); }
DI unsigned xb_add(unsigned* p, unsigned v) { return __hip_atomic_fetch_add(p, v, __ATOMIC_RELAXED, __HIP_MEMORY_SCOPE_AGENT); }
DI unsigned xb_xcc_id() { return (unsigned)__builtin_amdgcn_s_getreg((3 << 11) | 20) & 0xFu; }
#define XB_SPIN(cond, bar) do { unsigned _sp = 0; while (cond) { __builtin_amdgcn_s_sleep(1); \
    if ((++_sp & 255u) == 0u) { if (xb_ld(&(bar)[XB_TMO])) break; if (_sp > XB_SPIN_CAP) { atomicAdd(&(bar)[XB_TMO], 1u); break; } } } } while (0)
struct XcdBarrier { unsigned* bar; unsigned x; volatile LAS unsigned* st; };
DI XcdBarrier xcd_barrier_post(unsigned* bar, volatile LAS unsigned* st) {
  XcdBarrier b; b.bar = bar; b.x = xb_xcc_id(); b.st = st;
  if (threadIdx.x == 0) (void)xb_add(&bar[XB_XCNT(b.x)], 1u);
  return b;
}
DI void xcd_barrier_complete(unsigned* bar, unsigned x, unsigned& nloc, unsigned& nx) {
  const unsigned G = gridDim.x * gridDim.y * gridDim.z;
  unsigned sum, cnt, mine, sp = 0u;
  for (;;) {
    sum = 0u; cnt = 0u; mine = 0u;
#pragma unroll
    for (unsigned j = 0; j < 16; ++j) { const unsigned c = xb_ld(&bar[XB_XCNT(j)]); sum += c; cnt += (c > 0u) ? 1u : 0u; mine = (j == x) ? c : mine; }
    if (sum == G) break;
    __builtin_amdgcn_s_sleep(1);
    if ((++sp & 255u) == 0u) { if (xb_ld(&bar[XB_TMO])) break; if (sp > XB_SPIN_CAP) { atomicAdd(&bar[XB_TMO], 1u); break; } }
  }
  nloc = mine > 0u ? mine : 1u; nx = cnt > 0u ? cnt : 1u;
}
DI void xcd_barrier(const XcdBarrier& b) {
  asm volatile("s_waitcnt vmcnt(0)" ::: "memory");
  __syncthreads();
  if (threadIdx.x == 0) {
    unsigned* bar = b.bar;
    __builtin_amdgcn_s_waitcnt(0);
    unsigned nloc = b.st[0], nx = b.st[1];
    if (nloc == 0u) { xcd_barrier_complete(bar, b.x, nloc, nx); b.st[0] = nloc; b.st[1] = nx; }
    const unsigned old = xb_add(&bar[XB_XSUB(b.x)], 1u);
    const unsigned gen = old / nloc;
    if (old + 1u == (gen + 1u) * nloc) {
      __builtin_amdgcn_fence(__ATOMIC_RELEASE, "agent");
      asm volatile("s_waitcnt vmcnt(0)" ::: "memory");
      const unsigned og = xb_add(&bar[XB_TOP], 1u);
      const unsigned tg = og / nx;
      if (og + 1u == (tg + 1u) * nx) xb_add(&bar[XB_TOPGEN], 1u);
      else XB_SPIN(xb_ld(&bar[XB_TOPGEN]) == tg, bar);
      __builtin_amdgcn_fence(__ATOMIC_ACQUIRE, "agent");
      xb_add(&bar[XB_XGEN(b.x)], 1u);
      asm volatile("s_waitcnt vmcnt(0)" ::: "memory");
    } else {
      XB_SPIN(xb_ld(&bar[XB_XGEN(b.x)]) == gen, bar);
      __builtin_amdgcn_fence(__ATOMIC_ACQUIRE, "agent");
      asm volatile("s_waitcnt vmcnt(0)" ::: "memory");
    }
  }
  __syncthreads();
}

__global__ void __launch_bounds__(NTHR) fwd_megakernel(Params p_arg) {
  cg::grid_group grid = cg::this_grid();
  __shared__ __attribute__((aligned(1024))) char smem[2 * STAGE_B + 16384];
  const size_t RS = (size_t)R * D;
  (void)RS;
  __shared__ uint4 xb_words;
  if (threadIdx.x == 0) xb_words = make_uint4(0u, 0u, 0u, 0u);
  __syncthreads();
  const XcdBarrier xb = xcd_barrier_post(((CParams*)__builtin_amdgcn_kernarg_segment_ptr())->bar, (volatile LAS unsigned*)&xb_words);
  {
    Ctx cx; cx.tid = threadIdx.x; cx.bid = blockIdx.x;
    CParams* pp = (CParams*)__builtin_amdgcn_kernarg_segment_ptr();
    ph_prologue(cx, *pp, (float*)smem);
  }
  const int wave_s = __builtin_amdgcn_readfirstlane((int)threadIdx.x >> 6);
  grid.sync();
#pragma nounroll
  for (int it2 = 0; it2 < NG * NPH * 2; ++it2) {
    const int it = it2 >> 1;
    const int g = it / NPH, ph = it - g * NPH;
    if (it2 & 1) continue;
    const unsigned long long tp0 = PROBE_MASK ? wall_clock64() : 0ull;
    Ctx cx;
    {
      int t_ = (wave_s << 6) | (int)__builtin_amdgcn_mbcnt_hi(~0u, __builtin_amdgcn_mbcnt_lo(~0u, 0u));
      int b_ = blockIdx.x; asm volatile("" : "+v"(t_), "+s"(b_)); cx.tid = t_; cx.bid = b_; }
    CParams* pp = (CParams*)__builtin_amdgcn_kernarg_segment_ptr();
    asm volatile("" : "+s"(pp));
    CParams& p = *pp;
    switch (ph) {
      case 0: ph_norm0(cx, p, g); break;
      case 1: gemm256(cx, p.H, p.H, 1 << 30, D, p.wt_in, D, ZW / 256, false, EpBf16{p.BIG, ZW}, smem); break;
      case 2: ph_qkconv(cx, p, g); break;
      case 3: ph_scan0(cx, p, smem); break;
      case 4: ph_evout(cx, p, g); break;
      case 5: gemm256(cx, p.H, p.H, 1 << 30, D, p.wt_out, D, 4, false, EpBf16{(u16*)p.YO, D}, smem); break;
      case 6: ph_resid(cx, p, g, 0, 0, false); break;
      case 7: gemm256(cx, p.H, p.H, 1 << 30, D, p.wt_up, D, GUW / 256, false, EpBf16{p.BIG, GUW}, smem); break;
      case 8: ph_ffnact(cx, p, g, 0, false); break;
      case 9: gemm256(cx, p.BIG + DFF, p.BIG + DFF, 1 << 30, GUW, p.wt_down, DFF, 4, false, EpBf16{(u16*)p.YO, D}, smem); break;
      case 10: ph_resid(cx, p, g, 0, 1, false); break;
      case 11: ph_xx(cx, p, g); break;
      case 12: gemm256<true>(cx, p.H, p.QK, D, D, p.wt_1, K1, N1 / 256, false, EpRw1{p.BIG, p.LR}, smem, p.BIG + 3 * RS); break;
      case 13: gemm256(cx, p.LR, p.LR, 1 << 30, K2, p.wt_2, K2, N2 / 256, false, EpRw2{p.BIG, p.QK, p.rw_w0, p.rw_a0}, smem); break;
      case 14: ph_rwprep(cx, p); break;
      case 15: ph_rwscan(cx, p); break;
      case 16: ph_rwout(cx, p, g); break;
      case 17: gemm256(cx, p.H, p.H, 1 << 30, D, p.wt_o, D, 4, true, EpBf16{(u16*)p.YO, D}, smem); break;
      case 18: ph_resid(cx, p, g, 1, 0, true); break;
      case 19: gemm256(cx, p.H, p.H, 1 << 30, D, p.wt_up + (size_t)GUW * D, D, GUW / 256, true, EpBf16{p.BIG, GUW}, smem); break;
      case 20: ph_ffnact(cx, p, g, 1, true); break;
      case 21: gemm256(cx, p.BIG + DFF, p.BIG + DFF, 1 << 30, GUW, p.wt_down + (size_t)D * DFF, DFF, 4, true, EpBf16{(u16*)p.YO, D}, smem); break;
      default: ph_resid(cx, p, g, 1, 1, true); break;
    }
    xcd_barrier(xb);
    if (PROBE_MASK && ((PROBE_MASK >> ph) & 1u)) {
      const unsigned long long tp1 = wall_clock64();
      while (wall_clock64() - tp1 < tp1 - tp0) __builtin_amdgcn_s_sleep(8);
    }
  }
}

extern "C" void kernel_launch(void* const* d_in, const int* in_sizes, int n_in, void* d_out, int out_size, void* d_ws,
                              size_t ws_size, hipStream_t stream) {
  static int grid_blocks = 0;
  if (!grid_blocks) {
    int dev = 0, cus = 0, per_cu = 0;
    hipGetDevice(&dev);
    hipDeviceGetAttribute(&cus, hipDeviceAttributeMultiprocessorCount, dev);
    hipOccupancyMaxActiveBlocksPerMultiprocessor(&per_cu, fwd_megakernel, NTHR, 0);
    if (per_cu > 1) per_cu = 1;
    if (per_cu < 1) per_cu = 1;
    grid_blocks = cus * per_cu;
  }
  Params p{};
  const float** f = (const float**)&p;
  for (int i = 0; i < 32; ++i) f[i] = (const float*)d_in[i];
  p.out = (float*)d_out;
  char* ws = (char*)d_ws;
  size_t off = 0;
  auto take = [&](size_t bytes) { char* q = ws + off; off += (bytes + 255) & ~(size_t)255; return q; };
  p.wt_in = (u16*)take((size_t)ZW * D * 2);
  p.wt_out = (u16*)take((size_t)D * D * 2);
  p.wt_up = (u16*)take((size_t)2 * GUW * D * 2);
  p.wt_down = (u16*)take((size_t)2 * D * DFF * 2);
  p.wt_o = (u16*)take((size_t)D * D * 2);
  p.wt_1 = (u16*)take((size_t)N1 * K1 * 2);
  p.wt_2 = (u16*)take((size_t)N2 * K2 * 2);
  p.mod = (float*)take((size_t)2 * 33 * 6144 * 4);
  p.xc = (float*)take((size_t)NB * CTX * D * 4);
  p.H = (u16*)take((size_t)R * D * 2);
  p.BIG = (u16*)take((size_t)6 * R * D * 2);
  p.QK = (u16*)take((size_t)R * D * 2);
  p.YO = (float*)take((size_t)R * D * 4);
  p.LR = (u16*)take((size_t)R * K2 * 2);
  p.bar = (unsigned*)take((size_t)XCD_BAR_WORDS * 4);
  if (off > ws_size) { fprintf(stderr, "workspace too small: need %zu have %zu\n", off, ws_size); return; }
  hipMemsetAsync(p.bar, 0, (size_t)XCD_BAR_WORDS * 4, stream);
  void* args[] = {&p};
  hipError_t e = hipLaunchCooperativeKernel((void*)fwd_megakernel, dim3(grid_blocks), dim3(NTHR), args, 0, stream);
  if (e != hipSuccess) fprintf(stderr, "cooperative launch failed: %s (grid %d)\n", hipGetErrorString(e), grid_blocks);
}
```

```cpp
#include <hip/hip_runtime.h>
#include <hip/hip_cooperative_groups.h>
#include <cstdio>
namespace cg = cooperative_groups;

typedef unsigned short u16;
using bf16x8 = __attribute__((ext_vector_type(8))) short;
using s16x4  = __attribute__((ext_vector_type(4))) short;
using f32x16 = __attribute__((ext_vector_type(16))) float;
#define DI __device__ __forceinline__
#define MFMA(a, b, c) __builtin_amdgcn_mfma_f32_32x32x16_bf16((a), (b), (c), 0, 0, 0)

constexpr int D = 1024, NB = 32, SEQ = 2048, CTX = 256, TPS = 2304;
constexpr int NG = 2, SPG = 16, R = SPG * TPS;
constexpr int ZW = 3840;
constexpr int DFF = 2816, GUW = 5632;
constexpr int NTHR = 512, NWV = NTHR / 64, NPH = 23;
constexpr int N1 = 3584, K1 = 2048, N2 = 4096, K2 = 320;
#ifndef PROBE_MASK_V
#define PROBE_MASK_V 0u
#endif
constexpr unsigned PROBE_MASK = PROBE_MASK_V;

struct Ctx { int tid, bid; };
struct Params {
  const float *x, *c, *ctx, *c_ctx, *w_mod, *b_mod, *norm_g, *ffn_w_up, *ffn_conv_w, *ffn_conv_b, *ffn_w_down,
      *ev_w_in, *ev_b_gates, *ev_conv_w, *ev_conv_b, *ev_gla_w2, *ev_gla_b, *ev_head_g, *ev_w_out,
      *rw_mu, *rw_w_rkv, *rw_w_o, *rw_w0, *rw_w1, *rw_w2, *rw_a0, *rw_a1, *rw_a2, *rw_g1, *rw_g2, *rw_kvec, *rw_lnx;
  float* out;
  u16 *wt_in, *wt_out, *wt_up, *wt_down, *wt_o, *wt_1, *wt_2;
  float* mod; float* xc;
  u16* H; u16* BIG; u16* QK; float* YO; u16* LR; unsigned* bar;
};

typedef const __attribute__((address_space(4))) Params CParams;

DI float bf2f(u16 v) { return __uint_as_float(((unsigned)v) << 16); }
typedef __bf16 bf16x2_t __attribute__((ext_vector_type(2)));
typedef float f32x2_t __attribute__((ext_vector_type(2)));
DI unsigned pack2(float a, float b) { f32x2_t v; v.x = a; v.y = b; return __builtin_bit_cast(unsigned, __builtin_convertvector(v, bf16x2_t)); }
DI u16 f2bf(float f) { return (u16)(pack2(f, 0.f) & 0xffffu); }
DI float lo16(unsigned u) { return __uint_as_float(u << 16); }
DI float hi16(unsigned u) { return __uint_as_float(u & 0xffff0000u); }
DI void unpack8(const uint4& v, float* o) {
  o[0] = lo16(v.x); o[1] = hi16(v.x); o[2] = lo16(v.y); o[3] = hi16(v.y);
  o[4] = lo16(v.z); o[5] = hi16(v.z); o[6] = lo16(v.w); o[7] = hi16(v.w);
}
DI uint4 pack8(const float* o) { uint4 v; v.x = pack2(o[0], o[1]); v.y = pack2(o[2], o[3]); v.z = pack2(o[4], o[5]); v.w = pack2(o[6], o[7]); return v; }
DI int crow(int reg, int h) { return (reg & 3) + 8 * (reg >> 2) + 4 * h; }
DI float wsum(float v) { for (int o = 32; o; o >>= 1) v += __shfl_xor(v, o); return v; }
DI float sigmoidf_(float x) { return 1.f / (1.f + __expf(-x)); }
DI float logsigf_(float x) { return fminf(x, 0.f) - log1pf(__expf(-fabsf(x))); }
DI float siluf_(float x) { return x / (1.f + __expf(-x)); }
DI bf16x8 cat4(s16x4 lo, s16x4 hi) { return __builtin_shufflevector(lo, hi, 0, 1, 2, 3, 4, 5, 6, 7); }
DI bf16x8 pack_step(const f32x16& x, int s) {
  uint4 v;
  v.x = pack2(x[8 * s + 0], x[8 * s + 1]); v.y = pack2(x[8 * s + 2], x[8 * s + 3]);
  v.z = pack2(x[8 * s + 4], x[8 * s + 5]); v.w = pack2(x[8 * s + 6], x[8 * s + 7]);
  return __builtin_bit_cast(bf16x8, v);
}
DI float dppf(float x, int) { return x; }
#define DPP_F(x, ctrl) __int_as_float(__builtin_amdgcn_update_dpp(0, __float_as_int(x), (ctrl), 0xF, 0xF, true))
DI float red8(float x) {
  x += DPP_F(x, 0x141);
  x += DPP_F(x, 0xB1);
  x += DPP_F(x, 0x4E);
  return x;
}

DI int scan_row(int base, int dir, int p) {
  if (dir == 0) return base + p;
  return (p < CTX) ? base + (CTX - 1 - p) : base + (TPS + CTX - 1 - p);
}

__device__ __forceinline__ void convert_job(const Ctx cx, const float* __restrict__ src, int K, int N, int Npad, u16* __restrict__ dst, int ldd, const float* __restrict__ mu, float* tile) {
  const int tx = cx.tid & 31, ty = cx.tid >> 5;
  const int tk = K >> 5, tn = Npad >> 5;
  for (int t = cx.bid; t < tk * tn; t += gridDim.x) {
    const int k0 = (t / tn) * 32, n0 = (t % tn) * 32;
#pragma unroll
    for (int i = 0; i < 2; ++i) {
      const int kk = k0 + ty + 16 * i, nn = n0 + tx;
      float v = (nn < N) ? src[(size_t)kk * N + nn] : 0.f;
      if (mu) v *= mu[kk];
      tile[(ty + 16 * i) * 33 + tx] = v;
    }
    __syncthreads();
#pragma unroll
    for (int i = 0; i < 2; ++i) {
      const int nn = n0 + ty + 16 * i, kk = k0 + tx;
      dst[(size_t)nn * ldd + kk] = f2bf(tile[tx * 33 + ty + 16 * i]);
    }
    __syncthreads();
  }
}

__device__ __forceinline__ void ph_mod(const Ctx cx, CParams& p, float* smem) {
  const int tid = cx.tid, lane = tid & 63, w = tid >> 6;
  float* sc = smem + w * (33 * 64);
  for (int u = cx.bid; u < 2 * 96; u += gridDim.x) {
    const int layer = u / 96, n = (u % 96) * 64 + lane;
    const float* W = p.w_mod + (size_t)layer * D * 6144;
    float acc[33];
#pragma unroll
    for (int i = 0; i < 33; ++i) acc[i] = 0.f;
    for (int kc = 0; kc < 2; ++kc) {
      const int k0 = w * 128 + kc * 64;
#pragma nounroll
      for (int cr = 0; cr < 33; ++cr) {
        const float v = (cr < 32) ? p.c[cr * D + k0 + lane] : p.c_ctx[k0 + lane];
        sc[cr * 64 + lane] = siluf_(v);
      }
      __syncthreads();
#pragma unroll 2
      for (int j = 0; j < 64; ++j) {
        const float wv = W[(size_t)(k0 + j) * 6144 + n];
#pragma unroll
        for (int cr = 0; cr < 33; ++cr) acc[cr] += sc[cr * 64 + j] * wv;
      }
      __syncthreads();
    }
#pragma unroll
    for (int cr = 0; cr < 33; ++cr) sc[cr * 64 + lane] = acc[cr];
    __syncthreads();
    if (w == 0) {
      const float bm = p.b_mod[layer * 6144 + n];
      for (int cr = 0; cr < 33; ++cr) {
        float s = 0.f;
#pragma unroll
        for (int q = 0; q < NWV; ++q) s += smem[q * 33 * 64 + cr * 64 + lane];
        p.mod[((size_t)layer * 33 + cr) * 6144 + n] = s + bm;
      }
    }
    __syncthreads();
  }
}

__device__ __forceinline__ void ph_prologue(const Ctx cx, CParams& p, float* smem) {
  ph_mod(cx, p, smem);
  convert_job(cx, p.ev_w_in, D, 3632, ZW, p.wt_in, D, nullptr, smem);
  convert_job(cx, p.ev_w_out, D, D, D, p.wt_out, D, nullptr, smem);
  for (int l = 0; l < 2; ++l) {
    convert_job(cx, p.ffn_w_up + (size_t)l * D * GUW, D, GUW, GUW, p.wt_up + (size_t)l * GUW * D, D, nullptr, smem);
    convert_job(cx, p.ffn_w_down + (size_t)l * DFF * D, DFF, D, D, p.wt_down + (size_t)l * D * DFF, DFF, nullptr, smem);
  }
  convert_job(cx, p.rw_w_o, D, D, D, p.wt_o, D, nullptr, smem);
  for (int half = 0; half < 2; ++half) {
    u16* dcol = p.wt_1 + half * D;
    const float* m0 = half ? p.rw_mu : nullptr;
    convert_job(cx, p.rw_w_rkv, D, D, D, dcol, K1, half ? m0 + 0 * D : nullptr, smem);
    convert_job(cx, p.rw_w_rkv + (size_t)D * D, D, D, D, dcol + (size_t)1024 * K1, K1, half ? m0 + 2 * D : nullptr, smem);
    convert_job(cx, p.rw_w_rkv + (size_t)2 * D * D, D, D, D, dcol + (size_t)2048 * K1, K1, half ? m0 + 3 * D : nullptr, smem);
    convert_job(cx, p.rw_w1, D, 64, 64, dcol + (size_t)3072 * K1, K1, half ? m0 + 1 * D : nullptr, smem);
    convert_job(cx, p.rw_w1 + D * 64, D, 64, 64, dcol + (size_t)3136 * K1, K1, half ? m0 + 1 * D : nullptr, smem);
    convert_job(cx, p.rw_a1, D, 64, 64, dcol + (size_t)3200 * K1, K1, half ? m0 + 4 * D : nullptr, smem);
    convert_job(cx, p.rw_g1, D, 128, 320, dcol + (size_t)3264 * K1, K1, half ? m0 + 5 * D : nullptr, smem);
  }
  for (size_t i = (size_t)cx.bid * NTHR + cx.tid; i < (size_t)N2 * K2; i += (size_t)gridDim.x * NTHR) {
    const int n = (int)(i / K2), c = (int)(i % K2), blk = n >> 10, nn = n & 1023;
    float v = 0.f;
    if (blk == 0) { if (c < 64) v = p.rw_w2[(size_t)c * D + nn]; }
    else if (blk == 1) { if (c >= 64 && c < 128) v = p.rw_w2[(size_t)(64 + c - 64) * D + nn]; }
    else if (blk == 2) { if (c >= 128 && c < 192) v = p.rw_a2[(size_t)(c - 128) * D + nn]; }
    else { if (c >= 192) v = p.rw_g2[(size_t)(c - 192) * D + nn]; }
    p.wt_2[i] = f2bf(v);
  }
}

DI void rowinfo(int g, int row, int& b, int& pos) { const int bl = row / TPS; pos = row - bl * TPS; b = g * SPG + bl; }

__device__ __forceinline__ void ph_norm0(const Ctx cx, CParams& p, int g) {
  const int lane = cx.tid & 63;
  const int gw = cx.bid * NWV + (cx.tid >> 6), nw = gridDim.x * NWV;
  for (int row = gw; row < R; row += nw) {
    int b, pos; rowinfo(g, row, b, pos);
    const float* src = (pos < CTX) ? p.ctx + ((size_t)(b * CTX + pos)) * D : p.x + ((size_t)(b * SEQ + pos - CTX)) * D;
    const float* md = p.mod + ((size_t)(pos < CTX ? 32 : b)) * 6144;
    float4 v[4]; float ss = 0.f;
#pragma unroll
    for (int j = 0; j < 4; ++j) { v[j] = ((const float4*)src)[j * 64 + lane]; ss += v[j].x * v[j].x + v[j].y * v[j].y + v[j].z * v[j].z + v[j].w * v[j].w; }
    ss = wsum(ss);
    const float rstd = rsqrtf(ss * (1.f / D) + 1e-6f);
#pragma unroll
    for (int j = 0; j < 4; ++j) {
      const int col = j * 256 + lane * 4;
      const float4 gg = *(const float4*)(p.norm_g + col);
      const float4 sh = *(const float4*)(md + col), sc = *(const float4*)(md + D + col);
      uint2 o;
      o.x = pack2(v[j].x * rstd * gg.x * (1.f + sc.x) + sh.x, v[j].y * rstd * gg.y * (1.f + sc.y) + sh.y);
      o.y = pack2(v[j].z * rstd * gg.z * (1.f + sc.z) + sh.z, v[j].w * rstd * gg.w * (1.f + sc.w) + sh.w);
      *(uint2*)(p.H + (size_t)row * D + col) = o;
    }
  }
}

__device__ __forceinline__ void ph_resid(const Ctx cx, CParams& p, int g, int layer, int which, bool lat_only) {
  const int lane = cx.tid & 63;
  const int gw = cx.bid * NWV + (cx.tid >> 6), nw = gridDim.x * NWV;
  const bool from_inputs = (layer == 0 && which == 0);
  const bool has_next = (which == 0) || (layer + 1 < 2);
  const bool final_out = !has_next;
  const float* ga = p.norm_g + (layer * 4 + (which ? 3 : 1)) * D;
  const float* gb = (which == 0) ? p.norm_g + (layer * 4 + 2) * D : p.norm_g + ((layer + 1) * 4 + 0) * D;
  for (int row = gw; row < R; row += nw) {
    int b, pos; rowinfo(g, row, b, pos);
    if (lat_only && pos < CTX) continue;
    const size_t ridx = (pos < CTX) ? ((size_t)(b * CTX + pos)) * D : ((size_t)(b * SEQ + pos - CTX)) * D;
    const float* src = from_inputs ? ((pos < CTX) ? p.ctx + ridx : p.x + ridx) : ((pos < CTX) ? p.xc + ridx : p.out + ridx);
    float* dst = (pos < CTX) ? p.xc + ridx : p.out + ridx;
    const int cr = (pos < CTX) ? 32 : b;
    const float* md = p.mod + ((size_t)layer * 33 + cr) * 6144;
    const float* mdn = (which == 0) ? md + 3 * D : p.mod + ((size_t)(layer + 1) * 33 + cr) * 6144;
    const float* gate = md + (which ? 5 : 2) * D;
    const u16* yo = (const u16*)p.YO + (size_t)row * D;
    float4 y[4], xv[4]; float ss = 0.f;
#pragma unroll
    for (int j = 0; j < 4; ++j) {
      const uint2 yb = ((const uint2*)yo)[j * 64 + lane];
      y[j].x = lo16(yb.x); y[j].y = hi16(yb.x); y[j].z = lo16(yb.y); y[j].w = hi16(yb.y);
      if (from_inputs) xv[j] = ((const float4*)src)[j * 64 + lane];
      else { const uint2 xb = ((const uint2*)src)[j * 64 + lane]; xv[j].x = lo16(xb.x); xv[j].y = hi16(xb.x); xv[j].z = lo16(xb.y); xv[j].w = hi16(xb.y); }
      ss += y[j].x * y[j].x + y[j].y * y[j].y + y[j].z * y[j].z + y[j].w * y[j].w; }
    ss = wsum(ss);
    const float rstd = rsqrtf(ss * (1.f / D) + 1e-6f);
    float s2 = 0.f;
#pragma unroll
    for (int j = 0; j < 4; ++j) {
      const int col = j * 256 + lane * 4;
      const float4 g4 = *(const float4*)(ga + col), gt = *(const float4*)(gate + col);
      xv[j].x += gt.x * (y[j].x * rstd * g4.x); xv[j].y += gt.y * (y[j].y * rstd * g4.y);
      xv[j].z += gt.z * (y[j].z * rstd * g4.z); xv[j].w += gt.w * (y[j].w * rstd * g4.w);
      if (final_out) ((float4*)dst)[j * 64 + lane] = xv[j];
      else {
        uint2 xo; xo.x = pack2(xv[j].x, xv[j].y); xo.y = pack2(xv[j].z, xv[j].w);
        ((uint2*)dst)[j * 64 + lane] = xo;
        xv[j].x = lo16(xo.x); xv[j].y = hi16(xo.x); xv[j].z = lo16(xo.y); xv[j].w = hi16(xo.y);
      }
      s2 += xv[j].x * xv[j].x + xv[j].y * xv[j].y + xv[j].z * xv[j].z + xv[j].w * xv[j].w;
    }
    if (has_next) {
      s2 = wsum(s2);
      const float r2 = rsqrtf(s2 * (1.f / D) + 1e-6f);
#pragma unroll
      for (int j = 0; j < 4; ++j) {
        const int col = j * 256 + lane * 4;
        const float4 gg = *(const float4*)(gb + col);
        const float4 sh = *(const float4*)(mdn + col), sc = *(const float4*)(mdn + D + col);
        uint2 o;
        o.x = pack2(xv[j].x * r2 * gg.x * (1.f + sc.x) + sh.x, xv[j].y * r2 * gg.y * (1.f + sc.y) + sh.y);
        o.y = pack2(xv[j].z * r2 * gg.z * (1.f + sc.z) + sh.z, xv[j].w * r2 * gg.w * (1.f + sc.w) + sh.w);
        *(uint2*)(p.H + (size_t)row * D + col) = o;
      }
    }
  }
}

using f32x4 = __attribute__((ext_vector_type(4))) float;
using i32x4 = __attribute__((ext_vector_type(4))) int;
DI int lds_byte(int r, int c) {
  const int st = (r >> 4) * 2 + (c >> 5), ob = (r & 15) * 64 + (c & 31) * 2;
  return st * 1024 + (ob ^ (((ob >> 9) & 1) << 5));
}
DI void stage_rc(int b, int& Rr, int& Cc) {
  const int st = b >> 10, sb = b & 1023, swz = sb ^ (((sb >> 9) & 1) << 5);
  Rr = (st >> 1) * 16 + swz / 64;
  Cc = (st & 1) * 32 + (swz % 64) / 2;
}
constexpr int TILE_B = 256 * 64 * 2, STAGE_B = 2 * TILE_B;

DI const char* uni_ptr(const char* q) {
  const unsigned long long a = (unsigned long long)q;
  const unsigned lo = (unsigned)__builtin_amdgcn_readfirstlane((int)(unsigned)a), hi = (unsigned)__builtin_amdgcn_readfirstlane((int)(unsigned)(a >> 32));
  return (const char*)(((unsigned long long)hi << 32) | lo);
}
struct GUnit { const u16* A0; const u16* Bb; int ksplit, nt, brow, bcol; };
template <bool RW1>
DI GUnit gemm_unit(int u, int nN, int nMx, int xcd, bool lat_only, const u16* A0in, const u16* A2, int ksplit_in, int Kin, const u16* Bt, int ldb) {
  constexpr int GM = 4;
  const int grp = u / (GM * nN), fm = grp * GM, gsz = (nMx - fm) < GM ? (nMx - fm) : GM;
  const int rr_ = u - grp * (GM * nN);
  const int pn0 = rr_ / gsz, ml = fm + (rr_ - pn0 * gsz), pm = ml * 8 + xcd;
  int pn = pn0;
  if constexpr (RW1) pn = (pn0 < 2) ? pn0 + 12 : pn0 - 2;
  GUnit g;
  g.brow = lat_only ? ((pm >> 3) * 9 + 1 + (pm & 7)) * 256 : pm * 256;
  g.bcol = pn * 256;
  g.A0 = A0in; g.ksplit = ksplit_in; int K = Kin;
  if constexpr (RW1) { if (pn < 12) { g.A0 = A2 + (size_t)(pn >> 2) * ((size_t)R * D); g.ksplit = 1 << 30; K = D; } }
  g.nt = K >> 6;
  g.Bb = Bt + (size_t)g.bcol * ldb;
  return g;
}
template <bool RW1 = false, class EP>
__device__ __forceinline__ void gemm256(const Ctx cx, const u16* __restrict__ A0in, const u16* __restrict__ A1, int ksplit_in, int lda,
                        const u16* __restrict__ Bt, int Kin, int nN, bool lat_only, const EP& ep, char* shm, const u16* __restrict__ A2 = nullptr) {
  const int wsg = __builtin_amdgcn_readfirstlane(cx.tid >> 6);
  const int wid = wsg, lane = cx.tid & 63;
  const int nM = lat_only ? SPG * 8 : R / 256;
  const int ldb = Kin;
  const int fragA = lds_byte((wsg >> 2) * 128 + (lane & 15), (lane >> 4) * 8), fragB = lds_byte((wsg & 3) * 64 + (lane & 15), (lane >> 4) * 8);
  const int xcd = cx.bid & 7, slot = cx.bid >> 3, nslot = gridDim.x >> 3, per_xcd = (nM >> 3) * nN;
  const int nMx = nM >> 3;
  if (slot < per_xcd) {
#define G_STAGE(buf, kt, UU, AO, BO) do { const int kb_ = (kt) * 64; const size_t ro_ = (size_t)(UU).brow * lda; \
    const char* Ab0_ = (const char*)((kb_ < (UU).ksplit) ? (UU).A0 + ro_ + kb_ : A1 + ro_ + (kb_ - (UU).ksplit)); \
    const char* Bb0_ = (const char*)((UU).Bb + kb_); \
    _Pragma("unroll") for (int i = 0; i < 4; ++i) { \
      const char* Ab_ = uni_ptr(Ab0_ + (size_t)i * 128 * lda); const char* Bb_ = uni_ptr(Bb0_ + (size_t)i * 128 * ldb);     \
      __builtin_amdgcn_global_load_lds((const unsigned*)(Ab_ + AO), (__attribute__((address_space(3))) unsigned*)(shm + (buf) * STAGE_B + wid * 1024 + i * 8192), 16, 0, 0); \
      __builtin_amdgcn_global_load_lds((const unsigned*)(Bb_ + BO), (__attribute__((address_space(3))) unsigned*)(shm + (buf) * STAGE_B + TILE_B + wid * 1024 + i * 8192), 16, 0, 0); } } while (0)
#define G_STAGE1(buf, kt, UU, AO, BO, i) do { const int kb_ = (kt) * 64; const size_t ro_ = (size_t)(UU).brow * lda; \
    const char* Ab0_ = (const char*)((kb_ < (UU).ksplit) ? (UU).A0 + ro_ + kb_ : A1 + ro_ + (kb_ - (UU).ksplit)); \
    const char* Bb0_ = (const char*)((UU).Bb + kb_); \
    const char* Ab_ = uni_ptr(Ab0_ + (size_t)(i) * 128 * lda); const char* Bb_ = uni_ptr(Bb0_ + (size_t)(i) * 128 * ldb); \
    __builtin_amdgcn_global_load_lds((const unsigned*)(Ab_ + AO), (__attribute__((address_space(3))) unsigned*)(shm + (buf) * STAGE_B + wid * 1024 + (i) * 8192), 16, 0, 0); \
    __builtin_amdgcn_global_load_lds((const unsigned*)(Bb_ + BO), (__attribute__((address_space(3))) unsigned*)(shm + (buf) * STAGE_B + TILE_B + wid * 1024 + (i) * 8192), 16, 0, 0); } while (0)
#define G_OFFS(UU, AO, BO) do { int sR, sC; stage_rc(wid * 1024 + lane * 16, sR, sC); \
      AO = (unsigned)((sR * lda + sC) * 2); BO = (unsigned)((sR * ldb + sC) * 2); } while (0)
  int u = slot;
  GUnit cu = gemm_unit<RW1>(u, nN, nMx, xcd, lat_only, A0in, A2, ksplit_in, Kin, Bt, ldb);
  unsigned aoff, boff;
  G_OFFS(cu, aoff, boff);
  G_STAGE(0, 0, cu, aoff, boff);
  asm volatile("s_waitcnt vmcnt(0)" ::: "memory");
  __syncthreads();
  int gt = 0;
  for (;;) {
    const int un = u + nslot;
    const bool has_next = un < per_xcd;
    f32x4 acc[8][4];
#pragma unroll
    for (int m = 0; m < 8; ++m)
#pragma unroll
      for (int n = 0; n < 4; ++n) acc[m][n] = (f32x4){0.f, 0.f, 0.f, 0.f};
    const int nt = cu.nt;
#pragma nounroll
    for (int t = 0; t < nt; ++t) {
      const int cur = gt & 1;
      const char* SAp = shm + cur * STAGE_B; const char* SBp = SAp + TILE_B;
      {
        bf16x8 At[8], Bf[4];
        const char* abase = SAp + fragA;
        const char* bbase = SBp + fragB;
#pragma unroll
        for (int n = 0; n < 4; ++n) Bf[n] = *(const bf16x8*)(bbase + n * 2048);
#pragma unroll
        for (int m = 0; m < 2; ++m) At[m] = *(const bf16x8*)(abase + m * 2048);
        __builtin_amdgcn_sched_barrier(0);
        const bool in_unit = t + 1 < nt;
        const bool do_stage = in_unit || has_next;
        GUnit su = cu;
        if (!in_unit && has_next) su = gemm_unit<RW1>(un, nN, nMx, xcd, lat_only, A0in, A2, ksplit_in, Kin, Bt, ldb);
        const int skt = in_unit ? t + 1 : 0;
#pragma unroll
        for (int m = 0; m < 4; ++m) {
#pragma unroll
          for (int n = 0; n < 4; ++n) acc[m][n] = __builtin_amdgcn_mfma_f32_16x16x32_bf16(Bf[n], At[m], acc[m][n], 0, 0, 0);
          if (m < 3) { At[2 * m + 2] = *(const bf16x8*)(abase + (2 * m + 2) * 2048); At[2 * m + 3] = *(const bf16x8*)(abase + (2 * m + 3) * 2048); }
          At[m] = *(const bf16x8*)(abase + m * 2048 + 1024);
          if (do_stage) G_STAGE1(cur ^ 1, skt, su, aoff, boff, m);
          __builtin_amdgcn_sched_barrier(0);
        }
#pragma unroll
        for (int n = 0; n < 4; ++n) {
#pragma unroll
          for (int m = 4; m < 8; ++m) {
            acc[m][n] = __builtin_amdgcn_mfma_f32_16x16x32_bf16(Bf[n], At[m], acc[m][n], 0, 0, 0);
            if (n == 3) At[m] = *(const bf16x8*)(abase + m * 2048 + 1024);
          }
          Bf[n] = *(const bf16x8*)(bbase + n * 2048 + 1024);
          __builtin_amdgcn_sched_barrier(0);
        }
#pragma unroll
        for (int n = 0; n < 4; ++n) {
#pragma unroll
          for (int m = 0; m < 8; ++m) acc[m][n] = __builtin_amdgcn_mfma_f32_16x16x32_bf16(Bf[n], At[m], acc[m][n], 0, 0, 0);
          __builtin_amdgcn_sched_barrier(0);
        }
      }
      asm volatile("s_waitcnt vmcnt(0)" ::: "memory");
      __syncthreads();
      ++gt;
    }
    {
      int lane_ = (int)__builtin_amdgcn_mbcnt_hi(~0u, __builtin_amdgcn_mbcnt_lo(~0u, 0u));
      asm volatile("" : "+v"(lane_));
      const int wr = wsg >> 2, wc = wsg & 3, fr = lane_ & 15, fq = lane_ >> 4;
      char* ob = shm + 2 * STAGE_B + wsg * 2048;
      const int wofs = fr * 128 + (fq & 1) * 8, wch = fq >> 1, wsw = fr & 7;
      const int r8 = lane_ >> 3, c8 = lane_ & 7;
      const int rofs = r8 * 128 + ((c8 ^ (r8 & 7)) << 4);
#pragma unroll
      for (int m = 0; m < 8; ++m) {
#pragma unroll
        for (int n = 0; n < 4; ++n) {
          const f32x4 v = ep.conv(cu.brow + wr * 128 + m * 16 + fr, cu.bcol + wc * 64 + n * 16 + fq * 4, acc[m][n]);
          uint2 o; o.x = pack2(v[0], v[1]); o.y = pack2(v[2], v[3]);
          *(uint2*)(ob + wofs + ((((n << 1) | wch) ^ wsw) << 4)) = o;
        }
#pragma unroll
        for (int hh = 0; hh < 2; ++hh) {
          const uint4 val = *(const uint4*)(ob + hh * 1024 + rofs);
          u16* dp = ep.dst(cu.brow + wr * 128 + m * 16 + hh * 8 + r8, cu.bcol + wc * 64 + c8 * 8);
          if (dp) *(uint4*)dp = val;
        }
        __builtin_amdgcn_sched_barrier(0);
      }
    }
    if (!has_next) break;
    u = un;
    cu = gemm_unit<RW1>(u, nN, nMx, xcd, lat_only, A0in, A2, ksplit_in, Kin, Bt, ldb);
  }
  }
#undef G_STAGE
#undef G_STAGE1
#undef G_OFFS
}

DI float tanh_fast(float x) { x = fminf(fmaxf(x, -15.f), 15.f); const float t = __expf(2.f * x); return (t - 1.f) / (t + 1.f); }
DI float decay_m1(float lw) {
  const float el = __expf(-fabsf(lw));
  const float ls = fminf(lw, 0.f) - __logf(1.f + el);
  const float e = __expf(ls - 0.5f);
  return __expf(-e) - 1.f;
}
struct EpBf16 {
  u16* base; int ld;
  DI f32x4 conv(int, int, f32x4 v) const { return v; }
  DI u16* dst(int row, int col) const { return base + (size_t)row * ld + col; }
};
struct EpRw1 {
  u16* big; u16* lr;
  DI f32x4 conv(int, int col, f32x4 v) const {
    const int cu = __builtin_amdgcn_readfirstlane(col >> 6);
    if (cu >= 48 && cu < 50) { v[0] = tanh_fast(v[0]); v[1] = tanh_fast(v[1]); v[2] = tanh_fast(v[2]); v[3] = tanh_fast(v[3]); }
    else if (cu >= 51 && cu < 53) { v[0] = sigmoidf_(v[0]); v[1] = sigmoidf_(v[1]); v[2] = sigmoidf_(v[2]); v[3] = sigmoidf_(v[3]); }
    return v;
  }
  DI u16* dst(int row, int col) const {
    if (col < 3072) return big + (size_t)(col >> 10) * ((size_t)R * D) + (size_t)row * D + (col & 1023);
    if (col < 3392) return lr + (size_t)row * K2 + (col - 3072);
    return nullptr;
  }
};
struct EpRw2 {
  u16* big; u16* gq; const float* w0; const float* a0;
  DI f32x4 conv(int, int col, f32x4 v) const {
    const int blk = __builtin_amdgcn_readfirstlane(col >> 10), cc = col & 1023;
    if (blk < 2) {
      const float4 ww = *(const float4*)(w0 + blk * D + cc);
      v[0] = decay_m1(v[0] + ww.x); v[1] = decay_m1(v[1] + ww.y); v[2] = decay_m1(v[2] + ww.z); v[3] = decay_m1(v[3] + ww.w);
    } else if (blk == 2) {
      const float4 ww = *(const float4*)(a0 + cc);
      v[0] = sigmoidf_(v[0] + ww.x); v[1] = sigmoidf_(v[1] + ww.y); v[2] = sigmoidf_(v[2] + ww.z); v[3] = sigmoidf_(v[3] + ww.w);
    }
    return v;
  }
  DI u16* dst(int row, int col) const {
    const int blk = col >> 10, cc = col & 1023;
    if (blk < 2) return big + (size_t)(4 + blk) * ((size_t)R * D) + (size_t)row * D + cc;
    if (blk == 2) return big + (size_t)3 * ((size_t)R * D) + (size_t)row * D + cc;
    return gq + (size_t)row * D + cc;
  }
};

__device__ __forceinline__ void ph_qkconv(const Ctx cx, CParams& p, int g) {
  const size_t total = (size_t)R * 128;
  for (size_t i = (size_t)cx.bid * NTHR + cx.tid; i < total; i += (size_t)gridDim.x * NTHR) {
    const int row = (int)(i >> 7), c0 = ((int)(i & 127)) * 8;
    int b, pos; rowinfo(g, row, b, pos);
    const bool hasp = (pos != 0 && pos != CTX), hasn = (pos != CTX - 1 && pos != TPS - 1);
    const u16* Z = p.BIG + (size_t)row * ZW + c0;
    float cur[8], pv[8], nx[8];
    unpack8(*(const uint4*)Z, cur);
    if (hasp) unpack8(*(const uint4*)(Z - ZW), pv); else { for (int e = 0; e < 8; ++e) pv[e] = 0.f; }
    if (hasn) unpack8(*(const uint4*)(Z + ZW), nx); else { for (int e = 0; e < 8; ++e) nx[e] = 0.f; }
    const float scale = (c0 < 512) ? 0.08838834764831845f : 1.f;
    float o[8];
#pragma unroll
    for (int e = 0; e < 8; ++e) {
      const int c = c0 + e;
      const float v = pv[e] * p.ev_conv_w[c] + cur[e] * p.ev_conv_w[D + c] + nx[e] * p.ev_conv_w[2 * D + c] + p.ev_conv_b[c];
      o[e] = siluf_(v) * scale;
    }
    *(uint4*)(p.QK + (size_t)row * D + c0) = pack8(o);
  }
}

__device__ __forceinline__ void mlstm_item(const Ctx cx, CParams& p, int item, char* smem) {
  const int tid = cx.tid, lane = tid & 63, w = tid >> 6, r = lane & 31, h = lane >> 5;
  const int bl = item >> 3, head = (item >> 1) & 3, dir = item & 1;
  const int base = bl * TPS;
  u16* sQ = (u16*)smem;
  u16* sK = sQ + 32 * 136;
  u16* sVT = sK + 32 * 136;
  u16* sKT = sVT + 128 * 40;
  float* sU = (float*)(sKT + 128 * 40);
  float* sM = sU + 32; float* sBc = sM + 32; float* sLast = sBc + 32;
  float* sN = sLast + 32;
  float* sRD = sN + 128;
  float* sWI = sRD + 128;
  const u16* Z = p.BIG;
  u16* Y = p.BIG + (size_t)R * ZW + (size_t)dir * R * 512;
  const float bgi = p.ev_b_gates[(2 * dir) * 4 + head], bgf = p.ev_b_gates[(2 * dir + 1) * 4 + head];
  f32x16 cacc[4];
#pragma unroll
  for (int a = 0; a < 4; ++a)
#pragma unroll
    for (int i = 0; i < 16; ++i) cacc[a][i] = 0.f;
  if (tid < 128) sN[tid] = 0.f;
  float m = 0.f;
  const bool act = tid < 256;
  const int lr = (tid >> 3) & 31, lc = tid & 7;
  uint4 q0, q1, k0, k1, v0, v1;
  u16 gzi = 0, gzf = 0;
#define ML_LOAD(p0_) do { if (act) { const int grow = scan_row(base, dir, (p0_) + lr); \
      q0 = *(const uint4*)(p.QK + (size_t)grow * D + head * 128 + lc * 8); \
      q1 = *(const uint4*)(p.QK + (size_t)grow * D + head * 128 + lc * 8 + 64); \
      k0 = *(const uint4*)(p.QK + (size_t)grow * D + 512 + head * 128 + lc * 8); \
      k1 = *(const uint4*)(p.QK + (size_t)grow * D + 512 + head * 128 + lc * 8 + 64); \
      v0 = *(const uint4*)(Z + (size_t)grow * ZW + 1024 + head * 128 + lc * 8); \
      v1 = *(const uint4*)(Z + (size_t)grow * ZW + 1024 + head * 128 + lc * 8 + 64); } \
    if (w == 0) { const int row_ = scan_row(base, dir, (p0_) + (lane & 31)); \
      gzi = Z[(size_t)row_ * ZW + 2048 + (2 * dir) * 4 + head]; gzf = Z[(size_t)row_ * ZW + 2048 + (2 * dir + 1) * 4 + head]; } } while (0)
  ML_LOAD(0);
  for (int ch = 0; ch < TPS / 32; ++ch) {
    const int p0 = ch * 32;
    __syncthreads();
    if (w == 0) {
      const int t = lane & 31;
      const float zi = bf2f(gzi) + bgi;
      const float zf = bf2f(gzf) + bgf;
      float bsum = logsigf_(zf);
      for (int o = 1; o < 32; o <<= 1) { const float v = __shfl_up(bsum, o); if (t >= o) bsum += v; }
      const float u = zi - bsum;
      float pm = u;
      for (int o = 1; o < 32; o <<= 1) { const float v = __shfl_up(pm, o); if (t >= o) pm = fmaxf(pm, v); }
      const float M = fmaxf(m, pm);
      if (lane < 32) { sU[t] = u; sM[t] = M; sBc[t] = bsum; if (t == 31) { sLast[0] = M; sLast[1] = bsum; } }
    }
    __syncthreads();
    const float Mlast = sLast[0], blast = sLast[1];
    if (act) {
      const float ws = __expf(sU[lr] - Mlast);
      *(uint4*)(sQ + lr * 136 + lc * 8) = q0; *(uint4*)(sQ + lr * 136 + lc * 8 + 64) = q1;
      *(uint4*)(sK + lr * 136 + lc * 8) = k0; *(uint4*)(sK + lr * 136 + lc * 8 + 64) = k1;
      float f[8];
      unpack8(k0, f);
#pragma unroll
      for (int e = 0; e < 8; ++e) sKT[(lc * 8 + e) * 40 + lr] = f2bf(f[e] * ws);
      unpack8(k1, f);
#pragma unroll
      for (int e = 0; e < 8; ++e) sKT[(lc * 8 + 64 + e) * 40 + lr] = f2bf(f[e] * ws);
      const u16* pv0 = (const u16*)&v0; const u16* pv1 = (const u16*)&v1;
#pragma unroll
      for (int e = 0; e < 8; ++e) { sVT[(lc * 8 + e) * 40 + lr] = pv0[e]; sVT[(lc * 8 + 64 + e) * 40 + lr] = pv1[e]; }
    }
    if (ch + 1 < TPS / 32) ML_LOAD(p0 + 32);
    __syncthreads();
    f32x16 st;
#pragma unroll
    for (int i = 0; i < 16; ++i) st[i] = 0.f;
    if (act) {
#pragma unroll
    for (int ks = 0; ks < 8; ++ks) {
      const bf16x8 a = *(const bf16x8*)(sK + r * 136 + 16 * ks + 8 * h);
      const bf16x8 b = *(const bf16x8*)(sQ + r * 136 + 16 * ks + 8 * h);
      st = MFMA(a, b, st);
    }
    const float Mt = sM[r];
    float dsum = 0.f;
#pragma unroll
    for (int i = 0; i < 16; ++i) {
      const int s = crow(i, h);
      const float pv = (s <= r) ? st[i] * __expf(sU[s] - Mt) : 0.f;
      st[i] = pv; dsum += pv;
    }
    dsum += __shfl_xor(dsum, 32);
    float qn = 0.f;
#pragma unroll
    for (int d8 = 0; d8 < 8; ++d8) {
      float qf[8]; unpack8(*(const uint4*)(sQ + r * 136 + 64 * h + 8 * d8), qf);
#pragma unroll
      for (int e = 0; e < 8; ++e) qn += qf[e] * sN[64 * h + 8 * d8 + e];
    }
    qn += __shfl_xor(qn, 32);
    const float wi = __expf(m - Mt);
    const float den = dsum + wi * qn;
    const float dn = fmaxf(fabsf(den), __expf(-(sBc[r] + Mt)));
    if (h == 0) { sRD[w * 32 + r] = 1.f / dn; sWI[w * 32 + r] = wi; }
    }
    __syncthreads();
    const float wp = __expf(m - Mlast);
    if (act) {
    f32x16 o;
#pragma unroll
    for (int i = 0; i < 16; ++i) o[i] = 0.f;
#pragma unroll
    for (int mb = 0; mb < 4; ++mb)
#pragma unroll
      for (int s2 = 0; s2 < 2; ++s2) {
        const bf16x8 cb = pack_step(cacc[mb], s2);
        const u16* qp = sQ + r * 136 + 32 * mb + 16 * s2 + 4 * h;
        const bf16x8 a = cat4(*(const s16x4*)qp, *(const s16x4*)(qp + 8));
        o = MFMA(a, cb, o);
      }
#pragma unroll
    for (int i = 0; i < 16; ++i) o[i] *= sWI[w * 32 + crow(i, h)];
#pragma unroll
    for (int s2 = 0; s2 < 2; ++s2) {
      const bf16x8 a = pack_step(st, s2);
      const u16* vp = sVT + (32 * w + r) * 40 + 16 * s2 + 4 * h;
      const bf16x8 b = cat4(*(const s16x4*)vp, *(const s16x4*)(vp + 8));
      o = MFMA(a, b, o);
    }
#pragma unroll
    for (int i = 0; i < 16; ++i) {
      const int t = crow(i, h);
      const int row = scan_row(base, dir, p0 + t);
      Y[(size_t)row * 512 + head * 128 + 32 * w + r] = f2bf(o[i] * sRD[w * 32 + t]);
    }
#pragma unroll
    for (int mb = 0; mb < 4; ++mb) {
#pragma unroll
      for (int i = 0; i < 16; ++i) cacc[mb][i] *= wp;
#pragma unroll
      for (int s2 = 0; s2 < 2; ++s2) {
        const bf16x8 a = *(const bf16x8*)(sKT + (32 * mb + r) * 40 + 16 * s2 + 8 * h);
        const bf16x8 b = *(const bf16x8*)(sVT + (32 * w + r) * 40 + 16 * s2 + 8 * h);
        cacc[mb] = MFMA(a, b, cacc[mb]);
      }
    }
    }
    __syncthreads();
    if (tid < 128) {
      float s = 0.f;
#pragma unroll
      for (int e = 0; e < 32; ++e) s += bf2f(sKT[tid * 40 + e]);
      sN[tid] = wp * sN[tid] + s;
    }
    m = blast + Mlast;
  }
#undef ML_LOAD
}

__device__ __forceinline__ void gla_item(const Ctx cx, CParams& p, int item, char* smem) {
  const int tid = cx.tid, lane = tid & 63, w = tid >> 6, r = lane & 31, h = lane >> 5;
  const int bl = item >> 3, head = (item >> 1) & 3, dir = item & 1;
  const int base = bl * TPS;
  u16* sQ = (u16*)smem;
  u16* sK = sQ + 32 * 72;
  u16* sKT = sK + 32 * 72;
  u16* sVT = sKT + 64 * 40;
  float* sLa = (float*)(sVT + 128 * 40);
  float* sW2 = sLa + 32 * 64;
  float* sBi = sW2 + 16 * 64;
  const u16* Z = p.BIG;
  u16* Y = p.BIG + (size_t)R * ZW + (size_t)(2 + dir) * R * 512;
  for (int i = tid; i < 16 * 64; i += NTHR) sW2[i] = p.ev_gla_w2[((size_t)dir * 16 + (i >> 6)) * 256 + head * 64 + (i & 63)];
  if (tid < 64) sBi[tid] = p.ev_gla_b[dir * 256 + head * 64 + tid];
  f32x16 sacc[2];
#pragma unroll
  for (int a = 0; a < 2; ++a)
#pragma unroll
    for (int i = 0; i < 16; ++i) sacc[a][i] = 0.f;
  const bool act = tid < 256;
  const int lr = (tid >> 3) & 31, lc = tid & 7;
  uint4 gq, gk, v0, v1, gl0, gl1;
#define GLA_LOAD(p0_) do { if (act) { const int grow = scan_row(base, dir, (p0_) + lr); const u16* zr = Z + (size_t)grow * ZW; \
      gq = *(const uint4*)(zr + 2064 + head * 64 + lc * 8); gk = *(const uint4*)(zr + 2320 + head * 64 + lc * 8); \
      v0 = *(const uint4*)(zr + 2576 + head * 128 + lc * 8); v1 = *(const uint4*)(zr + 2576 + head * 128 + lc * 8 + 64); \
      gl0 = *(const uint4*)(zr + 3600 + dir * 16); gl1 = *(const uint4*)(zr + 3600 + dir * 16 + 8); } } while (0)
  GLA_LOAD(0);
  for (int ch = 0; ch < TPS / 32; ++ch) {
    const int p0 = ch * 32;
    __syncthreads();
    if (act) {
      float gl[16];
      unpack8(gl0, gl); unpack8(gl1, gl + 8);
#pragma unroll
      for (int e = 0; e < 8; ++e) {
        const int c = lc * 8 + e;
        float xv = sBi[c];
#pragma unroll
        for (int q = 0; q < 16; ++q) xv += gl[q] * sW2[q * 64 + c];
        sLa[lr * 64 + c] = logsigf_(xv) * (1.f / 16.f);
      }
    }
    __syncthreads();
    if (tid < 64) {
      float lv[32];
#pragma unroll
      for (int t = 0; t < 32; ++t) lv[t] = sLa[t * 64 + tid];
      float b = 0.f;
#pragma unroll
      for (int t = 0; t < 32; ++t) { b += lv[t]; sLa[t * 64 + tid] = b; }
    }
    __syncthreads();
    if (act) {
      float qf[8], kf[8], o[8];
      unpack8(gq, qf); unpack8(gk, kf);
#pragma unroll
      for (int e = 0; e < 8; ++e) { const float bb = sLa[lr * 64 + lc * 8 + e]; qf[e] *= 0.125f * __expf(bb); kf[e] *= __expf(-bb); }
      *(uint4*)(sQ + lr * 72 + lc * 8) = pack8(qf);
      *(uint4*)(sK + lr * 72 + lc * 8) = pack8(kf);
#pragma unroll
      for (int e = 0; e < 8; ++e) sKT[(lc * 8 + e) * 40 + lr] = f2bf(kf[e]);
      (void)o;
      const u16* pv0 = (const u16*)&v0; const u16* pv1 = (const u16*)&v1;
#pragma unroll
      for (int e = 0; e < 8; ++e) { sVT[(lc * 8 + e) * 40 + lr] = pv0[e]; sVT[(lc * 8 + 64 + e) * 40 + lr] = pv1[e]; }
    }
    if (ch + 1 < TPS / 32) GLA_LOAD(p0 + 32);
    __syncthreads();
    if (act) {
    f32x16 st;
#pragma unroll
    for (int i = 0; i < 16; ++i) st[i] = 0.f;
#pragma unroll
    for (int ks = 0; ks < 4; ++ks) {
      const bf16x8 a = *(const bf16x8*)(sK + r * 72 + 16 * ks + 8 * h);
      const bf16x8 b = *(const bf16x8*)(sQ + r * 72 + 16 * ks + 8 * h);
      st = MFMA(a, b, st);
    }
#pragma unroll
    for (int i = 0; i < 16; ++i) { if (crow(i, h) > r) st[i] = 0.f; }
    f32x16 o;
#pragma unroll
    for (int i = 0; i < 16; ++i) o[i] = 0.f;
#pragma unroll
    for (int mb = 0; mb < 2; ++mb)
#pragma unroll
      for (int s2 = 0; s2 < 2; ++s2) {
        const bf16x8 cb = pack_step(sacc[mb], s2);
        const u16* qp = sQ + r * 72 + 32 * mb + 16 * s2 + 4 * h;
        const bf16x8 a = cat4(*(const s16x4*)qp, *(const s16x4*)(qp + 8));
        o = MFMA(a, cb, o);
      }
#pragma unroll
    for (int s2 = 0; s2 < 2; ++s2) {
      const bf16x8 a = pack_step(st, s2);
      const u16* vp = sVT + (32 * w + r) * 40 + 16 * s2 + 4 * h;
      const bf16x8 b = cat4(*(const s16x4*)vp, *(const s16x4*)(vp + 8));
      o = MFMA(a, b, o);
    }
#pragma unroll
    for (int i = 0; i < 16; ++i) {
      const int row = scan_row(base, dir, p0 + crow(i, h));
      Y[(size_t)row * 512 + head * 128 + 32 * w + r] = f2bf(o[i]);
    }
#pragma unroll
    for (int mb = 0; mb < 2; ++mb) {
#pragma unroll
      for (int s2 = 0; s2 < 2; ++s2) {
        const bf16x8 a = *(const bf16x8*)(sKT + (32 * mb + r) * 40 + 16 * s2 + 8 * h);
        const bf16x8 b = *(const bf16x8*)(sVT + (32 * w + r) * 40 + 16 * s2 + 8 * h);
        sacc[mb] = MFMA(a, b, sacc[mb]);
      }
#pragma unroll
      for (int i = 0; i < 16; ++i) sacc[mb][i] *= __expf(sLa[31 * 64 + 32 * mb + crow(i, h)]);
    }
    }
  }
#undef GLA_LOAD
}

__device__ __forceinline__ void ph_scan0(const Ctx cx, CParams& p, char* smem) {
  for (int it = cx.bid; it < 2 * SPG * 8; it += gridDim.x) {
    __syncthreads();
    if (it < SPG * 8) mlstm_item(cx, p, it, smem); else gla_item(cx, p, it - SPG * 8, smem);
  }
}

__device__ __forceinline__ void ph_evout(const Ctx cx, CParams& p, int g) {
  const int lane = cx.tid & 63;
  const int gw = cx.bid * NWV + (cx.tid >> 6), nw = gridDim.x * NWV;
  const u16* Yb = p.BIG + (size_t)R * ZW;
  for (int row = gw; row < R; row += nw) {
    const int c0 = lane * 16;
    const int part = c0 >> 9, cc = c0 & 511;
    const u16* yf = Yb + ((size_t)(2 * part) * R + row) * 512 + cc;
    const u16* yb = Yb + ((size_t)(2 * part + 1) * R + row) * 512 + cc;
    float a[16], b[16];
    unpack8(*(const uint4*)yf, a); unpack8(*(const uint4*)(yf + 8), a + 8);
    unpack8(*(const uint4*)yb, b); unpack8(*(const uint4*)(yb + 8), b + 8);
    float ss = 0.f;
#pragma unroll
    for (int e = 0; e < 16; ++e) { a[e] += b[e]; ss += a[e] * a[e]; }
    ss += __shfl_xor(ss, 1); ss += __shfl_xor(ss, 2); ss += __shfl_xor(ss, 4);
    const float rstd = rsqrtf(ss * (1.f / 128.f) + 1e-6f);
    const u16* zg = p.BIG + (size_t)row * ZW + (part ? 3088 : 1536) + cc;
    float gt[16];
    unpack8(*(const uint4*)zg, gt); unpack8(*(const uint4*)(zg + 8), gt + 8);
#pragma unroll
    for (int e = 0; e < 16; ++e) {
      const float gv = part ? siluf_(gt[e]) : sigmoidf_(gt[e]);
      a[e] = a[e] * rstd * p.ev_head_g[c0 + e] * gv;
    }
    *(uint4*)(p.H + (size_t)row * D + c0) = pack8(a);
    *(uint4*)(p.H + (size_t)row * D + c0 + 8) = pack8(a + 8);
  }
}

__device__ __forceinline__ void ph_ffnact(const Ctx cx, CParams& p, int g, int layer, bool lat_only) {
  const float* cw = p.ffn_conv_w + (size_t)layer * 9 * DFF;
  const float* cb = p.ffn_conv_b + (size_t)layer * DFF;
  constexpr int SEG = 16, NSEG = TPS / SEG;
  const int total = SPG * NSEG * 352;
  for (int it = cx.bid * NTHR + cx.tid; it < total; it += gridDim.x * NTHR) {
    const int cg = it % 352, sg = (it / 352) % NSEG, s = it / (352 * NSEG);
    const int f0 = cg * 8;
    const int pos0 = sg * SEG;
    const bool isctx = pos0 < CTX;
    if (lat_only && isctx) continue;
    bool has_up = false, has_dn = false, has_l, has_r;
    if (isctx) { has_l = pos0 > 0; has_r = pos0 + SEG < CTX; }
    else { const int lp = pos0 - CTX, gr = lp >> 6, gc0 = lp & 63; has_up = gr > 0; has_dn = gr < 31; has_l = gc0 > 0; has_r = gc0 + SEG < 64; }
    float w[3][3][8], bias[8];
#pragma unroll
    for (int dh = 0; dh < 3; ++dh)
#pragma unroll
      for (int dw = 0; dw < 3; ++dw) {
        const float4 w0 = *(const float4*)(cw + (dh * 3 + dw) * DFF + f0), w1 = *(const float4*)(cw + (dh * 3 + dw) * DFF + f0 + 4);
        w[dh][dw][0] = w0.x; w[dh][dw][1] = w0.y; w[dh][dw][2] = w0.z; w[dh][dw][3] = w0.w;
        w[dh][dw][4] = w1.x; w[dh][dw][5] = w1.y; w[dh][dw][6] = w1.z; w[dh][dw][7] = w1.w;
      }
    { const float4 b0 = *(const float4*)(cb + f0), b1 = *(const float4*)(cb + f0 + 4);
      bias[0] = b0.x; bias[1] = b0.y; bias[2] = b0.z; bias[3] = b0.w; bias[4] = b1.x; bias[5] = b1.y; bias[6] = b1.z; bias[7] = b1.w; }
    u16* gu = p.BIG + (size_t)(s * TPS + pos0) * GUW + f0;
    float c0[3][8], c1[3][8], c2[3][8];
    uint4 nx[3];
#define FA_LD1(d, tok_, ok_) do { const bool o_ = (ok_); const uint4 r_ = *(const uint4*)(gu + (ptrdiff_t)(o_ ? (tok_) : 0) * GUW); \
      d.x = o_ ? r_.x : 0u; d.y = o_ ? r_.y : 0u; d.z = o_ ? r_.z : 0u; d.w = o_ ? r_.w : 0u; } while (0)
#define FA_LOAD(dst, tok, ok) do { FA_LD1(dst[1], (tok), (ok)); FA_LD1(dst[0], (tok) - 64, (ok) && has_up); FA_LD1(dst[2], (tok) + 64, (ok) && has_dn); } while (0)
    FA_LOAD(nx, -1, has_l);
    unpack8(nx[0], c0[0]); unpack8(nx[1], c0[1]); unpack8(nx[2], c0[2]);
    FA_LOAD(nx, 0, true);
    unpack8(nx[0], c1[0]); unpack8(nx[1], c1[1]); unpack8(nx[2], c1[2]);
    FA_LOAD(nx, 1, true);
#pragma unroll 2
    for (int t = 0; t < SEG; ++t) {
      unpack8(nx[0], c2[0]); unpack8(nx[1], c2[1]); unpack8(nx[2], c2[2]);
      const uint4 upraw = *(const uint4*)(gu + (ptrdiff_t)t * GUW + DFF);
      { const int tn = t + 2; const bool ok = (tn < SEG) || (tn == SEG && has_r); FA_LOAD(nx, tn, ok); }
      float acc[8];
#pragma unroll
      for (int e = 0; e < 8; ++e) {
        float a = bias[e];
#pragma unroll
        for (int dh = 0; dh < 3; ++dh) a += c0[dh][e] * w[dh][0][e] + c1[dh][e] * w[dh][1][e] + c2[dh][e] * w[dh][2][e];
        acc[e] = a;
      }
      float up[8]; unpack8(upraw, up);
#pragma unroll
      for (int e = 0; e < 8; ++e) {
        const float xg = acc[e];
        const float th = tanh_fast(0.7978845608028654f * (xg + 0.044715f * xg * xg * xg));
        up[e] *= 0.5f * xg * (1.f + th);
      }
      *(uint4*)(gu + (ptrdiff_t)t * GUW + DFF) = pack8(up);
#pragma unroll
      for (int dh = 0; dh < 3; ++dh)
#pragma unroll
        for (int e = 0; e < 8; ++e) { c0[dh][e] = c1[dh][e]; c1[dh][e] = c2[dh][e]; }
    }
#undef FA_LOAD
#undef FA_LD1
  }
}

__device__ __forceinline__ void ph_xx(const Ctx cx, CParams& p, int g) {
  const size_t total = (size_t)R * 128;
  for (size_t i = (size_t)cx.bid * NTHR + cx.tid; i < total; i += (size_t)gridDim.x * NTHR) {
    const int row = (int)(i >> 7), c0 = ((int)(i & 127)) * 8;
    int b, pos; rowinfo(g, row, b, pos);
    const int q = c0 >> 8;
    int off = 0; bool ok;
    if (pos < CTX) {
      if ((q & 1) == 0) { off = -1; ok = pos > 0; } else { off = 1; ok = pos < CTX - 1; }
    } else {
      const int lp = pos - CTX, gr = lp >> 6, gc = lp & 63;
      if (q == 0) { off = -1; ok = gc > 0; }
      else if (q == 1) { off = 1; ok = gc < 63; }
      else if (q == 2) { off = -64; ok = gr > 0; }
      else { off = 64; ok = gr < 31; }
    }
    float hc[8], hs[8];
    unpack8(*(const uint4*)(p.H + (size_t)row * D + c0), hc);
    if (ok) unpack8(*(const uint4*)(p.H + (size_t)(row + off) * D + c0), hs); else { for (int e = 0; e < 8; ++e) hs[e] = 0.f; }
#pragma unroll
    for (int e = 0; e < 8; ++e) hs[e] -= hc[e];
    *(uint4*)(p.QK + (size_t)row * D + c0) = pack8(hs);
    float m_[8];
    const size_t RS_ = (size_t)R * D;
#pragma unroll
    for (int e = 0; e < 8; ++e) m_[e] = hc[e] + hs[e] * p.rw_mu[0 * D + c0 + e];
    *(uint4*)(p.BIG + 3 * RS_ + (size_t)row * D + c0) = pack8(m_);
#pragma unroll
    for (int e = 0; e < 8; ++e) m_[e] = hc[e] + hs[e] * p.rw_mu[2 * D + c0 + e];
    *(uint4*)(p.BIG + 4 * RS_ + (size_t)row * D + c0) = pack8(m_);
#pragma unroll
    for (int e = 0; e < 8; ++e) m_[e] = hc[e] + hs[e] * p.rw_mu[3 * D + c0 + e];
    *(uint4*)(p.BIG + 5 * RS_ + (size_t)row * D + c0) = pack8(m_);
  }
}

__device__ __forceinline__ void ph_rwprep(const Ctx cx, CParams& p) {
  const int lane = cx.tid & 63;
  const int gw = cx.bid * NWV + (cx.tid >> 6), nw = gridDim.x * NWV;
  const size_t RS = (size_t)R * D;
  float* CS = (float*)p.LR;
  for (int row = gw; row < R; row += nw) {
    const int c0 = lane * 16;
    const size_t o = (size_t)row * D + c0;
    float rr[16], kk[16], aa[16], km[16], ka[16];
    unpack8(*(const uint4*)(p.BIG + o), rr); unpack8(*(const uint4*)(p.BIG + o + 8), rr + 8);
    unpack8(*(const uint4*)(p.BIG + RS + o), kk); unpack8(*(const uint4*)(p.BIG + RS + o + 8), kk + 8);
    unpack8(*(const uint4*)(p.BIG + 3 * RS + o), aa); unpack8(*(const uint4*)(p.BIG + 3 * RS + o + 8), aa + 8);
    float ss = 0.f;
#pragma unroll
    for (int e = 0; e < 16; ++e) {
      km[e] = bf2f(f2bf(kk[e] * (1.f + (aa[e] - 1.f) * p.rw_kvec[D + c0 + e])));
      kk[e] *= p.rw_kvec[c0 + e]; ss += kk[e] * kk[e];
    }
    ss += __shfl_xor(ss, 1); ss += __shfl_xor(ss, 2);
    const float inv = 1.f / fmaxf(sqrtf(ss), 1e-12f);
    float c1 = 0.f, c2 = 0.f;
#pragma unroll
    for (int e = 0; e < 16; ++e) {
      kk[e] *= inv; ka[e] = bf2f(f2bf(kk[e] * aa[e]));
      c1 += ka[e] * rr[e]; c2 += km[e] * rr[e];
    }
    c1 += __shfl_xor(c1, 1); c1 += __shfl_xor(c1, 2);
    c2 += __shfl_xor(c2, 1); c2 += __shfl_xor(c2, 2);
    *(uint4*)(p.BIG + RS + o) = pack8(kk); *(uint4*)(p.BIG + RS + o + 8) = pack8(kk + 8);
    *(uint4*)(p.BIG + 3 * RS + o) = pack8(ka); *(uint4*)(p.BIG + 3 * RS + o + 8) = pack8(ka + 8);
    *(uint4*)(p.H + o) = pack8(km); *(uint4*)(p.H + o + 8) = pack8(km + 8);
    if ((lane & 3) == 0) { float2 c; c.x = c1; c.y = c2; *(float2*)(CS + (size_t)row * 32 + (lane >> 2) * 2) = c; }
  }
}

__device__ __forceinline__ void ph_rwscan(const Ctx cx, CParams& p) {
  const int lane = cx.tid & 63, w = cx.tid >> 6;
  if (w >= 4) return;
  const int vq = lane >> 3, kq = lane & 7, hf = w & 1;
  const size_t RS = (size_t)R * D;
  const u16* Rb = p.BIG; const u16* KKb = p.BIG + RS; const u16* Vb = p.BIG + 2 * RS; const u16* KAb = p.BIG + 3 * RS; const u16* KMb = p.H;
  const float* CS = (const float*)p.LR;
  const int nblk = (SPG * 16 * 2) / 2;
  for (int bi = cx.bid; bi < nblk; bi += gridDim.x) {
    const int item = bi * 2 + (w >> 1);
    const int bl = item >> 5, head = (item >> 1) & 15, dir = item & 1;
    const u16* Wb = p.BIG + (size_t)(4 + dir) * RS;
    u16* Yb = (u16*)p.YO + (size_t)dir * RS;
    const int base = bl * TPS;
    const int colk = head * 64 + kq * 8, colv = head * 64 + hf * 32 + vq * 4;
    float S[4][8];
#pragma unroll
    for (int i = 0; i < 4; ++i)
#pragma unroll
      for (int e = 0; e < 8; ++e) S[i][e] = 0.f;
    char* dummy = (char*)p.LR + (size_t)R * 128 + (cx.tid & 511) * 8;
    constexpr int PF = 4;
    uint4 qr[PF], qkk[PF], qka[PF], qkm[PF], qw[PF]; uint2 qv[PF]; float2 qcs[PF]; int qrow[PF];
#define RW_LOAD(j, ps_) do { const int row_ = scan_row(base, dir, (ps_)); qrow[j] = row_; \
      const unsigned ok_ = (unsigned)(row_ * D + colk) * 2u, ov_ = (unsigned)(row_ * D + colv) * 2u, oc_ = (unsigned)(row_ * 32 + head * 2) * 4u; \
      qr[j] = *(const uint4*)((const char*)Rb + ok_); qkk[j] = *(const uint4*)((const char*)KKb + ok_); \
      qka[j] = *(const uint4*)((const char*)KAb + ok_); qkm[j] = *(const uint4*)((const char*)KMb + ok_); \
      qw[j] = *(const uint4*)((const char*)Wb + ok_); qv[j] = *(const uint2*)((const char*)Vb + ov_); \
      qcs[j] = *(const float2*)((const char*)CS + oc_); } while (0)
#pragma unroll
    for (int j = 0; j < PF; ++j) RW_LOAD(j, j);
    for (int ps0 = 0; ps0 < TPS; ps0 += PF) {
#pragma unroll
    for (int j = 0; j < PF; ++j) {
      const uint4 cr_ = qr[j], ckk = qkk[j], cka = qka[j], ckm = qkm[j], cw = qw[j]; const uint2 cv = qv[j]; const float2 cs = qcs[j];
      const int crow_ = qrow[j];
      { const int pn_ = ps0 + PF + j; RW_LOAD(j, pn_ < TPS ? pn_ : TPS - 1); }
      float wr[8], kk[8], wm1[8], vv[4], kka[8], km[8];
      unpack8(cr_, wr); unpack8(ckk, kk); unpack8(cka, kka); unpack8(ckm, km); unpack8(cw, wm1);
      vv[0] = lo16(cv.x); vv[1] = hi16(cv.x); vv[2] = lo16(cv.y); vv[3] = hi16(cv.y);
#pragma unroll
      for (int e = 0; e < 8; ++e) wr[e] += wr[e] * wm1[e];
      float sa[4], yo[4];
#pragma unroll
      for (int i = 0; i < 4; ++i) {
        float s = 0.f, t = 0.f;
#pragma unroll
        for (int e = 0; e < 8; ++e) { s += S[i][e] * kk[e]; t += S[i][e] * wr[e]; }
        sa[i] = s; yo[i] = t;
      }
#pragma unroll
      for (int i = 0; i < 4; ++i) { sa[i] = -red8(sa[i]); yo[i] = red8(yo[i]); }
#pragma unroll
      for (int i = 0; i < 4; ++i) {
#pragma unroll
        for (int e = 0; e < 8; ++e) {
          float t = S[i][e] + S[i][e] * wm1[e];
          t += sa[i] * kka[e];
          t += vv[i] * km[e];
          S[i][e] = t;
        }
        yo[i] += sa[i] * cs.x + vv[i] * cs.y;
      }
      { uint2 o; o.x = pack2(yo[0], yo[1]); o.y = pack2(yo[2], yo[3]);
        char* dst_ = (kq == 0) ? (char*)Yb + (unsigned)(crow_ * D + colv) * 2u : dummy;
        *(uint2*)dst_ = o; }
    }
    }
#undef RW_LOAD
  }
}

__device__ __forceinline__ void ph_rwout(const Ctx cx, CParams& p, int g) {
  const int lane = cx.tid & 63;
  const int gw = cx.bid * NWV + (cx.tid >> 6), nw = gridDim.x * NWV;
  const size_t RS = (size_t)R * D;
  for (int row = gw; row < R; row += nw) {
    int b, pos; rowinfo(g, row, b, pos);
    if (pos < CTX) continue;
    const int c0 = lane * 16;
    const size_t o = (size_t)row * D + c0;
    float yf[16], yb[16], rr[16], kk[16], vv[16], gg[16];
    const u16* Yy = (const u16*)p.YO;
    unpack8(*(const uint4*)(Yy + o), yf); unpack8(*(const uint4*)(Yy + o + 8), yf + 8);
    unpack8(*(const uint4*)(Yy + RS + o), yb); unpack8(*(const uint4*)(Yy + RS + o + 8), yb + 8);
    unpack8(*(const uint4*)(p.BIG + o), rr); unpack8(*(const uint4*)(p.BIG + o + 8), rr + 8);
    unpack8(*(const uint4*)(p.H + o), kk); unpack8(*(const uint4*)(p.H + o + 8), kk + 8);
    unpack8(*(const uint4*)(p.BIG + 2 * RS + o), vv); unpack8(*(const uint4*)(p.BIG + 2 * RS + o + 8), vv + 8);
    unpack8(*(const uint4*)(p.QK + o), gg); unpack8(*(const uint4*)(p.QK + o + 8), gg + 8);
    float s1 = 0.f, bon = 0.f;
#pragma unroll
    for (int e = 0; e < 16; ++e) {
      yf[e] += yb[e]; s1 += yf[e];
      bon += rr[e] * kk[e] * p.rw_kvec[2 * D + c0 + e];
    }
    s1 += __shfl_xor(s1, 1); s1 += __shfl_xor(s1, 2);
    bon += __shfl_xor(bon, 1); bon += __shfl_xor(bon, 2);
    const float mu = s1 * (1.f / 64.f);
    float s2 = 0.f;
#pragma unroll
    for (int e = 0; e < 16; ++e) { const float d = yf[e] - mu; s2 += d * d; }
    s2 += __shfl_xor(s2, 1); s2 += __shfl_xor(s2, 2);
    const float rstd = rsqrtf(s2 * (1.f / 64.f) + 64e-5f);
#pragma unroll
    for (int e = 0; e < 16; ++e) {
      const float yn = (yf[e] - mu) * rstd * p.rw_lnx[c0 + e] + p.rw_lnx[D + c0 + e];
      yf[e] = (yn + bon * vv[e]) * gg[e];
    }
    *(uint4*)(p.H + o) = pack8(yf);
    *(uint4*)(p.H + o + 8) = pack8(yf + 8);
  }
}

#define XB_TMO      128
#define XB_XCNT(j)  (256  + 64 * (j))
#define XB_XSUB(j)  (1280 + 64 * (j))
#define XB_XGEN(j)  (2304 + 64 * (j))
#define XB_TOP      3328
#define XB_TOPGEN   3392
#define XCD_BAR_WORDS 3456
#define XB_SPIN_CAP (1u << 20)
#define LAS __attribute__((address_space(3)))
DI unsigned xb_ld(unsigned* p)              { return __hip_atomic_load(p, __ATOMIC_RELAXED, __HIP_MEMORY_SCOPE_AGENT); }
DI unsigned xb_add(unsigned* p, unsigned v) { return __hip_atomic_fetch_add(p, v, __ATOMIC_RELAXED, __HIP_MEMORY_SCOPE_AGENT); }
DI unsigned xb_xcc_id() { return (unsigned)__builtin_amdgcn_s_getreg((3 << 11) | 20) & 0xFu; }
#define XB_SPIN(cond, bar) do { unsigned _sp = 0; while (cond) { __builtin_amdgcn_s_sleep(1); \
    if ((++_sp & 255u) == 0u) { if (xb_ld(&(bar)[XB_TMO])) break; if (_sp > XB_SPIN_CAP) { atomicAdd(&(bar)[XB_TMO], 1u); break; } } } } while (0)
struct XcdBarrier { unsigned* bar; unsigned x; volatile LAS unsigned* st; };
DI XcdBarrier xcd_barrier_post(unsigned* bar, volatile LAS unsigned* st) {
  XcdBarrier b; b.bar = bar; b.x = xb_xcc_id(); b.st = st;
  if (threadIdx.x == 0) (void)xb_add(&bar[XB_XCNT(b.x)], 1u);
  return b;
}
DI void xcd_barrier_complete(unsigned* bar, unsigned x, unsigned& nloc, unsigned& nx) {
  const unsigned G = gridDim.x * gridDim.y * gridDim.z;
  unsigned sum, cnt, mine, sp = 0u;
  for (;;) {
    sum = 0u; cnt = 0u; mine = 0u;
#pragma unroll
    for (unsigned j = 0; j < 16; ++j) { const unsigned c = xb_ld(&bar[XB_XCNT(j)]); sum += c; cnt += (c > 0u) ? 1u : 0u; mine = (j == x) ? c : mine; }
    if (sum == G) break;
    __builtin_amdgcn_s_sleep(1);
    if ((++sp & 255u) == 0u) { if (xb_ld(&bar[XB_TMO])) break; if (sp > XB_SPIN_CAP) { atomicAdd(&bar[XB_TMO], 1u); break; } }
  }
  nloc = mine > 0u ? mine : 1u; nx = cnt > 0u ? cnt : 1u;
}
DI void xcd_barrier(const XcdBarrier& b) {
  asm volatile("s_waitcnt vmcnt(0)" ::: "memory");
  __syncthreads();
  if (threadIdx.x == 0) {
    unsigned* bar = b.bar;
    __builtin_amdgcn_s_waitcnt(0);
    unsigned nloc = b.st[0], nx = b.st[1];
    if (nloc == 0u) { xcd_barrier_complete(bar, b.x, nloc, nx); b.st[0] = nloc; b.st[1] = nx; }
    const unsigned old = xb_add(&bar[XB_XSUB(b.x)], 1u);
    const unsigned gen = old / nloc;
    if (old + 1u == (gen + 1u) * nloc) {
      __builtin_amdgcn_fence(__ATOMIC_RELEASE, "agent");
      asm volatile("s_waitcnt vmcnt(0)" ::: "memory");
      const unsigned og = xb_add(&bar[XB_TOP], 1u);
      const unsigned tg = og / nx;
      if (og + 1u == (tg + 1u) * nx) xb_add(&bar[XB_TOPGEN], 1u);
      else XB_SPIN(xb_ld(&bar[XB_TOPGEN]) == tg, bar);
      __builtin_amdgcn_fence(__ATOMIC_ACQUIRE, "agent");
      xb_add(&bar[XB_XGEN(b.x)], 1u);
      asm volatile("s_waitcnt vmcnt(0)" ::: "memory");
    } else {
      XB_SPIN(xb_ld(&bar[XB_XGEN(b.x)]) == gen, bar);
      __builtin_amdgcn_fence(__ATOMIC_ACQUIRE, "agent");
      asm volatile("s_waitcnt vmcnt(0)" ::: "memory");
    }
  }
  __syncthreads();
}

__global__ void __launch_bounds__(NTHR) fwd_megakernel(Params p_arg) {
  cg::grid_group grid = cg::this_grid();
  __shared__ __attribute__((aligned(1024))) char smem[2 * STAGE_B + 16384];
  const size_t RS = (size_t)R * D;
  (void)RS;
  __shared__ uint4 xb_words;
  if (threadIdx.x == 0) xb_words = make_uint4(0u, 0u, 0u, 0u);
  __syncthreads();
  const XcdBarrier xb = xcd_barrier_post(((CParams*)__builtin_amdgcn_kernarg_segment_ptr())->bar, (volatile LAS unsigned*)&xb_words);
  {
    Ctx cx; cx.tid = threadIdx.x; cx.bid = blockIdx.x;
    CParams* pp = (CParams*)__builtin_amdgcn_kernarg_segment_ptr();
    ph_prologue(cx, *pp, (float*)smem);
  }
  const int wave_s = __builtin_amdgcn_readfirstlane((int)threadIdx.x >> 6);
  grid.sync();
#pragma nounroll
  for (int it2 = 0; it2 < NG * NPH * 2; ++it2) {
    const int it = it2 >> 1;
    const int g = it / NPH, ph = it - g * NPH;
    if (it2 & 1) continue;
    const unsigned long long tp0 = PROBE_MASK ? wall_clock64() : 0ull;
    Ctx cx;
    {
      int t_ = (wave_s << 6) | (int)__builtin_amdgcn_mbcnt_hi(~0u, __builtin_amdgcn_mbcnt_lo(~0u, 0u));
      int b_ = blockIdx.x; asm volatile("" : "+v"(t_), "+s"(b_)); cx.tid = t_; cx.bid = b_; }
    CParams* pp = (CParams*)__builtin_amdgcn_kernarg_segment_ptr();
    asm volatile("" : "+s"(pp));
    CParams& p = *pp;
    switch (ph) {
      case 0: ph_norm0(cx, p, g); break;
      case 1: gemm256(cx, p.H, p.H, 1 << 30, D, p.wt_in, D, ZW / 256, false, EpBf16{p.BIG, ZW}, smem); break;
      case 2: ph_qkconv(cx, p, g); break;
      case 3: ph_scan0(cx, p, smem); break;
      case 4: ph_evout(cx, p, g); break;
      case 5: gemm256(cx, p.H, p.H, 1 << 30, D, p.wt_out, D, 4, false, EpBf16{(u16*)p.YO, D}, smem); break;
      case 6: ph_resid(cx, p, g, 0, 0, false); break;
      case 7: gemm256(cx, p.H, p.H, 1 << 30, D, p.wt_up, D, GUW / 256, false, EpBf16{p.BIG, GUW}, smem); break;
      case 8: ph_ffnact(cx, p, g, 0, false); break;
      case 9: gemm256(cx, p.BIG + DFF, p.BIG + DFF, 1 << 30, GUW, p.wt_down, DFF, 4, false, EpBf16{(u16*)p.YO, D}, smem); break;
      case 10: ph_resid(cx, p, g, 0, 1, false); break;
      case 11: ph_xx(cx, p, g); break;
      case 12: gemm256<true>(cx, p.H, p.QK, D, D, p.wt_1, K1, N1 / 256, false, EpRw1{p.BIG, p.LR}, smem, p.BIG + 3 * RS); break;
      case 13: gemm256(cx, p.LR, p.LR, 1 << 30, K2, p.wt_2, K2, N2 / 256, false, EpRw2{p.BIG, p.QK, p.rw_w0, p.rw_a0}, smem); break;
      case 14: ph_rwprep(cx, p); break;
      case 15: ph_rwscan(cx, p); break;
      case 16: ph_rwout(cx, p, g); break;
      case 17: gemm256(cx, p.H, p.H, 1 << 30, D, p.wt_o, D, 4, true, EpBf16{(u16*)p.YO, D}, smem); break;
      case 18: ph_resid(cx, p, g, 1, 0, true); break;
      case 19: gemm256(cx, p.H, p.H, 1 << 30, D, p.wt_up + (size_t)GUW * D, D, GUW / 256, true, EpBf16{p.BIG, GUW}, smem); break;
      case 20: ph_ffnact(cx, p, g, 1, true); break;
      case 21: gemm256(cx, p.BIG + DFF, p.BIG + DFF, 1 << 30, GUW, p.wt_down + (size_t)D * DFF, DFF, 4, true, EpBf16{(u16*)p.YO, D}, smem); break;
      default: ph_resid(cx, p, g, 1, 1, true); break;
    }
    xcd_barrier(xb);
    if (PROBE_MASK && ((PROBE_MASK >> ph) & 1u)) {
      const unsigned long long tp1 = wall_clock64();
      while (wall_clock64() - tp1 < tp1 - tp0) __builtin_amdgcn_s_sleep(8);
    }
  }
}

extern "C" void kernel_launch(void* const* d_in, const int* in_sizes, int n_in, void* d_out, int out_size, void* d_ws,
                              size_t ws_size, hipStream_t stream) {
  static int grid_blocks = 0;
  if (!grid_blocks) {
    int dev = 0, cus = 0, per_cu = 0;
    hipGetDevice(&dev);
    hipDeviceGetAttribute(&cus, hipDeviceAttributeMultiprocessorCount, dev);
    hipOccupancyMaxActiveBlocksPerMultiprocessor(&per_cu, fwd_megakernel, NTHR, 0);
    if (per_cu > 1) per_cu = 1;
    if (per_cu < 1) per_cu = 1;
    grid_blocks = cus * per_cu;
  }
  Params p{};
  const float** f = (const float**)&p;
  for (int i = 0; i < 32; ++i) f[i] = (const float*)d_in[i];
  p.out = (float*)d_out;
  char* ws = (char*)d_ws;
  size_t off = 0;
  auto take = [&](size_t bytes) { char* q = ws + off; off += (bytes + 255) & ~(size_t)255; return q; };
  p.wt_in = (u16*)take((size_t)ZW * D * 2);
  p.wt_out = (u16*)take((size_t)D * D * 2);
  p.wt_up = (u16*)take((size_t)2 * GUW * D * 2);
  p.wt_down = (u16*)take((size_t)2 * D * DFF * 2);
  p.wt_o = (u16*)take((size_t)D * D * 2);
  p.wt_1 = (u16*)take((size_t)N1 * K1 * 2);
  p.wt_2 = (u16*)take((size_t)N2 * K2 * 2);
  p.mod = (float*)take((size_t)2 * 33 * 6144 * 4);
  p.xc = (float*)take((size_t)NB * CTX * D * 4);
  p.H = (u16*)take((size_t)R * D * 2);
  p.BIG = (u16*)take((size_t)6 * R * D * 2);
  p.QK = (u16*)take((size_t)R * D * 2);
  p.YO = (float*)take((size_t)R * D * 4);
  p.LR = (u16*)take((size_t)R * K2 * 2);
  p.bar = (unsigned*)take((size_t)XCD_BAR_WORDS * 4);
  if (off > ws_size) { fprintf(stderr, "workspace too small: need %zu have %zu\n", off, ws_size); return; }
  hipMemsetAsync(p.bar, 0, (size_t)XCD_BAR_WORDS * 4, stream);
  void* args[] = {&p};
  hipError_t e = hipLaunchCooperativeKernel((void*)fwd_megakernel, dim3(grid_blocks), dim3(NTHR), args, 0, stream);
  if (e != hipSuccess) fprintf(stderr, "cooperative launch failed: %s (grid %d)\n", hipGetErrorString(e), grid_blocks);
}
```
